# Optimizing an MI355X kernel written in HIP

```python
import jax, jax.numpy as jnp
from jax import lax
import numpy as np

D_MODEL = 1024
BATCH = 2
SEQ = 16384
DEPTH = 4

N_MIXERS = 2
N_POOL_LAYERS = (DEPTH + 1) // 2
N_MLA_LAYERS = DEPTH // 2
POOL_WINDOWS = (2, 4, 8, 16)
N_POOL_GROUPS = len(POOL_WINDOWS)
POOL_GROUP = D_MODEL // N_POOL_GROUPS
N_HEADS = D_MODEL // 128
QK_NOPE = 128
QK_ROPE = 64
QK_HEAD = QK_NOPE + QK_ROPE
V_HEAD = 128
Q_LORA = 3 * D_MODEL // 4
KV_LORA = D_MODEL // 4
ROPE_THETA = 10000.0
Q_BLOCK = 128
D_FF = 2816
FFN_HALF = 0.5
EPS = 1e-6

kernel_name = "hybrid_pool_mla_macaron_trunk"


def rmsnorm(x, gain):
    x32 = x.astype(jnp.float32)
    y = x32 * lax.rsqrt(jnp.mean(x32 * x32, axis=-1, keepdims=True) + EPS)
    return (y * gain.astype(jnp.float32)).astype(x.dtype)


def swiglu(h, w_gate, w_up, w_down):
    return (jax.nn.silu(h @ w_gate) * (h @ w_up)) @ w_down


def pool_mixer(h, w, scale):
    B, S, D = h.shape
    u = h.astype(jnp.float32).reshape(B, S, N_POOL_GROUPS, POOL_GROUP)
    cs = jnp.pad(jnp.cumsum(u, axis=1), ((0, 0), (1, 0), (0, 0), (0, 0)))
    sums = []
    for g, w_len in enumerate(POOL_WINDOWS):
        c = cs[:, :, g]
        lower = jnp.pad(c[:, :S + 1 - w_len], ((0, 0), (w_len - 1, 0), (0, 0)))
        sums.append(c[:, 1:] - lower)
    window_sum = jnp.stack(sums, axis=2)
    t = jnp.arange(S)
    count = jnp.minimum(t[:, None] + 1, jnp.array(POOL_WINDOWS, jnp.int32)[None, :])
    pooled = window_sum / count.astype(jnp.float32)[None, :, :, None] - u
    y = jnp.einsum('bsgc,gcd->bsgd', pooled.astype(h.dtype), w).reshape(B, S, D)
    return y * scale


def rope_tail(x, cos, sin):
    x_nope, x_pe = jnp.split(x, [QK_NOPE], axis=-1)
    x1, x2 = jnp.split(x_pe, 2, axis=-1)
    c = cos[:, :, None, :].astype(x.dtype)
    s = sin[:, :, None, :].astype(x.dtype)
    return jnp.concatenate([x_nope, x1 * c - x2 * s, x2 * c + x1 * s], axis=-1)


def causal_attention(q, k, v):
    B, S, H, Dq = q.shape
    nb = S // Q_BLOCK
    qb = q.reshape(B, nb, Q_BLOCK, H, Dq).transpose(1, 0, 3, 2, 4)
    kt = k.transpose(0, 2, 1, 3)
    vt = v.transpose(0, 2, 1, 3)
    kpos = jnp.arange(S)
    scale = QK_HEAD ** -0.5

    def one_block(args):
        q_blk, blk = args
        s = jnp.einsum('bhqd,bhkd->bhqk', q_blk, kt,
                       preferred_element_type=jnp.float32) * scale
        qpos = blk * Q_BLOCK + jnp.arange(Q_BLOCK)
        s = jnp.where(kpos[None, :] <= qpos[:, None], s, -jnp.inf)
        p = jax.nn.softmax(s, axis=-1).astype(vt.dtype)
        return jnp.einsum('bhqk,bhkv->bhqv', p, vt)

    out = lax.map(one_block, (qb, jnp.arange(nb)))
    return out.transpose(1, 0, 3, 2, 4).reshape(B, S, H, V_HEAD)


def mla_mixer(h, cos, sin, w_in, q_norm, w_q_up, kv_norm, w_kv_up,
              q_head_norm, k_head_norm, w_out):
    B, S, _ = h.shape
    lat = h @ w_in
    cq, ckv, k_pe = jnp.split(lat, [Q_LORA, Q_LORA + KV_LORA], axis=-1)
    q = (rmsnorm(cq, q_norm) @ w_q_up).reshape(B, S, N_HEADS, QK_HEAD)
    kv = (rmsnorm(ckv, kv_norm) @ w_kv_up).reshape(B, S, N_HEADS, QK_NOPE + V_HEAD)
    k_nope, v = jnp.split(kv, [QK_NOPE], axis=-1)
    k = jnp.concatenate(
        [k_nope, jnp.broadcast_to(k_pe[:, :, None, :], (B, S, N_HEADS, QK_ROPE))], axis=-1)
    q = rope_tail(rmsnorm(q, q_head_norm), cos, sin)
    k = rope_tail(rmsnorm(k, k_head_norm), cos, sin)
    o = causal_attention(q, k, v)
    return o.reshape(B, S, N_HEADS * V_HEAD) @ w_out


def setup_inputs(seed: int = 0) -> dict:
    key = jax.random.key(seed)
    ks = jax.random.split(key, 24)
    f32 = jnp.float32

    def dense(k, shape, fan_in):
        return jax.random.normal(k, shape, f32) * fan_in ** -0.5

    def gain(k, shape):
        return 1.0 + 0.05 * jax.random.normal(k, shape, f32)

    x = jax.random.normal(ks[0], (BATCH, SEQ, D_MODEL), f32)
    offsets = jax.random.randint(ks[1], (BATCH, 1), 0, 4096, dtype=jnp.int32)
    positions = (jnp.arange(SEQ, dtype=jnp.int32)[None, :] + offsets).astype(jnp.int32)
    return {
        "x": x,
        "positions": positions,
        "ffn1_norm": gain(ks[2], (DEPTH, D_MODEL)),
        "ffn1_w_gate": dense(ks[3], (DEPTH, D_MODEL, D_FF), D_MODEL),
        "ffn1_w_up": dense(ks[4], (DEPTH, D_MODEL, D_FF), D_MODEL),
        "ffn1_w_down": dense(ks[5], (DEPTH, D_FF, D_MODEL), D_FF),
        "mix_norm": gain(ks[6], (DEPTH, D_MODEL)),
        "pool_w": dense(ks[7], (N_POOL_LAYERS, N_POOL_GROUPS, POOL_GROUP, POOL_GROUP), POOL_GROUP),
        "pool_scale": gain(ks[8], (N_POOL_LAYERS, D_MODEL)),
        "mla_w_in": dense(ks[9], (N_MLA_LAYERS, D_MODEL, Q_LORA + KV_LORA + QK_ROPE), D_MODEL),
        "mla_q_norm": gain(ks[10], (N_MLA_LAYERS, Q_LORA)),
        "mla_w_q_up": dense(ks[11], (N_MLA_LAYERS, Q_LORA, N_HEADS * QK_HEAD), Q_LORA),
        "mla_kv_norm": gain(ks[12], (N_MLA_LAYERS, KV_LORA)),
        "mla_w_kv_up": dense(ks[13], (N_MLA_LAYERS, KV_LORA, N_HEADS * (QK_NOPE + V_HEAD)), KV_LORA),
        "mla_q_head_norm": gain(ks[14], (N_MLA_LAYERS, QK_HEAD)),
        "mla_k_head_norm": gain(ks[15], (N_MLA_LAYERS, QK_HEAD)),
        "mla_w_out": dense(ks[16], (N_MLA_LAYERS, N_HEADS * V_HEAD, D_MODEL), N_HEADS * V_HEAD),
        "ffn2_norm": gain(ks[17], (DEPTH, D_MODEL)),
        "ffn2_w_gate": dense(ks[18], (DEPTH, D_MODEL, D_FF), D_MODEL),
        "ffn2_w_up": dense(ks[19], (DEPTH, D_MODEL, D_FF), D_MODEL),
        "ffn2_w_down": dense(ks[20], (DEPTH, D_FF, D_MODEL), D_FF),
    }


def reference(x, positions, ffn1_norm, ffn1_w_gate, ffn1_w_up, ffn1_w_down, mix_norm,
              pool_w, pool_scale, mla_w_in, mla_q_norm, mla_w_q_up, mla_kv_norm,
              mla_w_kv_up, mla_q_head_norm, mla_k_head_norm, mla_w_out,
              ffn2_norm, ffn2_w_gate, ffn2_w_up, ffn2_w_down):
    inv_freq = 1.0 / (ROPE_THETA ** (jnp.arange(0, QK_ROPE, 2, dtype=jnp.float32) / QK_ROPE))
    ang = positions.astype(jnp.float32)[..., None] * inv_freq
    cos, sin = jnp.cos(ang), jnp.sin(ang)

    for i in range(DEPTH):
        h = rmsnorm(x, ffn1_norm[i])
        x = x + FFN_HALF * swiglu(h, ffn1_w_gate[i], ffn1_w_up[i], ffn1_w_down[i])
        h = rmsnorm(x, mix_norm[i])
        j = i // N_MIXERS
        if i % N_MIXERS == 0:
            x = x + pool_mixer(h, pool_w[j], pool_scale[j])
        else:
            x = x + mla_mixer(h, cos, sin, mla_w_in[j], mla_q_norm[j], mla_w_q_up[j],
                              mla_kv_norm[j], mla_w_kv_up[j], mla_q_head_norm[j],
                              mla_k_head_norm[j], mla_w_out[j])
        h = rmsnorm(x, ffn2_norm[i])
        x = x + FFN_HALF * swiglu(h, ffn2_w_gate[i], ffn2_w_up[i], ffn2_w_down[i])
    return x
```

```cpp
#include <hip/hip_runtime.h>
#include <hip/hip_cooperative_groups.h>
#include <cstdio>
#include <cstdint>
namespace cg = cooperative_groups;

#define DI __device__ __forceinline__
typedef unsigned short bf16_t;
typedef short bf16x8 __attribute__((ext_vector_type(8)));
typedef float f32x16 __attribute__((ext_vector_type(16)));
typedef float f32x4 __attribute__((ext_vector_type(4)));
typedef float f32x2 __attribute__((ext_vector_type(2)));
typedef unsigned u32x4 __attribute__((ext_vector_type(4)));
typedef unsigned u32x2 __attribute__((ext_vector_type(2)));
typedef __bf16 bf16v2 __attribute__((ext_vector_type(2)));

constexpr int NB = 2, S = 16384, T = NB * S, D = 1024, FF = 2816, NH = 8, DEPTH = 4;
constexpr int QL = 768, KVL = 256, QKH = 192, VH = 128;
constexpr int LATNP = 1280;
constexpr int LDH = D + 64;
constexpr int LDA = FF + 64;
constexpr int SV = S + 64;
constexpr int PADK = 64;
constexpr float EPS = 1e-6f;

constexpr size_t SZ_WGU = (size_t)2 * FF * (D + PADK) * 2, SZ_WDN = (size_t)D * (FF + PADK) * 2;
constexpr size_t OFF_WGU1 = 0, OFF_WDN1 = OFF_WGU1 + SZ_WGU, OFF_WGU2 = OFF_WDN1 + SZ_WDN, OFF_WDN2 = OFF_WGU2 + SZ_WGU;
constexpr size_t SZ_WPOOL = (size_t)1024 * (256 + PADK) * 2, SZ_WIN = (size_t)LATNP * (D + PADK) * 2, SZ_WQ = (size_t)1536 * (QL + PADK) * 2;
constexpr size_t SZ_WKV = (size_t)2048 * (KVL + PADK) * 2, SZ_WOUT = (size_t)D * (D + PADK) * 2;
constexpr size_t OFF_WPOOL = OFF_WDN2 + SZ_WDN;
constexpr size_t OFF_WIN = OFF_WPOOL + 2 * SZ_WPOOL;
constexpr size_t OFF_WQ = OFF_WIN + 2 * SZ_WIN;
constexpr size_t OFF_WKV = OFF_WQ + 2 * SZ_WQ;
constexpr size_t OFF_WOUT = OFF_WKV + 2 * SZ_WKV;
constexpr size_t OFF_COS = OFF_WOUT + 2 * SZ_WOUT;
constexpr size_t OFF_SIN = OFF_COS + (size_t)T * 32 * 4;
constexpr size_t OFF_SSQ = OFF_SIN + (size_t)T * 32 * 4;
constexpr size_t OFF_KPE = OFF_SSQ + (size_t)16 * T * 4;
constexpr size_t OFF_HB = OFF_KPE + (size_t)T * 64 * 4;
constexpr size_t OFF_BIG = OFF_HB + (size_t)T * LDH * 2;
constexpr size_t OFF_ACT = OFF_BIG;
constexpr size_t OFF_LAT = OFF_BIG;
constexpr size_t OFF_POOLED = OFF_BIG;
constexpr size_t OFF_QRAW = OFF_LAT + (size_t)T * LDH * 2;
constexpr size_t OFF_K = OFF_QRAW + (size_t)T * 1536 * 2;
constexpr size_t OFF_VT = OFF_K + (size_t)T * NH * QKH * 2;
constexpr size_t WS_END = OFF_VT + (size_t)NB * NH * VH * SV * 2;
static_assert(OFF_ACT + (size_t)T * LDA * 2 <= WS_END, "act must fit in the big region");
constexpr size_t OFF_CTL = WS_END;
constexpr size_t WS_TOTAL = OFF_CTL + 256;
static_assert(WS_TOTAL <= (size_t)536870912, "workspace budget (4 x largest tensor)");
constexpr int LDS_BYTES = 131072;
constexpr int VHALF_BYTES = 36864;

struct Params { const float* in[21]; float* out; unsigned char* ws; };
extern __shared__ __attribute__((aligned(1024))) unsigned char smem[];

DI unsigned pack_bf16(float lo, float hi) { f32x2 v = {lo, hi}; bf16v2 b = __builtin_convertvector(v, bf16v2); return __builtin_bit_cast(unsigned, b); }
DI bf16_t to_bf16(float x) { return (bf16_t)(pack_bf16(x, 0.f) & 0xffffu); }
DI float bf2f(short v) { return __uint_as_float(((unsigned)(unsigned short)v) << 16); }
DI int crow(int i, int h) { return (i & 3) + 8 * (i >> 2) + 4 * h; }
DI float red32(float v) { v += __shfl_xor(v, 1); v += __shfl_xor(v, 2); v += __shfl_xor(v, 4); v += __shfl_xor(v, 8); v += __shfl_xor(v, 16); return v; }
DI float red64(float v) { v = red32(v); v += __shfl_xor(v, 32); return v; }
DI int opaque_tid() { int t = threadIdx.x & 255; asm volatile("" : "+v"(t)); return t; }
DI int opaque_tid512() { int t = threadIdx.x; asm volatile("" : "+v"(t)); return t; }
#define MFMA(a, b, c) __builtin_amdgcn_mfma_f32_32x32x16_bf16((a), (b), (c), 0, 0, 0)
DI void grid_bar(unsigned* ctr, unsigned target) {
  asm volatile("s_waitcnt vmcnt(0)" ::: "memory");
  __syncthreads();
  if (threadIdx.x == 0) {
    __builtin_amdgcn_fence(__ATOMIC_RELEASE, "agent");
    asm volatile("s_waitcnt vmcnt(0)" ::: "memory");
    (void)__hip_atomic_fetch_add(ctr, 1u, __ATOMIC_RELAXED, __HIP_MEMORY_SCOPE_AGENT);
    while (__hip_atomic_load(ctr, __ATOMIC_RELAXED, __HIP_MEMORY_SCOPE_AGENT) < target) __builtin_amdgcn_s_sleep(1);
    __builtin_amdgcn_fence(__ATOMIC_ACQUIRE, "agent");
    asm volatile("s_waitcnt vmcnt(0)" ::: "memory");
  }
  __syncthreads();
}

DI void prep_w(int vb, int nvb, const float* __restrict__ W, bf16_t* __restrict__ Wt, int K, int N, const float* __restrict__ gk, const float* __restrict__ sn, int mode, float* smf) {
  const int ldt = K + PADK;
  const int tid = opaque_tid();
  const int ntn = N / 64, nt = (K / 64) * ntn;
  for (int t0 = 0; t0 < nt; t0 += nvb) {
    const int t = t0 + vb;
    const bool on = t < nt;
    const int k0 = (t / ntn) * 64, n0 = (t % ntn) * 64;
    if (on) {
#pragma unroll
      for (int i = 0; i < 16; ++i) {
        const int kk = i * 4 + (tid >> 6), nn = tid & 63;
        float v = __builtin_nontemporal_load(W + (size_t)(k0 + kk) * N + n0 + nn);
        if (gk) v *= gk[k0 + kk];
        if (sn) v *= sn[n0 + nn];
        smf[kk * 65 + nn] = v;
      }
    }
    __syncthreads();
    if (on) {
      const int nl = tid >> 2, kq = (tid & 3) * 16;
      u32x4 p0, p1;
      p0.x = pack_bf16(smf[(kq + 0) * 65 + nl], smf[(kq + 1) * 65 + nl]);
      p0.y = pack_bf16(smf[(kq + 2) * 65 + nl], smf[(kq + 3) * 65 + nl]);
      p0.z = pack_bf16(smf[(kq + 4) * 65 + nl], smf[(kq + 5) * 65 + nl]);
      p0.w = pack_bf16(smf[(kq + 6) * 65 + nl], smf[(kq + 7) * 65 + nl]);
      p1.x = pack_bf16(smf[(kq + 8) * 65 + nl], smf[(kq + 9) * 65 + nl]);
      p1.y = pack_bf16(smf[(kq + 10) * 65 + nl], smf[(kq + 11) * 65 + nl]);
      p1.z = pack_bf16(smf[(kq + 12) * 65 + nl], smf[(kq + 13) * 65 + nl]);
      p1.w = pack_bf16(smf[(kq + 14) * 65 + nl], smf[(kq + 15) * 65 + nl]);
      const int n = n0 + nl;
      int row = n;
      if (mode == 1) row = (n >> 4) * 32 + (n & 15);
      else if (mode == 2) row = (n >> 4) * 32 + 16 + (n & 15);
      else if (mode == 3) { const int hd = n >> 8, j = n & 255; row = (j < 128) ? (hd * 128 + j) : (1024 + hd * 128 + (j - 128)); }
      u32x4* dst = (u32x4*)(Wt + (size_t)row * ldt + k0 + kq);
      dst[0] = p0; dst[1] = p1;
    }
    __syncthreads();
  }
}

template <int WM_, int WN_, int MI_, int NI_, int BK_, int ST_>
struct Cfg {
  static constexpr int WM = WM_, WN = WN_, MI = MI_, NI = NI_, BK = BK_, ST = ST_;
  static constexpr int BM = WM * MI * 32, BN = WN * NI * 32;
  static constexpr int LS = BK + 8;
  static constexpr int A_EL = BM * LS, B_EL = BN * LS, STAGE_EL = A_EL + B_EL;
  static constexpr int CPR = BK / 8;
  static constexpr int A_CH = BM * CPR / 256, B_CH = BN * CPR / 256;
  static_assert(WM * WN == 4, "4 waves");
  static_assert(ST * STAGE_EL * 2 <= VHALF_BYTES, "LDS of a virtual half-block");
};

template <class C, class Epi>
DI void gemm_tile(const bf16_t* __restrict__ A, int lda, const bf16_t* __restrict__ Bt, int K, int m0, int n0, const Epi& epi, bf16_t* sm) {
  const int tid = opaque_tid(), lane = tid & 63, wave = tid >> 6, r = lane & 31, h = lane >> 5;
  const int wm = wave / C::WN, wn = wave % C::WN;
  f32x16 acc[C::MI][C::NI];
#pragma unroll
  for (int mi = 0; mi < C::MI; ++mi)
#pragma unroll
    for (int ni = 0; ni < C::NI; ++ni)
#pragma unroll
      for (int i = 0; i < 16; ++i) acc[mi][ni][i] = 0.f;
  const bf16_t* Ag = A + (size_t)m0 * lda;
  const int ldb = K + PADK;
  const bf16_t* Bg = Bt + (size_t)n0 * ldb;
  u32x4 ra[C::A_CH], rb[C::B_CH];
  const int nk = K / C::BK;
  constexpr int RPP = 256 / C::CPR;
  const unsigned a_off = (unsigned)(tid / C::CPR) * (unsigned)lda + (unsigned)(tid % C::CPR) * 8u;
  const unsigned b_off = (unsigned)(tid / C::CPR) * (unsigned)ldb + (unsigned)(tid % C::CPR) * 8u;
  const unsigned l_off = (unsigned)(tid / C::CPR) * C::LS + (unsigned)(tid % C::CPR) * 8u;
#define GLOAD(k0_)                                                                                   \
  {                                                                                                  \
    const bf16_t* ag_ = Ag + (k0_); const bf16_t* bg_ = Bg + (k0_);                                  \
    _Pragma("unroll") for (int i = 0; i < C::A_CH; ++i) ra[i] = *(const u32x4*)(ag_ + (a_off + (unsigned)(i * RPP) * (unsigned)lda)); \
    _Pragma("unroll") for (int i = 0; i < C::B_CH; ++i) rb[i] = *(const u32x4*)(bg_ + (b_off + (unsigned)(i * RPP) * (unsigned)ldb));   \
  }
#define LSTORE(buf_)                                                                                 \
  {                                                                                                  \
    bf16_t* sa_ = sm + (buf_) * C::STAGE_EL + l_off; bf16_t* sb_ = sa_ + C::A_EL;                    \
    _Pragma("unroll") for (int i = 0; i < C::A_CH; ++i) *(u32x4*)(sa_ + i * RPP * C::LS) = ra[i];   \
    _Pragma("unroll") for (int i = 0; i < C::B_CH; ++i) *(u32x4*)(sb_ + i * RPP * C::LS) = rb[i];   \
  }
  GLOAD(0);
  if (C::ST == 2) {
    LSTORE(0);
    __syncthreads();
  }
  for (int kt = 0; kt < nk; ++kt) {
    const int buf = (C::ST == 2) ? (kt & 1) : 0;
    if (C::ST == 1) {
      __syncthreads();
      LSTORE(0);
      __syncthreads();
    }
    if (kt + 1 < nk) GLOAD((kt + 1) * C::BK);
    __builtin_amdgcn_sched_barrier(0);
    const bf16_t* sa = sm + buf * C::STAGE_EL + (wm * C::MI * 32 + r) * C::LS + h * 8;
    const bf16_t* sb = sm + buf * C::STAGE_EL + C::A_EL + (wn * C::NI * 32 + r) * C::LS + h * 8;
#pragma unroll
    for (int ks = 0; ks < C::BK / 16; ++ks) {
      bf16x8 af[C::MI], bfr[C::NI];
#pragma unroll
      for (int mi = 0; mi < C::MI; ++mi) af[mi] = *(const bf16x8*)(sa + mi * 32 * C::LS + ks * 16);
#pragma unroll
      for (int ni = 0; ni < C::NI; ++ni) bfr[ni] = *(const bf16x8*)(sb + ni * 32 * C::LS + ks * 16);
#pragma unroll
      for (int mi = 0; mi < C::MI; ++mi)
#pragma unroll
        for (int ni = 0; ni < C::NI; ++ni) acc[mi][ni] = MFMA(af[mi], bfr[ni], acc[mi][ni]);
    }
    if (C::ST == 2) {
      if (kt + 1 < nk) LSTORE((kt + 1) & 1);
      __syncthreads();
    }
  }
  if (C::ST == 1) __syncthreads();
#undef GLOAD
#undef LSTORE
  epi.template run<C::MI, C::NI>(acc, m0 + wm * C::MI * 32, n0 + wn * C::NI * 32, r, h);
}

template <class C, class Epi>
DI void gemm_phase(int x, int j, int nb, const bf16_t* __restrict__ A, int lda, const bf16_t* __restrict__ Bt, int K, int N, int a_grp, const Epi& epi, bf16_t* sm) {
  static_assert(C::BM == 128 && (C::BN == 128 || C::BN == 256), "tile");
  constexpr int GN = (C::BN == 256) ? 4 : 8;
  const int nN = N / C::BN;
  const int total = 32 * nN;
  for (int u = j; u < total; u += nb) {
    const int ng = u / (32 * GN), rem = u % (32 * GN);
    int gn = nN - GN * ng; if (gn > GN) gn = GN;
    const int mg = rem / (8 * gn), jj = rem % (8 * gn);
    const int mt = 32 * x + 8 * mg + (jj & 7), nt = GN * ng + (jj >> 3);
    const int n0 = nt * C::BN;
    const bf16_t* Ap = a_grp ? (A + (n0 / a_grp) * K) : A;
    gemm_tile<C, Epi>(Ap, lda, Bt, K, mt * 128, n0, epi, sm);
  }
}

struct EpiGU {
  bf16_t* act; const float* ssq;
  template <int MI, int NI> DI void run(f32x16 (&acc)[MI][NI], int mb, int nb, int r, int h) const {
    static_assert((NI & 1) == 0, "gate/up pairs");
#pragma unroll
    for (int mi = 0; mi < MI; ++mi)
#pragma unroll
      for (int i = 0; i < 16; ++i) {
        const int row = mb + mi * 32 + crow(i, h);
        const float rs = rsqrtf(ssq[row] * (1.f / D) + EPS);
#pragma unroll
        for (int pi = 0; pi < NI / 2; ++pi) {
          const float g = acc[mi][2 * pi][i] * rs, u = acc[mi][2 * pi + 1][i] * rs;
          const float a = g / (1.f + __expf(-g)) * u;
          act[(size_t)row * LDA + (nb >> 1) + pi * 32 + r] = to_bf16(a);
        }
      }
  }
};
struct EpiResid {
  const float* xin; float* xout; float scale; bf16_t* xb; float* ssq;
  template <int MI, int NI> DI void run(f32x16 (&acc)[MI][NI], int mb, int nb, int r, int h) const {
#pragma unroll
    for (int mi = 0; mi < MI; ++mi)
#pragma unroll
      for (int hf = 0; hf < 2; ++hf) {
        float xv[8][NI];
#pragma unroll
        for (int i = 0; i < 8; ++i)
#pragma unroll
          for (int ni = 0; ni < NI; ++ni) xv[i][ni] = xin[(size_t)(mb + mi * 32 + crow(hf * 8 + i, h)) * D + nb + ni * 32 + r];
        __builtin_amdgcn_sched_barrier(0);
        float ssv[8];
#pragma unroll
        for (int i = 0; i < 8; ++i) {
          const int row = mb + mi * 32 + crow(hf * 8 + i, h);
          float ss = 0.f;
#pragma unroll
          for (int ni = 0; ni < NI; ++ni) {
            const float v = xv[i][ni] + scale * acc[mi][ni][hf * 8 + i];
            xout[(size_t)row * D + nb + ni * 32 + r] = v;
            if (xb) { xb[(size_t)row * LDH + nb + ni * 32 + r] = to_bf16(v); ss += v * v; }
          }
          ssv[i] = ss;
        }
        if (xb) {
#pragma unroll
          for (int i = 0; i < 8; ++i) { const float t = red32(ssv[i]); if (r == 0) atomicAdd(ssq + mb + mi * 32 + crow(hf * 8 + i, h), t); }
        }
        __builtin_amdgcn_sched_barrier(0);
      }
  }
};
struct EpiLat {
  bf16_t* lat; float* kpe; float* ssq_q; float* ssq_kv; const float* ssq_x;
  template <int MI, int NI> DI void run(f32x16 (&acc)[MI][NI], int mb, int nb, int r, int h) const {
    if (nb >= 1088) return;
    float* ssq = (nb < QL) ? ssq_q : ssq_kv;
#pragma unroll
    for (int mi = 0; mi < MI; ++mi) {
      float rsv[16];
#pragma unroll
      for (int i = 0; i < 16; ++i) rsv[i] = rsqrtf(ssq_x[mb + mi * 32 + crow(i, h)] * (1.f / D) + EPS);
      __builtin_amdgcn_sched_barrier(0);
      if (nb >= 1024) {
#pragma unroll
        for (int i = 0; i < 16; ++i)
#pragma unroll
          for (int ni = 0; ni < NI; ++ni) kpe[(size_t)(mb + mi * 32 + crow(i, h)) * 64 + (nb - 1024) + ni * 32 + r] = acc[mi][ni][i] * rsv[i];
      } else {
        float ssv[16];
#pragma unroll
        for (int i = 0; i < 16; ++i) {
          const int row = mb + mi * 32 + crow(i, h);
          float ss = 0.f;
#pragma unroll
          for (int ni = 0; ni < NI; ++ni) { const float v = acc[mi][ni][i] * rsv[i]; ss += v * v; lat[(size_t)row * LDH + nb + ni * 32 + r] = to_bf16(v); }
          ssv[i] = ss;
        }
#pragma unroll
        for (int i = 0; i < 16; ++i) { const float t = red32(ssv[i]); if (r == 0) atomicAdd(ssq + mb + mi * 32 + crow(i, h), t); }
      }
    }
  }
};
struct EpiQraw {
  bf16_t* q; const float* ssq_q;
  template <int MI, int NI> DI void run(f32x16 (&acc)[MI][NI], int mb, int nb, int r, int h) const {
#pragma unroll
    for (int mi = 0; mi < MI; ++mi)
#pragma unroll
      for (int i = 0; i < 16; ++i) {
        const int row = mb + mi * 32 + crow(i, h);
        const float rs = rsqrtf(ssq_q[row] * (1.f / QL) + EPS);
#pragma unroll
        for (int ni = 0; ni < NI; ++ni) q[(size_t)row * 1536 + nb + ni * 32 + r] = to_bf16(acc[mi][ni][i] * rs);
      }
  }
};
struct EpiKV {
  const float* ssq_kv; const float* kpe; const float* gk; const float* cosT; const float* sinT; bf16_t* kout; bf16_t* vt;
  template <int MI, int NI> DI void run(f32x16 (&acc)[MI][NI], int mb, int nb, int r, int h) const {
    static_assert(MI == 1 && NI == 4, "kv epilogue layout");
    const int b = mb / S, sb = mb % S;
    if (nb < 1024) {
      const int head = nb >> 7;
      const float g0 = gk[r], g1 = gk[32 + r], g2 = gk[64 + r], g3 = gk[96 + r], g4 = gk[128 + r], g5 = gk[160 + r];
#pragma unroll
      for (int i = 0; i < 16; ++i) {
        const int rw = crow(i, h), tok = mb + rw;
        const float rkv = rsqrtf(ssq_kv[tok] * (1.f / KVL) + EPS);
        const float v0 = acc[0][0][i] * rkv, v1 = acc[0][1][i] * rkv, v2 = acc[0][2][i] * rkv, v3 = acc[0][3][i] * rkv;
        const float p1 = kpe[(size_t)tok * 64 + r], p2 = kpe[(size_t)tok * 64 + 32 + r];
        float ss = v0 * v0 + v1 * v1 + v2 * v2 + v3 * v3 + p1 * p1 + p2 * p2;
        ss = red32(ss);
        const float rk = rsqrtf(ss * (1.f / QKH) + EPS);
        bf16_t* kr = kout + ((size_t)(b * NH + head) * S + sb + rw) * QKH;
        kr[r] = to_bf16(v0 * rk * g0); kr[32 + r] = to_bf16(v1 * rk * g1); kr[64 + r] = to_bf16(v2 * rk * g2); kr[96 + r] = to_bf16(v3 * rk * g3);
        const float c = cosT[(size_t)tok * 32 + r], sn = sinT[(size_t)tok * 32 + r];
        const float x1 = p1 * rk * g4, x2 = p2 * rk * g5;
        kr[128 + r] = to_bf16(x1 * c - x2 * sn); kr[160 + r] = to_bf16(x2 * c + x1 * sn);
      }
    } else {
      const int head = (nb - 1024) >> 7;
      float rkv[16];
#pragma unroll
      for (int i = 0; i < 16; ++i) rkv[i] = rsqrtf(ssq_kv[mb + crow(i, h)] * (1.f / KVL) + EPS);
#pragma unroll
      for (int ni = 0; ni < 4; ++ni) {
        bf16_t* vr = vt + ((size_t)(b * NH + head) * VH + ni * 32 + r) * SV + sb;
#pragma unroll
        for (int a = 0; a < 4; ++a) {
          u32x2 o;
          o.x = pack_bf16(acc[0][ni][4 * a] * rkv[4 * a], acc[0][ni][4 * a + 1] * rkv[4 * a + 1]);
          o.y = pack_bf16(acc[0][ni][4 * a + 2] * rkv[4 * a + 2], acc[0][ni][4 * a + 3] * rkv[4 * a + 3]);
          *(u32x2*)(vr + 16 * (a >> 1) + 8 * h + 4 * (a & 1)) = o;
        }
      }
    }
  }
};


DI int lds_byte2(int r, int c) { const int st = (r >> 4) * 2 + (c >> 5), ob = (r & 15) * 64 + (c & 31) * 2; return st * 1024 + (ob ^ (((ob >> 9) & 1) << 5)); }
DI void stage_rc2(int b, int& R, int& C) { const int st = b >> 10, sb = b & 1023, swz = sb ^ (((sb >> 9) & 1) << 5); R = (st >> 1) * 16 + swz / 64; C = (st & 1) * 32 + (swz % 64) / 2; }
#define MFMA16(a, b, c) __builtin_amdgcn_mfma_f32_16x16x32_bf16((a), (b), (c), 0, 0, 0)
constexpr int G8_TILE_B = 256 * 64 * 2, G8_STAGE_B = 2 * G8_TILE_B;

template <class Epi>
DI void gemm8_tile(const bf16_t* __restrict__ Ab, int lda, const bf16_t* __restrict__ Bb, int ldb, int K, int brow, int bcol, const Epi epi,
                   bool staged, bool has_next, const bf16_t* __restrict__ Abn, const bf16_t* __restrict__ Bbn) {
  const int tid = opaque_tid512(), wid = tid >> 6, lane = tid & 63, wr = wid >> 2, wc = wid & 3, fr = lane & 15, fq = lane >> 4;
  unsigned aoff[4], boff[4];
#pragma unroll
  for (int i = 0; i < 4; ++i) { int R, C; stage_rc2(wid * 1024 + i * 8192 + lane * 16, R, C); aoff[i] = (unsigned)R * (unsigned)lda + (unsigned)C; boff[i] = (unsigned)R * (unsigned)ldb + (unsigned)C; }
#define G8_STAGE_R(buf_, ap_, bp_, i0_, i1_)                                                                         \
  {                                                                                                                  \
    const bf16_t* ag_ = (ap_); const bf16_t* bg_ = (bp_);                                                            \
    _Pragma("unroll") for (int i = (i0_); i < (i1_); ++i) {                                                          \
      __builtin_amdgcn_global_load_lds((const unsigned*)(ag_ + aoff[i]), (unsigned*)(smem + (buf_) * G8_STAGE_B + wid * 1024 + i * 8192), 16, 0, 0);              \
      __builtin_amdgcn_global_load_lds((const unsigned*)(bg_ + boff[i]), (unsigned*)(smem + (buf_) * G8_STAGE_B + G8_TILE_B + wid * 1024 + i * 8192), 16, 0, 0);  \
    }                                                                                                                \
  }
#define G8_STAGE(buf_, ap_, bp_) G8_STAGE_R(buf_, ap_, bp_, 0, 4)
  f32x4 acc[8][4];
#pragma unroll
  for (int m = 0; m < 8; ++m)
#pragma unroll
    for (int n = 0; n < 4; ++n) acc[m][n] = (f32x4){0.f, 0.f, 0.f, 0.f};
  const int nt = K / 64;
  if (!staged) {
    G8_STAGE(0, Ab, Bb);
    asm volatile("s_waitcnt vmcnt(0)" ::: "memory");
    __syncthreads();
  }
  for (int t = 0; t < nt; ++t) {
    const int cur = t & 1;
    const unsigned char* sa = smem + cur * G8_STAGE_B;
    const unsigned char* sb = sa + G8_TILE_B;
#pragma unroll
    for (int ks = 0; ks < 2; ++ks) {
      bf16x8 At[8], Bf[4];
#pragma unroll
      for (int m = 0; m < 8; ++m) At[m] = *(const bf16x8*)(sa + lds_byte2(wr * 128 + m * 16 + fr, ks * 32 + fq * 8));
#pragma unroll
      for (int n = 0; n < 4; ++n) Bf[n] = *(const bf16x8*)(sb + lds_byte2(wc * 64 + n * 16 + fr, ks * 32 + fq * 8));
      {
        __builtin_amdgcn_sched_barrier(0);
        if (t + 1 < nt) { G8_STAGE_R(cur ^ 1, Ab + (t + 1) * 64, Bb + (t + 1) * 64, 2 * ks, 2 * ks + 2); }
        else if (has_next) { G8_STAGE_R(0, Abn, Bbn, 2 * ks, 2 * ks + 2); }
        __builtin_amdgcn_sched_barrier(0);
      }
      __builtin_amdgcn_s_setprio(1);
#pragma unroll
      for (int m = 0; m < 8; ++m)
#pragma unroll
        for (int n = 0; n < 4; ++n) acc[m][n] = MFMA16(At[m], Bf[n], acc[m][n]);
      __builtin_amdgcn_s_setprio(0);
      __builtin_amdgcn_sched_barrier(0);
    }
    asm volatile("s_waitcnt vmcnt(0)" ::: "memory");
    __syncthreads();
  }
#undef G8_STAGE
#undef G8_STAGE_R
  epi.run8(acc, brow + wr * 128, bcol + wc * 64, fr, fq);
  if (Epi::LDS_SCRATCH) __syncthreads();
}

DI void g8_decode(int u, int x, int nN, int& pm, int& pn) {
  const int ng = u >> 6, rem = u & 63;
  int gn = nN - 4 * ng; if (gn > 4) gn = 4;
  const int mg = rem / (8 * gn), jj = rem % (8 * gn);
  pm = 16 * x + 8 * mg + (jj & 7); pn = 4 * ng + (jj >> 3);
}
template <class Epi>
DI void gemm8_phase(int x, int j, const bf16_t* __restrict__ A, int lda, const bf16_t* __restrict__ Bt, int K, int N, int a_grp, const Epi epi) {
  const int nN = N / 256, nb = gridDim.x >> 3, ldb = K + PADK;
  const int total = 16 * nN;
  bool staged = false;
  for (int u = j; u < total; u += nb) {
    int pm, pn; g8_decode(u, x, nN, pm, pn);
    const int brow = pm * 256, bcol = pn * 256;
    const bf16_t* Ab = A + (size_t)brow * lda + (a_grp ? (bcol / a_grp) * K : 0);
    const bf16_t* Bb = Bt + (size_t)bcol * ldb;
    const bool has_next = (u + nb < total);
    const bf16_t* Abn = Ab; const bf16_t* Bbn = Bb;
    if (has_next) {
      int pm2, pn2; g8_decode(u + nb, x, nN, pm2, pn2);
      Abn = A + (size_t)(pm2 * 256) * lda + (a_grp ? ((pn2 * 256) / a_grp) * K : 0);
      Bbn = Bt + (size_t)(pn2 * 256) * ldb;
    }
    gemm8_tile<Epi>(Ab, lda, Bb, ldb, K, brow, bcol, epi, staged, has_next, Abn, Bbn);
    staged = has_next;
  }
}
DI float red16(float v) { v += __shfl_xor(v, 1); v += __shfl_xor(v, 2); v += __shfl_xor(v, 4); v += __shfl_xor(v, 8); return v; }

struct EpiGU8 {
  static constexpr bool LDS_SCRATCH = true;
  bf16_t* act; const float* ssq;
  DI void run8(f32x4 (&acc)[8][4], int rb, int cb, int fr, int fq) const {
    const int lane = fq * 16 + fr, wid = (int)(threadIdx.x >> 6);
    bf16_t* scr = (bf16_t*)(smem + G8_STAGE_B + wid * 1280);
    const int srow = lane >> 2, sch = lane & 3;
    bf16_t* ap = act + (size_t)(rb + srow) * LDA + (cb >> 1) + sch * 8;
    float rsv[8][4];
#pragma unroll
    for (int m = 0; m < 8; ++m)
#pragma unroll
      for (int j = 0; j < 4; ++j) rsv[m][j] = rsqrtf(ssq[rb + m * 16 + fq * 4 + j] * (1.f / D) + EPS);
#pragma unroll
    for (int m = 0; m < 8; ++m) {
#pragma unroll
      for (int j = 0; j < 4; ++j)
#pragma unroll
        for (int pi = 0; pi < 2; ++pi) {
          const float g = acc[m][2 * pi][j] * rsv[m][j], u = acc[m][2 * pi + 1][j] * rsv[m][j];
          const float a = g * __builtin_amdgcn_rcpf(1.f + __expf(-g)) * u;
          scr[(fq * 4 + j) * 40 + pi * 16 + fr] = to_bf16(a);
        }
      __builtin_amdgcn_sched_barrier(0);
      const u32x4 o = *(const u32x4*)(scr + srow * 40 + sch * 8);
      *(u32x4*)(ap + (size_t)(m * 16) * LDA) = o;
      __builtin_amdgcn_sched_barrier(0);
    }
  }
};
struct EpiResid8 {
  static constexpr bool LDS_SCRATCH = true;
  const float* xin; float* xout; float scale; bf16_t* xb; float* ssq;
  DI void run8(f32x4 (&acc)[8][4], int rb, int cb, int fr, int fq) const {
    const int lane = fq * 16 + fr, wid = (int)(threadIdx.x >> 6);
    const float sc = scale; bf16_t* const xbp = xb; float* const ssqp = ssq;
    float* scr = (float*)(smem + G8_STAGE_B + wid * 4352);
    const int prow = lane >> 4, c4 = lane & 15;
    const float* xp = xin + (size_t)(rb + prow) * D + cb + c4 * 4;
    float* op = xout + (size_t)(rb + prow) * D + cb + c4 * 4;
#pragma unroll
    for (int mh = 0; mh < 2; ++mh) {
      f32x4 xv[4][4];
#pragma unroll
      for (int mm = 0; mm < 4; ++mm)
#pragma unroll
        for (int ps = 0; ps < 4; ++ps) xv[mm][ps] = __builtin_nontemporal_load((const f32x4*)(xp + (size_t)((mh * 4 + mm) * 16 + ps * 4) * D));
      __builtin_amdgcn_sched_barrier(0);
#pragma unroll
      for (int mm = 0; mm < 4; ++mm) {
        const int m = mh * 4 + mm;
#pragma unroll
        for (int n = 0; n < 4; ++n)
#pragma unroll
          for (int j = 0; j < 4; ++j) scr[(fq * 4 + j) * 68 + n * 16 + fr] = acc[m][n][j];
        __builtin_amdgcn_sched_barrier(0);
#pragma unroll
        for (int ps = 0; ps < 4; ++ps) {
          const f32x4 a = *(const f32x4*)(scr + (ps * 4 + prow) * 68 + c4 * 4);
          f32x4 v;
          v.x = xv[mm][ps].x + a.x * sc; v.y = xv[mm][ps].y + a.y * sc; v.z = xv[mm][ps].z + a.z * sc; v.w = xv[mm][ps].w + a.w * sc;
          const int grow = rb + m * 16 + ps * 4 + prow;
          __builtin_nontemporal_store(v, (f32x4*)(op + (size_t)(m * 16 + ps * 4) * D));
          if (xbp) {
            u32x2 o; o.x = pack_bf16(v.x, v.y); o.y = pack_bf16(v.z, v.w);
            *(u32x2*)(xbp + (size_t)grow * LDH + cb + c4 * 4) = o;
            const float t = red16(v.x * v.x + v.y * v.y + v.z * v.z + v.w * v.w);
            if (c4 == 0) atomicAdd(ssqp + grow, t);
          }
        }
        __builtin_amdgcn_sched_barrier(0);
      }
    }
  }
};
struct EpiLat8 {
  static constexpr bool LDS_SCRATCH = false;
  bf16_t* lat; float* kpe; float* ssq_q; float* ssq_kv; const float* ssq_x;
  DI void run8(f32x4 (&acc)[8][4], int rb, int cb, int fr, int fq) const {
    if (cb >= 1088) return;
    float* ssq = (cb < QL) ? ssq_q : ssq_kv;
#pragma unroll
    for (int mp = 0; mp < 2; ++mp) {
      float rsv[4][4];
#pragma unroll
      for (int mm = 0; mm < 4; ++mm)
#pragma unroll
        for (int j = 0; j < 4; ++j) rsv[mm][j] = rsqrtf(ssq_x[rb + (4 * mp + mm) * 16 + fq * 4 + j] * (1.f / D) + EPS);
      __builtin_amdgcn_sched_barrier(0);
#pragma unroll
      for (int mm = 0; mm < 4; ++mm) {
        float ssv[4];
#pragma unroll
        for (int j = 0; j < 4; ++j) {
          const int row = rb + (4 * mp + mm) * 16 + fq * 4 + j;
          float ss = 0.f;
#pragma unroll
          for (int n = 0; n < 4; ++n) {
            const float v = acc[4 * mp + mm][n][j] * rsv[mm][j];
            if (cb >= 1024) kpe[(size_t)row * 64 + (cb - 1024) + n * 16 + fr] = v;
            else { lat[(size_t)row * LDH + cb + n * 16 + fr] = to_bf16(v); ss += v * v; }
          }
          ssv[j] = ss;
        }
        if (cb < 1024) {
#pragma unroll
          for (int j = 0; j < 4; ++j) { const float t = red16(ssv[j]); if (fr == 0) atomicAdd(ssq + rb + (4 * mp + mm) * 16 + fq * 4 + j, t); }
        }
      }
    }
  }
};
struct EpiQraw8 {
  static constexpr bool LDS_SCRATCH = false;
  bf16_t* q; const float* ssq_q;
  DI void run8(f32x4 (&acc)[8][4], int rb, int cb, int fr, int fq) const {
#pragma unroll
    for (int m = 0; m < 8; ++m)
#pragma unroll
      for (int j = 0; j < 4; ++j) {
        const int row = rb + m * 16 + fq * 4 + j;
        const float rs = rsqrtf(ssq_q[row] * (1.f / QL) + EPS);
#pragma unroll
        for (int n = 0; n < 4; ++n) q[(size_t)row * 1536 + cb + n * 16 + fr] = to_bf16(acc[m][n][j] * rs);
      }
  }
};

DI void norm0_phase(const float* __restrict__ x, bf16_t* __restrict__ hb, float* __restrict__ ssq) {
  const int tid = opaque_tid512();
  const int lane = tid & 63, gw = blockIdx.x * 8 + (tid >> 6), nw = gridDim.x * 8;
  for (int row = gw; row < T; row += nw) {
    const f32x4* xr = (const f32x4*)(x + (size_t)row * D);
    f32x4 v[4];
    float ss = 0.f;
#pragma unroll
    for (int c = 0; c < 4; ++c) { v[c] = __builtin_nontemporal_load(xr + c * 64 + lane); ss += v[c].x * v[c].x + v[c].y * v[c].y + v[c].z * v[c].z + v[c].w * v[c].w; }
    ss = red64(ss);
    if (lane == 0) ssq[row] = ss;
#pragma unroll
    for (int c = 0; c < 4; ++c) {
      u32x2 o; o.x = pack_bf16(v[c].x, v[c].y); o.y = pack_bf16(v[c].z, v[c].w);
      *(u32x2*)(hb + (size_t)row * LDH + (c * 64 + lane) * 4) = o;
    }
  }
}

template <int W>
DI void pool_rows(const float* __restrict__ x, const float* smr, bf16_t* __restrict__ pb, int t0, int s0, int tid) {
  const int tq0 = t0 - s0;
  const float* xq = x + tid * 4;
  f32x4 Sm = {0.f, 0.f, 0.f, 0.f};
#pragma unroll
  for (int i = 1; i < W; ++i) {
    int t = t0 - i; if (t < tq0) t = tq0;
    Sm += *(const f32x4*)(xq + (size_t)t * D) * smr[15 - i];
  }
#pragma unroll 8
  for (int tl = 0; tl < 64; ++tl) {
    const int t = t0 + tl, s = s0 + tl;
    int to = t - W + 1; if (to < tq0) to = tq0;
    const f32x4 hn = *(const f32x4*)(xq + (size_t)t * D) * smr[15 + tl];
    const f32x4 ho = *(const f32x4*)(xq + (size_t)to * D) * smr[15 + tl - W + 1];
    const int cnt = (s + 1 < W) ? (s + 1) : W;
    const float ic = 1.f / (float)cnt;
    Sm += hn;
    const f32x4 p = Sm * ic - hn;
    Sm -= ho;
    u32x2 o; o.x = pack_bf16(p.x, p.y); o.y = pack_bf16(p.z, p.w);
    *(u32x2*)(pb + (size_t)t * LDH + tid * 4) = o;
  }
}
DI void poolprep_phase(int vb, int nvb, const float* __restrict__ x, const float* __restrict__ ssq, bf16_t* __restrict__ pb, float* smf) {
  const int tid = opaque_tid(), wave = tid >> 6;
  for (int c0 = 0; c0 < T / 64; c0 += nvb) {
    const int ch = c0 + vb;
    const bool on = ch < T / 64;
    const int t0 = ch * 64, s0 = t0 & (S - 1);
    if (on && tid < 79) smf[tid] = (s0 + tid >= 15) ? rsqrtf(ssq[t0 - 15 + tid] * (1.f / D) + EPS) : 0.f;
    __syncthreads();
    if (on) {
      if (wave == 0) pool_rows<2>(x, smf, pb, t0, s0, tid);
      else if (wave == 1) pool_rows<4>(x, smf, pb, t0, s0, tid);
      else if (wave == 2) pool_rows<8>(x, smf, pb, t0, s0, tid);
      else pool_rows<16>(x, smf, pb, t0, s0, tid);
    }
    __syncthreads();
  }
}

constexpr int KLS = QKH + 8;
constexpr int VLS = 64 + 8;
constexpr int K_EL = 64 * KLS;
constexpr int ATT_STG_EL = K_EL + 128 * VLS;

DI void attn_phase(const bf16_t* __restrict__ qraw, const bf16_t* __restrict__ kbuf, const bf16_t* __restrict__ vtb, bf16_t* __restrict__ obuf,
                   const float* __restrict__ gq, const float* __restrict__ cosT, const float* __restrict__ sinT, bf16_t* sm, int x, int j) {
  const int nb = gridDim.x >> 3;
  for (int p = j; p < 64; p += nb) {
    const int bh = 2 * x + (p >> 5);
    const int b = bh >> 3, hd = bh & 7;
    for (int half = 0; half < 2; ++half) {
      const int tid = opaque_tid512(), lane = tid & 63, wave = tid >> 6, r = lane & 31, h = lane >> 5;
      const int qb = half ? (p & 31) : (63 - (p & 31));
      const int q0 = qb * 256 + wave * 32;
      const size_t tok = (size_t)b * S + q0 + r;
      bf16x8 qf[12];
      {
        const bf16_t* qp = qraw + tok * 1536 + hd * QKH + h * 8;
#pragma unroll
        for (int st = 0; st < 12; ++st) qf[st] = *(const bf16x8*)(qp + st * 16);
        float ss = 0.f;
#pragma unroll
        for (int st = 0; st < 12; ++st) {
#pragma unroll
          for (int e = 0; e < 8; ++e) { const float f = bf2f(qf[st][e]); ss += f * f; }
          u32x4 t = __builtin_bit_cast(u32x4, qf[st]);
          asm volatile("" : "+v"(t));
          qf[st] = __builtin_bit_cast(bf16x8, t);
        }
        ss += __shfl_xor(ss, 32);
        const float rq = rsqrtf(ss * (1.f / QKH) + EPS) * (0.07216878364870322f * 1.4426950408889634f);
        __builtin_amdgcn_sched_barrier(0);
#pragma unroll
        for (int st = 0; st < 8; ++st) {
          const f32x4 ga = *(const f32x4*)(gq + st * 16 + h * 8), gb = *(const f32x4*)(gq + st * 16 + h * 8 + 4);
          u32x4 o;
          o.x = pack_bf16(bf2f(qf[st][0]) * rq * ga.x, bf2f(qf[st][1]) * rq * ga.y);
          o.y = pack_bf16(bf2f(qf[st][2]) * rq * ga.z, bf2f(qf[st][3]) * rq * ga.w);
          o.z = pack_bf16(bf2f(qf[st][4]) * rq * gb.x, bf2f(qf[st][5]) * rq * gb.y);
          o.w = pack_bf16(bf2f(qf[st][6]) * rq * gb.z, bf2f(qf[st][7]) * rq * gb.w);
          asm volatile("" : "+v"(o));
          qf[st] = __builtin_bit_cast(bf16x8, o);
          __builtin_amdgcn_sched_barrier(0);
        }
#pragma unroll
        for (int st = 8; st < 10; ++st) {
          const int jb = (st - 8) * 16 + h * 8;
          u32x4 o1, o2;
#pragma unroll
          for (int hf = 0; hf < 2; ++hf) {
            const f32x4 g1 = *(const f32x4*)(gq + 128 + jb + 4 * hf), g2 = *(const f32x4*)(gq + 160 + jb + 4 * hf);
            const f32x4 cc = *(const f32x4*)(cosT + tok * 32 + jb + 4 * hf), sn = *(const f32x4*)(sinT + tok * 32 + jb + 4 * hf);
            float y1[4], y2[4];
#pragma unroll
            for (int e = 0; e < 4; ++e) {
              const float x1 = bf2f(qf[st][4 * hf + e]) * rq * g1[e], x2 = bf2f(qf[st + 2][4 * hf + e]) * rq * g2[e];
              y1[e] = x1 * cc[e] - x2 * sn[e]; y2[e] = x2 * cc[e] + x1 * sn[e];
            }
            if (hf == 0) { o1.x = pack_bf16(y1[0], y1[1]); o1.y = pack_bf16(y1[2], y1[3]); o2.x = pack_bf16(y2[0], y2[1]); o2.y = pack_bf16(y2[2], y2[3]); }
            else { o1.z = pack_bf16(y1[0], y1[1]); o1.w = pack_bf16(y1[2], y1[3]); o2.z = pack_bf16(y2[0], y2[1]); o2.w = pack_bf16(y2[2], y2[3]); }
          }
          asm volatile("" : "+v"(o1), "+v"(o2));
          qf[st] = __builtin_bit_cast(bf16x8, o1); qf[st + 2] = __builtin_bit_cast(bf16x8, o2);
          __builtin_amdgcn_sched_barrier(0);
        }
      }
      f32x16 oacc[4];
#pragma unroll
      for (int mt = 0; mt < 4; ++mt)
#pragma unroll
        for (int i = 0; i < 16; ++i) oacc[mt][i] = 0.f;
      float m_run = -1e30f, l_run = 0.f;
      const int nkt = 4 * qb + 4;
      const bf16_t* kg = kbuf + (size_t)bh * S * QKH;
      const bf16_t* vg = vtb + (size_t)bh * VH * SV;
      u32x4 rk[3], rv[2];
      const unsigned kg_off0 = (unsigned)(tid >> 3) * QKH + (unsigned)(tid & 7) * 8u;
      const unsigned vg_off0 = (unsigned)(tid >> 3) * (unsigned)SV + (unsigned)(tid & 7) * 8u;
      const unsigned kl_off = (unsigned)(tid >> 3) * KLS + (unsigned)(tid & 7) * 8u;
      const unsigned vl_off = (unsigned)(tid >> 3) * VLS + (unsigned)(tid & 7) * 8u;
#define ALOAD(kt_)                                                                                                     \
  {                                                                                                                    \
    const bf16_t* kgt_ = kg + (size_t)(kt_) * 64 * QKH; const bf16_t* vgt_ = vg + (kt_) * 64;                          \
    unsigned kg_off = kg_off0, vg_off = vg_off0; asm volatile("" : "+v"(kg_off), "+v"(vg_off));                        \
    _Pragma("unroll") for (int i = 0; i < 3; ++i) rk[i] = *(const u32x4*)(kgt_ + (kg_off + (unsigned)(i * 64)));       \
    _Pragma("unroll") for (int i = 0; i < 2; ++i) rv[i] = *(const u32x4*)(vgt_ + (vg_off + (unsigned)(i * 64) * (unsigned)SV)); \
  }
      ALOAD(0);
#define ASTORE(stg_)                                                                                                   \
  {                                                                                                                    \
    bf16_t* sk_ = sm + (stg_) * ATT_STG_EL; bf16_t* sv_ = sk_ + K_EL;                                                  \
    _Pragma("unroll") for (int i = 0; i < 3; ++i) *(u32x4*)(sk_ + kl_off + i * 64) = rk[i];                            \
    _Pragma("unroll") for (int i = 0; i < 2; ++i) *(u32x4*)(sv_ + vl_off + i * 64 * VLS) = rv[i];                      \
  }
      ASTORE(0);
      __syncthreads();
      for (int kt = 0; kt < nkt; ++kt) {
        const bf16_t* smk = sm + (kt & 1) * ATT_STG_EL;
        const bf16_t* smv = smk + K_EL;
        if (kt + 1 < nkt) ALOAD(kt + 1);
        __builtin_amdgcn_sched_barrier(0);
        if (kt * 64 <= q0 + 31) {
        f32x16 sacc[2];
#pragma unroll
        for (int mt = 0; mt < 2; ++mt)
#pragma unroll
          for (int i = 0; i < 16; ++i) sacc[mt][i] = 0.f;
        const bf16_t* kp = smk + r * KLS + h * 8;
        {
          bf16x8 ka = *(const bf16x8*)(kp), kb = *(const bf16x8*)(kp + 32 * KLS);
#pragma unroll
          for (int st = 0; st < 12; ++st) {
            bf16x8 na = ka, nbq = kb;
            if (st + 1 < 12) { na = *(const bf16x8*)(kp + (st + 1) * 16); nbq = *(const bf16x8*)(kp + 32 * KLS + (st + 1) * 16); }
            sacc[0] = MFMA(ka, qf[st], sacc[0]);
            sacc[1] = MFMA(kb, qf[st], sacc[1]);
            ka = na; kb = nbq;
            __builtin_amdgcn_sched_barrier(0);
          }
        }
        if (kt * 64 + 63 > q0) {
          const int qpos = q0 + r;
#pragma unroll
          for (int mt = 0; mt < 2; ++mt)
#pragma unroll
            for (int i = 0; i < 16; ++i) { const int key = kt * 64 + mt * 32 + crow(i, h); if (key > qpos) sacc[mt][i] = -INFINITY; }
        }
        float mx = sacc[0][0];
#pragma unroll
        for (int mt = 0; mt < 2; ++mt)
#pragma unroll
          for (int i = 0; i < 16; ++i) mx = fmaxf(mx, sacc[mt][i]);
        mx = fmaxf(mx, __shfl_xor(mx, 32));
        const float m_new = fmaxf(m_run, mx);
        const float alpha = __builtin_amdgcn_exp2f(m_run - m_new);
        m_run = m_new;
        float rs = 0.f;
#pragma unroll
        for (int mt = 0; mt < 2; ++mt)
#pragma unroll
          for (int i = 0; i < 16; ++i) { const float pv = __builtin_amdgcn_exp2f(sacc[mt][i] - m_new); sacc[mt][i] = pv; rs += pv; }
        rs += __shfl_xor(rs, 32);
        l_run = l_run * alpha + rs;
        if (__any(alpha != 1.f)) {
#pragma unroll
          for (int mt = 0; mt < 4; ++mt)
#pragma unroll
            for (int i = 0; i < 16; ++i) oacc[mt][i] *= alpha;
        }
        bf16x8 pf[4];
#pragma unroll
        for (int ks = 0; ks < 4; ++ks) {
          u32x4 o;
          o.x = pack_bf16(sacc[ks >> 1][8 * (ks & 1) + 0], sacc[ks >> 1][8 * (ks & 1) + 1]);
          o.y = pack_bf16(sacc[ks >> 1][8 * (ks & 1) + 2], sacc[ks >> 1][8 * (ks & 1) + 3]);
          o.z = pack_bf16(sacc[ks >> 1][8 * (ks & 1) + 4], sacc[ks >> 1][8 * (ks & 1) + 5]);
          o.w = pack_bf16(sacc[ks >> 1][8 * (ks & 1) + 6], sacc[ks >> 1][8 * (ks & 1) + 7]);
          pf[ks] = __builtin_bit_cast(bf16x8, o);
        }
        const bf16_t* vp = smv + r * VLS + h * 8;
        __builtin_amdgcn_sched_barrier(0);
#pragma unroll
        for (int ks = 0; ks < 4; ++ks) {
          const bf16x8 v0 = *(const bf16x8*)(vp + ks * 16), v1 = *(const bf16x8*)(vp + 32 * VLS + ks * 16);
          const bf16x8 v2 = *(const bf16x8*)(vp + 64 * VLS + ks * 16), v3 = *(const bf16x8*)(vp + 96 * VLS + ks * 16);
          oacc[0] = MFMA(v0, pf[ks], oacc[0]);
          oacc[1] = MFMA(v1, pf[ks], oacc[1]);
          oacc[2] = MFMA(v2, pf[ks], oacc[2]);
          oacc[3] = MFMA(v3, pf[ks], oacc[3]);
          __builtin_amdgcn_sched_barrier(0);
        }
        }
        if (kt + 1 < nkt) ASTORE((kt + 1) & 1);
        __syncthreads();
      }
#undef ALOAD
#undef ASTORE
      const float inv = 1.f / l_run;
      bf16_t* op = obuf + tok * LDH + hd * VH + 4 * h;
#pragma unroll
      for (int mt = 0; mt < 4; ++mt)
#pragma unroll
        for (int a = 0; a < 4; ++a) {
          u32x2 o;
          o.x = pack_bf16(oacc[mt][4 * a] * inv, oacc[mt][4 * a + 1] * inv);
          o.y = pack_bf16(oacc[mt][4 * a + 2] * inv, oacc[mt][4 * a + 3] * inv);
          *(u32x2*)(op + mt * 32 + 8 * a) = o;
        }
      __syncthreads();
    }
  }
}

typedef Cfg<4, 1, 1, 4, 64, 1> CR;

__global__ void __launch_bounds__(512, 2) fwd_megakernel(Params p) {
  cg::grid_group grid = cg::this_grid();
  unsigned char* ws = p.ws;
  const float* x_in = p.in[0];
  const int* positions = (const int*)p.in[1];
  float* out = p.out;
  bf16_t* wgu1 = (bf16_t*)(ws + OFF_WGU1); bf16_t* wdn1 = (bf16_t*)(ws + OFF_WDN1);
  bf16_t* wgu2 = (bf16_t*)(ws + OFF_WGU2); bf16_t* wdn2 = (bf16_t*)(ws + OFF_WDN2);
  bf16_t* wpool = (bf16_t*)(ws + OFF_WPOOL); bf16_t* win = (bf16_t*)(ws + OFF_WIN); bf16_t* wq = (bf16_t*)(ws + OFF_WQ);
  bf16_t* wkv = (bf16_t*)(ws + OFF_WKV); bf16_t* wout = (bf16_t*)(ws + OFF_WOUT);
  float* cosT = (float*)(ws + OFF_COS); float* sinT = (float*)(ws + OFF_SIN);
  float* ssq_all = (float*)(ws + OFF_SSQ);
  float* kpe = (float*)(ws + OFF_KPE);
  bf16_t* hb = (bf16_t*)(ws + OFF_HB);
  bf16_t* act = (bf16_t*)(ws + OFF_ACT); bf16_t* lat = (bf16_t*)(ws + OFF_LAT); bf16_t* qraw = (bf16_t*)(ws + OFF_QRAW);
  bf16_t* kbuf = (bf16_t*)(ws + OFF_K); bf16_t* vtb = (bf16_t*)(ws + OFF_VT);
  bf16_t* obuf = lat; bf16_t* pooled = (bf16_t*)(ws + OFF_POOLED);
  const int gt = blockIdx.x * 512 + threadIdx.x, gs = gridDim.x * 512;
  const int vhalf = __builtin_amdgcn_readfirstlane((int)(threadIdx.x >> 8));
  const int vb = blockIdx.x * 2 + vhalf, nvb = gridDim.x * 2;
  bf16_t* smh = (bf16_t*)(smem + vhalf * VHALF_BYTES);
  float* smf = (float*)(smem + vhalf * VHALF_BYTES);

  unsigned* ctl = (unsigned*)(ws + OFF_CTL);
  if (threadIdx.x == 0) {
    const unsigned xcc = (unsigned)__builtin_amdgcn_s_getreg((3 << 11) | 20) & 0x7u;
    const unsigned rank = atomicAdd(ctl + xcc, 1u);
    ((volatile int*)smem)[0] = (int)xcc; ((volatile int*)smem)[1] = (int)rank;
  }
  __syncthreads();
  int xs = __builtin_amdgcn_readfirstlane(((volatile int*)smem)[0]);
  int js = __builtin_amdgcn_readfirstlane(((volatile int*)smem)[1]);
  __syncthreads();

  for (int idx = gt; idx < T * 32; idx += gs) {
    const int t = idx >> 5, jf = idx & 31;
    const float inv_freq = exp2f(-(float)jf * 0.41524101186092029f);
    const float ang = (float)positions[t] * inv_freq;
    const double rev = (double)ang * 0.15915494309189535;
    const float fr = (float)(rev - rint(rev));
    cosT[idx] = __builtin_amdgcn_cosf(fr);
    sinT[idx] = __builtin_amdgcn_sinf(fr);
  }
  for (int i = gt; i < 15 * T; i += gs) ssq_all[T + i] = 0.f;
  norm0_phase(x_in, hb, ssq_all);
  for (int jl = 0; jl < 2; ++jl) {
    for (int g = 0; g < 4; ++g)
      prep_w(vb, nvb, p.in[7] + ((size_t)jl * 4 + g) * 65536, wpool + ((size_t)jl * 4 + g) * 256 * (256 + PADK), 256, 256, p.in[6] + (size_t)(2 * jl) * D + g * 256, p.in[8] + (size_t)jl * D + g * 256, 0, smf);
    prep_w(vb, nvb, p.in[9] + (size_t)jl * D * 1088, win + (size_t)jl * LATNP * (D + PADK), D, 1088, p.in[6] + (size_t)(2 * jl + 1) * D, nullptr, 0, smf);
    for (int i = gt; i < (LATNP - 1088) * (D + PADK) / 8; i += gs) ((u32x4*)(win + (size_t)jl * LATNP * (D + PADK) + (size_t)1088 * (D + PADK)))[i] = (u32x4){0u, 0u, 0u, 0u};
    prep_w(vb, nvb, p.in[11] + (size_t)jl * QL * 1536, wq + (size_t)jl * 1536 * (QL + PADK), QL, 1536, p.in[10] + (size_t)jl * QL, nullptr, 0, smf);
    prep_w(vb, nvb, p.in[13] + (size_t)jl * KVL * 2048, wkv + (size_t)jl * 2048 * (KVL + PADK), KVL, 2048, p.in[12] + (size_t)jl * KVL, nullptr, 3, smf);
    prep_w(vb, nvb, p.in[16] + (size_t)jl * D * D, wout + (size_t)jl * D * (D + PADK), D, D, nullptr, nullptr, 0, smf);
  }
#define PREP_FFN1(L_) { const size_t wo_ = (size_t)(L_) * D * FF; \
    prep_w(vb, nvb, p.in[3] + wo_, wgu1, D, FF, p.in[2] + (size_t)(L_) * D, nullptr, 1, smf); \
    prep_w(vb, nvb, p.in[4] + wo_, wgu1, D, FF, p.in[2] + (size_t)(L_) * D, nullptr, 2, smf); \
    prep_w(vb, nvb, p.in[5] + wo_, wdn1, FF, D, nullptr, nullptr, 0, smf); }
#define PREP_FFN2(L_) { const size_t wo_ = (size_t)(L_) * D * FF; \
    prep_w(vb, nvb, p.in[18] + wo_, wgu2, D, FF, p.in[17] + (size_t)(L_) * D, nullptr, 1, smf); \
    prep_w(vb, nvb, p.in[19] + wo_, wgu2, D, FF, p.in[17] + (size_t)(L_) * D, nullptr, 2, smf); \
    prep_w(vb, nvb, p.in[20] + wo_, wdn2, FF, D, nullptr, nullptr, 0, smf); }
  PREP_FFN1(0);
  PREP_FFN2(0);
  grid.sync();
  {
    bool even = true;
    for (int i = 0; i < 8; ++i) even = even && (__hip_atomic_load(ctl + i, __ATOMIC_RELAXED, __HIP_MEMORY_SCOPE_AGENT) == (gridDim.x >> 3));
    if (!even || js >= (int)(gridDim.x >> 3)) { xs = blockIdx.x & 7; js = blockIdx.x >> 3; }
  }
  unsigned bar_target = 0;
#define GBAR() { bar_target += gridDim.x; grid_bar(ctl + 32, bar_target); }
  unsigned xbar_target = 0;
#define XBAR() { xbar_target += (gridDim.x >> 3); grid_bar(ctl + 48 + xs, xbar_target); }
  const int jv = js * 2 + vhalf, nbv = (int)(gridDim.x >> 3) * 2;

  for (int layer = 0; layer < DEPTH; ++layer) {
    const float* xcur = (layer == 0) ? x_in : out;
    float* ssq0 = ssq_all + (size_t)(layer * 3 + 0) * T;
    float* ssq1 = ssq_all + (size_t)(layer * 3 + 1) * T;
    float* ssq2 = ssq_all + (size_t)(layer * 3 + 2) * T;
    float* ssq_next = ssq_all + (size_t)((layer + 1) * 3) * T;
    const int jl = layer >> 1;
    float* ssq_q = ssq_all + (size_t)(12 + jl) * T;
    float* ssq_kv = ssq_all + (size_t)(14 + jl) * T;
    if (layer > 0) PREP_FFN2(layer);
    gemm8_phase(xs, js, hb, LDH, wgu1, D, 2 * FF, 0, EpiGU8{act, ssq0});
    XBAR();
    gemm8_phase(xs, js, act, LDA, wdn1, FF, D, 0, EpiResid8{xcur, out, 0.5f, hb, ssq1});
    GBAR();
    if (layer + 1 < DEPTH) PREP_FFN1(layer + 1);
    if ((layer & 1) == 0) {
      poolprep_phase(vb, nvb, out, ssq1, pooled, smf);
      GBAR();
      gemm8_phase(xs, js, pooled, LDH, wpool + (size_t)jl * 1024 * (256 + PADK), 256, D, 256, EpiResid8{out, out, 1.0f, hb, ssq2});
      GBAR();
    } else {
      gemm8_phase(xs, js, hb, LDH, win + (size_t)jl * LATNP * (D + PADK), D, LATNP, 0, EpiLat8{lat, kpe, ssq_q, ssq_kv, ssq1});
      GBAR();
      gemm8_phase(xs, js, lat, LDH, wq + (size_t)jl * 1536 * (QL + PADK), QL, 1536, 0, EpiQraw8{qraw, ssq_q});
      gemm_phase<CR>(xs, jv, nbv, lat + QL, LDH, wkv + (size_t)jl * 2048 * (KVL + PADK), KVL, 2048, 0, EpiKV{ssq_kv, kpe, p.in[15] + (size_t)jl * QKH, cosT, sinT, kbuf, vtb}, smh);
      GBAR();
      attn_phase(qraw, kbuf, vtb, obuf, p.in[14] + (size_t)jl * QKH, cosT, sinT, (bf16_t*)smem, xs, js);
      GBAR();
      gemm8_phase(xs, js, obuf, LDH, wout + (size_t)jl * D * (D + PADK), D, D, 0, EpiResid8{out, out, 1.0f, hb, ssq2});
      GBAR();
    }
    gemm8_phase(xs, js, hb, LDH, wgu2, D, 2 * FF, 0, EpiGU8{act, ssq2});
    XBAR();
    const bool last = (layer + 1 == DEPTH);
    gemm8_phase(xs, js, act, LDA, wdn2, FF, D, 0, EpiResid8{out, out, 0.5f, last ? nullptr : hb, last ? nullptr : ssq_next});
    if (!last) GBAR();
  }
}

extern "C" void kernel_launch(void* const* d_in, const int* in_sizes, int n_in, void* d_out, int out_size, void* d_ws, size_t ws_size, hipStream_t stream) {
  static int grid_blocks = 0;
  if (!grid_blocks) {
    int dev = 0, cus = 0, per_cu = 0;
    (void)hipGetDevice(&dev);
    (void)hipDeviceGetAttribute(&cus, hipDeviceAttributeMultiprocessorCount, dev);
    (void)hipFuncSetAttribute((const void*)fwd_megakernel, hipFuncAttributeMaxDynamicSharedMemorySize, LDS_BYTES);
    (void)hipOccupancyMaxActiveBlocksPerMultiprocessor(&per_cu, fwd_megakernel, 512, LDS_BYTES);
    grid_blocks = cus;
    if (n_in != 21 || out_size != T * D || ws_size < WS_TOTAL || per_cu < 1) fprintf(stderr, "kernel_launch: unexpected n_in=%d out=%d ws=%zu (need %zu) per_cu=%d\n", n_in, out_size, ws_size, (size_t)WS_TOTAL, per_cu);
  }
  Params p{};
  for (int i = 0; i < 21; ++i) p.in[i] = (const float*)d_in[i];
  p.out = (float*)d_out; p.ws = (unsigned char*)d_ws;
  (void)hipMemsetAsync((unsigned char*)d_ws + OFF_CTL, 0, 256, stream);
  void* args[] = {&p};
  hipError_t e = hipLaunchCooperativeKernel((void*)fwd_megakernel, dim3(grid_blocks), dim3(512), args, LDS_BYTES, stream);
  if (e != hipSuccess) fprintf(stderr, "cooperative launch failed: %s (grid %d)\n", hipGetErrorString(e), grid_blocks);
}
```

```cpp
#include <hip/hip_runtime.h>
#include <hip/hip_cooperative_groups.h>
#include <cstdio>
#include <cstdint>
namespace cg = cooperative_groups;

#define DI __device__ __forceinline__
typedef unsigned short bf16_t;
typedef short bf16x8 __attribute__((ext_vector_type(8)));
typedef float f32x16 __attribute__((ext_vector_type(16)));
typedef float f32x4 __attribute__((ext_vector_type(4)));
typedef float f32x2 __attribute__((ext_vector_type(2)));
typedef unsigned u32x4 __attribute__((ext_vector_type(4)));
typedef unsigned u32x2 __attribute__((ext_vector_type(2)));
typedef __bf16 bf16v2 __attribute__((ext_vector_type(2)));

constexpr int NB = 2, S = 16384, T = NB * S, D = 1024, FF = 2816, NH = 8, DEPTH = 4;
constexpr int QL = 768, KVL = 256, QKH = 192, VH = 128;
constexpr int LATNP = 1280;
constexpr int LDH = D + 64;
constexpr int LDA = FF + 64;
constexpr int SV = S + 64;
constexpr int PADK = 64;
constexpr float EPS = 1e-6f;

constexpr size_t SZ_WGU = (size_t)2 * FF * (D + PADK) * 2, SZ_WDN = (size_t)D * (FF + PADK) * 2;
constexpr size_t OFF_WGU1 = 0, OFF_WDN1 = OFF_WGU1 + SZ_WGU, OFF_WGU2 = OFF_WDN1 + SZ_WDN, OFF_WDN2 = OFF_WGU2 + SZ_WGU;
constexpr size_t SZ_WPOOL = (size_t)1024 * (256 + PADK) * 2, SZ_WIN = (size_t)LATNP * (D + PADK) * 2, SZ_WQ = (size_t)1536 * (QL + PADK) * 2;
constexpr size_t SZ_WKV = (size_t)2048 * (KVL + PADK) * 2, SZ_WOUT = (size_t)D * (D + PADK) * 2;
constexpr size_t OFF_WPOOL = OFF_WDN2 + SZ_WDN;
constexpr size_t OFF_WIN = OFF_WPOOL + 2 * SZ_WPOOL;
constexpr size_t OFF_WQ = OFF_WIN + 2 * SZ_WIN;
constexpr size_t OFF_WKV = OFF_WQ + 2 * SZ_WQ;
constexpr size_t OFF_WOUT = OFF_WKV + 2 * SZ_WKV;
constexpr size_t OFF_COS = OFF_WOUT + 2 * SZ_WOUT;
constexpr size_t OFF_SIN = OFF_COS + (size_t)T * 32 * 4;
constexpr size_t OFF_SSQ = OFF_SIN + (size_t)T * 32 * 4;
constexpr size_t OFF_KPE = OFF_SSQ + (size_t)16 * T * 4;
constexpr size_t OFF_HB = OFF_KPE + (size_t)T * 64 * 4;
constexpr size_t OFF_BIG = OFF_HB + (size_t)T * LDH * 2;
constexpr size_t OFF_ACT = OFF_BIG;
constexpr size_t OFF_LAT = OFF_BIG;
constexpr size_t OFF_POOLED = OFF_BIG;
constexpr size_t OFF_QRAW = OFF_LAT + (size_t)T * LDH * 2;
constexpr size_t OFF_K = OFF_QRAW + (size_t)T * 1536 * 2;
constexpr size_t OFF_VT = OFF_K + (size_t)T * NH * QKH * 2;
constexpr size_t WS_END = OFF_VT + (size_t)NB * NH * VH * SV * 2;
static_assert(OFF_ACT + (size_t)T * LDA * 2 <= WS_END, "act must fit in the big region");
constexpr size_t OFF_CTL = WS_END;
constexpr size_t WS_TOTAL = OFF_CTL + 256;
static_assert(WS_TOTAL <= (size_t)536870912, "workspace budget (4 x largest tensor)");
constexpr int LDS_BYTES = 131072;
constexpr int VHALF_BYTES = 36864;

struct Params { const float* in[21]; float* out; unsigned char* ws; };
extern __shared__ __attribute__((aligned(1024))) unsigned char smem[];

DI unsigned pack_bf16(float lo, float hi) { f32x2 v = {lo, hi}; bf16v2 b = __builtin_convertvector(v, bf16v2); return __builtin_bit_cast(unsigned, b); }
DI bf16_t to_bf16(float x) { return (bf16_t)(pack_bf16(x, 0.f) & 0xffffu); }
DI float bf2f(short v) { return __uint_as_float(((unsigned)(unsigned short)v) << 16); }
DI int crow(int i, int h) { return (i & 3) + 8 * (i >> 2) + 4 * h; }
DI float red32(float v) { v += __shfl_xor(v, 1); v += __shfl_xor(v, 2); v += __shfl_xor(v, 4); v += __shfl_xor(v, 8); v += __shfl_xor(v, 16); return v; }
DI float red64(float v) { v = red32(v); v += __shfl_xor(v, 32); return v; }
DI int opaque_tid() { int t = threadIdx.x & 255; asm volatile("" : "+v"(t)); return t; }
DI int opaque_tid512() { int t = threadIdx.x; asm volatile("" : "+v"(t)); return t; }
#define MFMA(a, b, c) __builtin_amdgcn_mfma_f32_32x32x16_bf16((a), (b), (c), 0, 0, 0)
DI void grid_bar(unsigned* ctr, unsigned target) {
  asm volatile("s_waitcnt vmcnt(0)" ::: "memory");
  __syncthreads();
  if (threadIdx.x == 0) {
    __builtin_amdgcn_fence(__ATOMIC_RELEASE, "agent");
    asm volatile("s_waitcnt vmcnt(0)" ::: "memory");
    (void)__hip_atomic_fetch_add(ctr, 1u, __ATOMIC_RELAXED, __HIP_MEMORY_SCOPE_AGENT);
    while (__hip_atomic_load(ctr, __ATOMIC_RELAXED, __HIP_MEMORY_SCOPE_AGENT) < target) __builtin_amdgcn_s_sleep(1);
    __builtin_amdgcn_fence(__ATOMIC_ACQUIRE, "agent");
    asm volatile("s_waitcnt vmcnt(0)" ::: "memory");
  }
  __syncthreads();
}

DI void prep_w(int vb, int nvb, const float* __restrict__ W, bf16_t* __restrict__ Wt, int K, int N, const float* __restrict__ gk, const float* __restrict__ sn, int mode, float* smf) {
  const int ldt = K + PADK;
  const int tid = opaque_tid();
  const int ntn = N / 64, nt = (K / 64) * ntn;
  for (int t0 = 0; t0 < nt; t0 += nvb) {
    const int t = t0 + vb;
    const bool on = t < nt;
    const int k0 = (t / ntn) * 64, n0 = (t % ntn) * 64;
    if (on) {
#pragma unroll
      for (int i = 0; i < 16; ++i) {
        const int kk = i * 4 + (tid >> 6), nn = tid & 63;
        float v = __builtin_nontemporal_load(W + (size_t)(k0 + kk) * N + n0 + nn);
        if (gk) v *= gk[k0 + kk];
        if (sn) v *= sn[n0 + nn];
        smf[kk * 65 + nn] = v;
      }
    }
    __syncthreads();
    if (on) {
      const int nl = tid >> 2, kq = (tid & 3) * 16;
      u32x4 p0, p1;
      p0.x = pack_bf16(smf[(kq + 0) * 65 + nl], smf[(kq + 1) * 65 + nl]);
      p0.y = pack_bf16(smf[(kq + 2) * 65 + nl], smf[(kq + 3) * 65 + nl]);
      p0.z = pack_bf16(smf[(kq + 4) * 65 + nl], smf[(kq + 5) * 65 + nl]);
      p0.w = pack_bf16(smf[(kq + 6) * 65 + nl], smf[(kq + 7) * 65 + nl]);
      p1.x = pack_bf16(smf[(kq + 8) * 65 + nl], smf[(kq + 9) * 65 + nl]);
      p1.y = pack_bf16(smf[(kq + 10) * 65 + nl], smf[(kq + 11) * 65 + nl]);
      p1.z = pack_bf16(smf[(kq + 12) * 65 + nl], smf[(kq + 13) * 65 + nl]);
      p1.w = pack_bf16(smf[(kq + 14) * 65 + nl], smf[(kq + 15) * 65 + nl]);
      const int n = n0 + nl;
      int row = n;
      if (mode == 1) row = (n >> 4) * 32 + (n & 15);
      else if (mode == 2) row = (n >> 4) * 32 + 16 + (n & 15);
      else if (mode == 3) { const int hd = n >> 8, j = n & 255; row = (j < 128) ? (hd * 128 + j) : (1024 + hd * 128 + (j - 128)); }
      u32x4* dst = (u32x4*)(Wt + (size_t)row * ldt + k0 + kq);
      dst[0] = p0; dst[1] = p1;
    }
    __syncthreads();
  }
}

template <int WM_, int WN_, int MI_, int NI_, int BK_, int ST_>
struct Cfg {
  static constexpr int WM = WM_, WN = WN_, MI = MI_, NI = NI_, BK = BK_, ST = ST_;
  static constexpr int BM = WM * MI * 32, BN = WN * NI * 32;
  static constexpr int LS = BK + 8;
  static constexpr int A_EL = BM * LS, B_EL = BN * LS, STAGE_EL = A_EL + B_EL;
  static constexpr int CPR = BK / 8;
  static constexpr int A_CH = BM * CPR / 256, B_CH = BN * CPR / 256;
  static_assert(WM * WN == 4, "4 waves");
  static_assert(ST * STAGE_EL * 2 <= VHALF_BYTES, "LDS of a virtual half-block");
};

template <class C, class Epi>
DI void gemm_tile(const bf16_t* __restrict__ A, int lda, const bf16_t* __restrict__ Bt, int K, int m0, int n0, const Epi& epi, bf16_t* sm) {
  const int tid = opaque_tid(), lane = tid & 63, wave = tid >> 6, r = lane & 31, h = lane >> 5;
  const int wm = wave / C::WN, wn = wave % C::WN;
  f32x16 acc[C::MI][C::NI];
#pragma unroll
  for (int mi = 0; mi < C::MI; ++mi)
#pragma unroll
    for (int ni = 0; ni < C::NI; ++ni)
#pragma unroll
      for (int i = 0; i < 16; ++i) acc[mi][ni][i] = 0.f;
  const bf16_t* Ag = A + (size_t)m0 * lda;
  const int ldb = K + PADK;
  const bf16_t* Bg = Bt + (size_t)n0 * ldb;
  u32x4 ra[C::A_CH], rb[C::B_CH];
  const int nk = K / C::BK;
  constexpr int RPP = 256 / C::CPR;
  const unsigned a_off = (unsigned)(tid / C::CPR) * (unsigned)lda + (unsigned)(tid % C::CPR) * 8u;
  const unsigned b_off = (unsigned)(tid / C::CPR) * (unsigned)ldb + (unsigned)(tid % C::CPR) * 8u;
  const unsigned l_off = (unsigned)(tid / C::CPR) * C::LS + (unsigned)(tid % C::CPR) * 8u;
#define GLOAD(k0_)                                                                                   \
  {                                                                                                  \
    const bf16_t* ag_ = Ag + (k0_); const bf16_t* bg_ = Bg + (k0_);                                  \
    _Pragma("unroll") for (int i = 0; i < C::A_CH; ++i) ra[i] = *(const u32x4*)(ag_ + (a_off + (unsigned)(i * RPP) * (unsigned)lda)); \
    _Pragma("unroll") for (int i = 0; i < C::B_CH; ++i) rb[i] = *(const u32x4*)(bg_ + (b_off + (unsigned)(i * RPP) * (unsigned)ldb));   \
  }
#define LSTORE(buf_)                                                                                 \
  {                                                                                                  \
    bf16_t* sa_ = sm + (buf_) * C::STAGE_EL + l_off; bf16_t* sb_ = sa_ + C::A_EL;                    \
    _Pragma("unroll") for (int i = 0; i < C::A_CH; ++i) *(u32x4*)(sa_ + i * RPP * C::LS) = ra[i];   \
    _Pragma("unroll") for (int i = 0; i < C::B_CH; ++i) *(u32x4*)(sb_ + i * RPP * C::LS) = rb[i];   \
  }
  GLOAD(0);
  if (C::ST == 2) {
    LSTORE(0);
    __syncthreads();
  }
  for (int kt = 0; kt < nk; ++kt) {
    const int buf = (C::ST == 2) ? (kt & 1) : 0;
    if (C::ST == 1) {
      __syncthreads();
      LSTORE(0);
      __syncthreads();
    }
    if (kt + 1 < nk) GLOAD((kt + 1) * C::BK);
    __builtin_amdgcn_sched_barrier(0);
    const bf16_t* sa = sm + buf * C::STAGE_EL + (wm * C::MI * 32 + r) * C::LS + h * 8;
    const bf16_t* sb = sm + buf * C::STAGE_EL + C::A_EL + (wn * C::NI * 32 + r) * C::LS + h * 8;
#pragma unroll
    for (int ks = 0; ks < C::BK / 16; ++ks) {
      bf16x8 af[C::MI], bfr[C::NI];
#pragma unroll
      for (int mi = 0; mi < C::MI; ++mi) af[mi] = *(const bf16x8*)(sa + mi * 32 * C::LS + ks * 16);
#pragma unroll
      for (int ni = 0; ni < C::NI; ++ni) bfr[ni] = *(const bf16x8*)(sb + ni * 32 * C::LS + ks * 16);
#pragma unroll
      for (int mi = 0; mi < C::MI; ++mi)
#pragma unroll
        for (int ni = 0; ni < C::NI; ++ni) acc[mi][ni] = MFMA(af[mi], bfr[ni], acc[mi][ni]);
    }
    if (C::ST == 2) {
      if (kt + 1 < nk) LSTORE((kt + 1) & 1);
      __syncthreads();
    }
  }
  if (C::ST == 1) __syncthreads();
#undef GLOAD
#undef LSTORE
  epi.template run<C::MI, C::NI>(acc, m0 + wm * C::MI * 32, n0 + wn * C::NI * 32, r, h);
}

template <class C, class Epi>
DI void gemm_phase(int x, int j, int nb, const bf16_t* __restrict__ A, int lda, const bf16_t* __restrict__ Bt, int K, int N, int a_grp, const Epi& epi, bf16_t* sm) {
  static_assert(C::BM == 128 && (C::BN == 128 || C::BN == 256), "tile");
  constexpr int GN = (C::BN == 256) ? 4 : 8;
  const int nN = N / C::BN;
  const int total = 32 * nN;
  for (int u = j; u < total; u += nb) {
    const int ng = u / (32 * GN), rem = u % (32 * GN);
    int gn = nN - GN * ng; if (gn > GN) gn = GN;
    const int mg = rem / (8 * gn), jj = rem % (8 * gn);
    const int mt = 32 * x + 8 * mg + (jj & 7), nt = GN * ng + (jj >> 3);
    const int n0 = nt * C::BN;
    const bf16_t* Ap = a_grp ? (A + (n0 / a_grp) * K) : A;
    gemm_tile<C, Epi>(Ap, lda, Bt, K, mt * 128, n0, epi, sm);
  }
}

struct EpiGU {
  bf16_t* act; const float* ssq;
  template <int MI, int NI> DI void run(f32x16 (&acc)[MI][NI], int mb, int nb, int r, int h) const {
    static_assert((NI & 1) == 0, "gate/up pairs");
#pragma unroll
    for (int mi = 0; mi < MI; ++mi)
#pragma unroll
      for (int i = 0; i < 16; ++i) {
        const int row = mb + mi * 32 + crow(i, h);
        const float rs = rsqrtf(ssq[row] * (1.f / D) + EPS);
#pragma unroll
        for (int pi = 0; pi < NI / 2; ++pi) {
          const float g = acc[mi][2 * pi][i] * rs, u = acc[mi][2 * pi + 1][i] * rs;
          const float a = g / (1.f + __expf(-g)) * u;
          act[(size_t)row * LDA + (nb >> 1) + pi * 32 + r] = to_bf16(a);
        }
      }
  }
};
struct EpiResid {
  const float* xin; float* xout; float scale; bf16_t* xb; float* ssq;
  template <int MI, int NI> DI void run(f32x16 (&acc)[MI][NI], int mb, int nb, int r, int h) const {
#pragma unroll
    for (int mi = 0; mi < MI; ++mi)
#pragma unroll
      for (int hf = 0; hf < 2; ++hf) {
        float xv[8][NI];
#pragma unroll
        for (int i = 0; i < 8; ++i)
#pragma unroll
          for (int ni = 0; ni < NI; ++ni) xv[i][ni] = xin[(size_t)(mb + mi * 32 + crow(hf * 8 + i, h)) * D + nb + ni * 32 + r];
        __builtin_amdgcn_sched_barrier(0);
        float ssv[8];
#pragma unroll
        for (int i = 0; i < 8; ++i) {
          const int row = mb + mi * 32 + crow(hf * 8 + i, h);
          float ss = 0.f;
#pragma unroll
          for (int ni = 0; ni < NI; ++ni) {
            const float v = xv[i][ni] + scale * acc[mi][ni][hf * 8 + i];
            xout[(size_t)row * D + nb + ni * 32 + r] = v;
            if (xb) { xb[(size_t)row * LDH + nb + ni * 32 + r] = to_bf16(v); ss += v * v; }
          }
          ssv[i] = ss;
        }
        if (xb) {
#pragma unroll
          for (int i = 0; i < 8; ++i) { const float t = red32(ssv[i]); if (r == 0) atomicAdd(ssq + mb + mi * 32 + crow(hf * 8 + i, h), t); }
        }
        __builtin_amdgcn_sched_barrier(0);
      }
  }
};
struct EpiLat {
  bf16_t* lat; float* kpe; float* ssq_q; float* ssq_kv; const float* ssq_x;
  template <int MI, int NI> DI void run(f32x16 (&acc)[MI][NI], int mb, int nb, int r, int h) const {
    if (nb >= 1088) return;
    float* ssq = (nb < QL) ? ssq_q : ssq_kv;
#pragma unroll
    for (int mi = 0; mi < MI; ++mi) {
      float rsv[16];
#pragma unroll
      for (int i = 0; i < 16; ++i) rsv[i] = rsqrtf(ssq_x[mb + mi * 32 + crow(i, h)] * (1.f / D) + EPS);
      __builtin_amdgcn_sched_barrier(0);
      if (nb >= 1024) {
#pragma unroll
        for (int i = 0; i < 16; ++i)
#pragma unroll
          for (int ni = 0; ni < NI; ++ni) kpe[(size_t)(mb + mi * 32 + crow(i, h)) * 64 + (nb - 1024) + ni * 32 + r] = acc[mi][ni][i] * rsv[i];
      } else {
        float ssv[16];
#pragma unroll
        for (int i = 0; i < 16; ++i) {
          const int row = mb + mi * 32 + crow(i, h);
          float ss = 0.f;
#pragma unroll
          for (int ni = 0; ni < NI; ++ni) { const float v = acc[mi][ni][i] * rsv[i]; ss += v * v; lat[(size_t)row * LDH + nb + ni * 32 + r] = to_bf16(v); }
          ssv[i] = ss;
        }
#pragma unroll
        for (int i = 0; i < 16; ++i) { const float t = red32(ssv[i]); if (r == 0) atomicAdd(ssq + mb + mi * 32 + crow(i, h), t); }
      }
    }
  }
};
struct EpiQraw {
  bf16_t* q; const float* ssq_q;
  template <int MI, int NI> DI void run(f32x16 (&acc)[MI][NI], int mb, int nb, int r, int h) const {
#pragma unroll
    for (int mi = 0; mi < MI; ++mi)
#pragma unroll
      for (int i = 0; i < 16; ++i) {
        const int row = mb + mi * 32 + crow(i, h);
        const float rs = rsqrtf(ssq_q[row] * (1.f / QL) + EPS);
#pragma unroll
        for (int ni = 0; ni < NI; ++ni) q[(size_t)row * 1536 + nb + ni * 32 + r] = to_bf16(acc[mi][ni][i] * rs);
      }
  }
};
struct EpiKV {
  const float* ssq_kv; const float* kpe; const float* gk; const float* cosT; const float* sinT; bf16_t* kout; bf16_t* vt;
  template <int MI, int NI> DI void run(f32x16 (&acc)[MI][NI], int mb, int nb, int r, int h) const {
    static_assert(MI == 1 && NI == 4, "kv epilogue layout");
    const int b = mb / S, sb = mb % S;
    if (nb < 1024) {
      const int head = nb >> 7;
      const float g0 = gk[r], g1 = gk[32 + r], g2 = gk[64 + r], g3 = gk[96 + r], g4 = gk[128 + r], g5 = gk[160 + r];
#pragma unroll
      for (int i = 0; i < 16; ++i) {
        const int rw = crow(i, h), tok = mb + rw;
        const float rkv = rsqrtf(ssq_kv[tok] * (1.f / KVL) + EPS);
        const float v0 = acc[0][0][i] * rkv, v1 = acc[0][1][i] * rkv, v2 = acc[0][2][i] * rkv, v3 = acc[0][3][i] * rkv;
        const float p1 = kpe[(size_t)tok * 64 + r], p2 = kpe[(size_t)tok * 64 + 32 + r];
        float ss = v0 * v0 + v1 * v1 + v2 * v2 + v3 * v3 + p1 * p1 + p2 * p2;
        ss = red32(ss);
        const float rk = rsqrtf(ss * (1.f / QKH) + EPS);
        bf16_t* kr = kout + ((size_t)(b * NH + head) * S + sb + rw) * QKH;
        kr[r] = to_bf16(v0 * rk * g0); kr[32 + r] = to_bf16(v1 * rk * g1); kr[64 + r] = to_bf16(v2 * rk * g2); kr[96 + r] = to_bf16(v3 * rk * g3);
        const float c = cosT[(size_t)tok * 32 + r], sn = sinT[(size_t)tok * 32 + r];
        const float x1 = p1 * rk * g4, x2 = p2 * rk * g5;
        kr[128 + r] = to_bf16(x1 * c - x2 * sn); kr[160 + r] = to_bf16(x2 * c + x1 * sn);
      }
    } else {
      const int head = (nb - 1024) >> 7;
      float rkv[16];
#pragma unroll
      for (int i = 0; i < 16; ++i) rkv[i] = rsqrtf(ssq_kv[mb + crow(i, h)] * (1.f / KVL) + EPS);
#pragma unroll
      for (int ni = 0; ni < 4; ++ni) {
        bf16_t* vr = vt + ((size_t)(b * NH + head) * VH + ni * 32 + r) * SV + sb;
#pragma unroll
        for (int a = 0; a < 4; ++a) {
          u32x2 o;
          o.x = pack_bf16(acc[0][ni][4 * a] * rkv[4 * a], acc[0][ni][4 * a + 1] * rkv[4 * a + 1]);
          o.y = pack_bf16(acc[0][ni][4 * a + 2] * rkv[4 * a + 2], acc[0][ni][4 * a + 3] * rkv[4 * a + 3]);
          *(u32x2*)(vr + 16 * (a >> 1) + 8 * h + 4 * (a & 1)) = o;
        }
      }
    }
  }
};


DI int lds_byte2(int r, int c) { const int st = (r >> 4) * 2 + (c >> 5), ob = (r & 15) * 64 + (c & 31) * 2; return st * 1024 + (ob ^ (((ob >> 9) & 1) << 5)); }
DI void stage_rc2(int b, int& R, int& C) { const int st = b >> 10, sb = b & 1023, swz = sb ^ (((sb >> 9) & 1) << 5); R = (st >> 1) * 16 + swz / 64; C = (st & 1) * 32 + (swz % 64) / 2; }
#define MFMA16(a, b, c) __builtin_amdgcn_mfma_f32_16x16x32_bf16((a), (b), (c), 0, 0, 0)
constexpr int G8_TILE_B = 256 * 64 * 2, G8_STAGE_B = 2 * G8_TILE_B;

template <class Epi>
DI void gemm8_tile(const bf16_t* __restrict__ Ab, int lda, const bf16_t* __restrict__ Bb, int ldb, int K, int brow, int bcol, const Epi epi,
                   bool staged, bool has_next, const bf16_t* __restrict__ Abn, const bf16_t* __restrict__ Bbn) {
  const int tid = opaque_tid512(), wid = tid >> 6, lane = tid & 63, wr = wid >> 2, wc = wid & 3, fr = lane & 15, fq = lane >> 4;
  unsigned aoff[4], boff[4];
#pragma unroll
  for (int i = 0; i < 4; ++i) { int R, C; stage_rc2(wid * 1024 + i * 8192 + lane * 16, R, C); aoff[i] = (unsigned)R * (unsigned)lda + (unsigned)C; boff[i] = (unsigned)R * (unsigned)ldb + (unsigned)C; }
#define G8_STAGE_R(buf_, ap_, bp_, i0_, i1_)                                                                         \
  {                                                                                                                  \
    const bf16_t* ag_ = (ap_); const bf16_t* bg_ = (bp_);                                                            \
    _Pragma("unroll") for (int i = (i0_); i < (i1_); ++i) {                                                          \
      __builtin_amdgcn_global_load_lds((const unsigned*)(ag_ + aoff[i]), (unsigned*)(smem + (buf_) * G8_STAGE_B + wid * 1024 + i * 8192), 16, 0, 0);              \
      __builtin_amdgcn_global_load_lds((const unsigned*)(bg_ + boff[i]), (unsigned*)(smem + (buf_) * G8_STAGE_B + G8_TILE_B + wid * 1024 + i * 8192), 16, 0, 0);  \
    }                                                                                                                \
  }
#define G8_STAGE(buf_, ap_, bp_) G8_STAGE_R(buf_, ap_, bp_, 0, 4)
  f32x4 acc[8][4];
#pragma unroll
  for (int m = 0; m < 8; ++m)
#pragma unroll
    for (int n = 0; n < 4; ++n) acc[m][n] = (f32x4){0.f, 0.f, 0.f, 0.f};
  const int nt = K / 64;
  if (!staged) {
    G8_STAGE(0, Ab, Bb);
    asm volatile("s_waitcnt vmcnt(0)" ::: "memory");
    __syncthreads();
  }
  for (int t = 0; t < nt; ++t) {
    const int cur = t & 1;
    const unsigned char* sa = smem + cur * G8_STAGE_B;
    const unsigned char* sb = sa + G8_TILE_B;
#pragma unroll
    for (int ks = 0; ks < 2; ++ks) {
      bf16x8 At[8], Bf[4];
#pragma unroll
      for (int m = 0; m < 8; ++m) At[m] = *(const bf16x8*)(sa + lds_byte2(wr * 128 + m * 16 + fr, ks * 32 + fq * 8));
#pragma unroll
      for (int n = 0; n < 4; ++n) Bf[n] = *(const bf16x8*)(sb + lds_byte2(wc * 64 + n * 16 + fr, ks * 32 + fq * 8));
      {
        __builtin_amdgcn_sched_barrier(0);
        if (t + 1 < nt) { G8_STAGE_R(cur ^ 1, Ab + (t + 1) * 64, Bb + (t + 1) * 64, 2 * ks, 2 * ks + 2); }
        else if (has_next) { G8_STAGE_R(0, Abn, Bbn, 2 * ks, 2 * ks + 2); }
        __builtin_amdgcn_sched_barrier(0);
      }
#pragma unroll
      for (int m = 0; m < 8; ++m)
#pragma unroll
        for (int n = 0; n < 4; ++n) acc[m][n] = MFMA16(At[m], Bf[n], acc[m][n]);
      __builtin_amdgcn_sched_barrier(0);
    }
    asm volatile("s_waitcnt vmcnt(0)" ::: "memory");
    __syncthreads();
  }
#undef G8_STAGE
#undef G8_STAGE_R
  epi.run8(acc, brow + wr * 128, bcol + wc * 64, fr, fq);
  if (Epi::LDS_SCRATCH) __syncthreads();
}

DI void g8_decode(int u, int x, int nN, int& pm, int& pn) {
  const int ng = u >> 6, rem = u & 63;
  int gn = nN - 4 * ng; if (gn > 4) gn = 4;
  const int mg = rem / (8 * gn), jj = rem % (8 * gn);
  pm = 16 * x + 8 * mg + (jj & 7); pn = 4 * ng + (jj >> 3);
}
template <class Epi>
DI void gemm8_phase(int x, int j, const bf16_t* __restrict__ A, int lda, const bf16_t* __restrict__ Bt, int K, int N, int a_grp, const Epi epi) {
  const int nN = N / 256, nb = gridDim.x >> 3, ldb = K + PADK;
  const int total = 16 * nN;
  bool staged = false;
  for (int u = j; u < total; u += nb) {
    int pm, pn; g8_decode(u, x, nN, pm, pn);
    const int brow = pm * 256, bcol = pn * 256;
    const bf16_t* Ab = A + (size_t)brow * lda + (a_grp ? (bcol / a_grp) * K : 0);
    const bf16_t* Bb = Bt + (size_t)bcol * ldb;
    const bool has_next = (u + nb < total);
    const bf16_t* Abn = Ab; const bf16_t* Bbn = Bb;
    if (has_next) {
      int pm2, pn2; g8_decode(u + nb, x, nN, pm2, pn2);
      Abn = A + (size_t)(pm2 * 256) * lda + (a_grp ? ((pn2 * 256) / a_grp) * K : 0);
      Bbn = Bt + (size_t)(pn2 * 256) * ldb;
    }
    gemm8_tile<Epi>(Ab, lda, Bb, ldb, K, brow, bcol, epi, staged, has_next, Abn, Bbn);
    staged = has_next;
  }
}
DI float red16(float v) { v += __shfl_xor(v, 1); v += __shfl_xor(v, 2); v += __shfl_xor(v, 4); v += __shfl_xor(v, 8); return v; }

struct EpiGU8 {
  static constexpr bool LDS_SCRATCH = true;
  bf16_t* act; const float* ssq;
  DI void run8(f32x4 (&acc)[8][4], int rb, int cb, int fr, int fq) const {
    const int lane = fq * 16 + fr, wid = (int)(threadIdx.x >> 6);
    bf16_t* scr = (bf16_t*)(smem + G8_STAGE_B + wid * 1280);
    const int srow = lane >> 2, sch = lane & 3;
    bf16_t* ap = act + (size_t)(rb + srow) * LDA + (cb >> 1) + sch * 8;
    float rsv[8][4];
#pragma unroll
    for (int m = 0; m < 8; ++m)
#pragma unroll
      for (int j = 0; j < 4; ++j) rsv[m][j] = rsqrtf(ssq[rb + m * 16 + fq * 4 + j] * (1.f / D) + EPS);
#pragma unroll
    for (int m = 0; m < 8; ++m) {
#pragma unroll
      for (int j = 0; j < 4; ++j)
#pragma unroll
        for (int pi = 0; pi < 2; ++pi) {
          const float g = acc[m][2 * pi][j] * rsv[m][j], u = acc[m][2 * pi + 1][j] * rsv[m][j];
          const float a = g * __builtin_amdgcn_rcpf(1.f + __expf(-g)) * u;
          scr[(fq * 4 + j) * 40 + pi * 16 + fr] = to_bf16(a);
        }
      __builtin_amdgcn_sched_barrier(0);
      const u32x4 o = *(const u32x4*)(scr + srow * 40 + sch * 8);
      *(u32x4*)(ap + (size_t)(m * 16) * LDA) = o;
      __builtin_amdgcn_sched_barrier(0);
    }
  }
};
struct EpiResid8 {
  static constexpr bool LDS_SCRATCH = true;
  const float* xin; float* xout; float scale; bf16_t* xb; float* ssq;
  DI void run8(f32x4 (&acc)[8][4], int rb, int cb, int fr, int fq) const {
    const int lane = fq * 16 + fr, wid = (int)(threadIdx.x >> 6);
    const float sc = scale; bf16_t* const xbp = xb; float* const ssqp = ssq;
    float* scr = (float*)(smem + G8_STAGE_B + wid * 4352);
    const int prow = lane >> 4, c4 = lane & 15;
    const float* xp = xin + (size_t)(rb + prow) * D + cb + c4 * 4;
    float* op = xout + (size_t)(rb + prow) * D + cb + c4 * 4;
#pragma unroll
    for (int mh = 0; mh < 2; ++mh) {
      f32x4 xv[4][4];
#pragma unroll
      for (int mm = 0; mm < 4; ++mm)
#pragma unroll
        for (int ps = 0; ps < 4; ++ps) xv[mm][ps] = __builtin_nontemporal_load((const f32x4*)(xp + (size_t)((mh * 4 + mm) * 16 + ps * 4) * D));
      __builtin_amdgcn_sched_barrier(0);
#pragma unroll
      for (int mm = 0; mm < 4; ++mm) {
        const int m = mh * 4 + mm;
#pragma unroll
        for (int n = 0; n < 4; ++n)
#pragma unroll
          for (int j = 0; j < 4; ++j) scr[(fq * 4 + j) * 68 + n * 16 + fr] = acc[m][n][j];
        __builtin_amdgcn_sched_barrier(0);
#pragma unroll
        for (int ps = 0; ps < 4; ++ps) {
          const f32x4 a = *(const f32x4*)(scr + (ps * 4 + prow) * 68 + c4 * 4);
          f32x4 v;
          v.x = xv[mm][ps].x + a.x * sc; v.y = xv[mm][ps].y + a.y * sc; v.z = xv[mm][ps].z + a.z * sc; v.w = xv[mm][ps].w + a.w * sc;
          const int grow = rb + m * 16 + ps * 4 + prow;
          __builtin_nontemporal_store(v, (f32x4*)(op + (size_t)(m * 16 + ps * 4) * D));
          if (xbp) {
            u32x2 o; o.x = pack_bf16(v.x, v.y); o.y = pack_bf16(v.z, v.w);
            *(u32x2*)(xbp + (size_t)grow * LDH + cb + c4 * 4) = o;
            const float t = red16(v.x * v.x + v.y * v.y + v.z * v.z + v.w * v.w);
            if (c4 == 0) atomicAdd(ssqp + grow, t);
          }
        }
        __builtin_amdgcn_sched_barrier(0);
      }
    }
  }
};
struct EpiLat8 {
  static constexpr bool LDS_SCRATCH = false;
  bf16_t* lat; float* kpe; float* ssq_q; float* ssq_kv; const float* ssq_x;
  DI void run8(f32x4 (&acc)[8][4], int rb, int cb, int fr, int fq) const {
    if (cb >= 1088) return;
    float* ssq = (cb < QL) ? ssq_q : ssq_kv;
#pragma unroll
    for (int mp = 0; mp < 2; ++mp) {
      float rsv[4][4];
#pragma unroll
      for (int mm = 0; mm < 4; ++mm)
#pragma unroll
        for (int j = 0; j < 4; ++j) rsv[mm][j] = rsqrtf(ssq_x[rb + (4 * mp + mm) * 16 + fq * 4 + j] * (1.f / D) + EPS);
      __builtin_amdgcn_sched_barrier(0);
#pragma unroll
      for (int mm = 0; mm < 4; ++mm) {
        float ssv[4];
#pragma unroll
        for (int j = 0; j < 4; ++j) {
          const int row = rb + (4 * mp + mm) * 16 + fq * 4 + j;
          float ss = 0.f;
#pragma unroll
          for (int n = 0; n < 4; ++n) {
            const float v = acc[4 * mp + mm][n][j] * rsv[mm][j];
            if (cb >= 1024) kpe[(size_t)row * 64 + (cb - 1024) + n * 16 + fr] = v;
            else { lat[(size_t)row * LDH + cb + n * 16 + fr] = to_bf16(v); ss += v * v; }
          }
          ssv[j] = ss;
        }
        if (cb < 1024) {
#pragma unroll
          for (int j = 0; j < 4; ++j) { const float t = red16(ssv[j]); if (fr == 0) atomicAdd(ssq + rb + (4 * mp + mm) * 16 + fq * 4 + j, t); }
        }
      }
    }
  }
};
struct EpiQraw8 {
  static constexpr bool LDS_SCRATCH = true;
  bf16_t* q; const float* ssq_q;
  DI void run8(f32x4 (&acc)[8][4], int rb, int cb, int fr, int fq) const {
    const int lane = fq * 16 + fr, wid = (opaque_tid512() >> 6);
    bf16_t* scr = (bf16_t*)(smem + G8_STAGE_B + wid * 2304);
    const int srow = lane >> 3, sch = lane & 7;
    bf16_t* qp = q + (size_t)(rb + srow) * 1536 + cb + sch * 8;
#pragma unroll
    for (int m = 0; m < 8; ++m) {
#pragma unroll
      for (int j = 0; j < 4; ++j) {
        const float rs = rsqrtf(ssq_q[rb + m * 16 + fq * 4 + j] * (1.f / QL) + EPS);
#pragma unroll
        for (int n = 0; n < 4; ++n) scr[(fq * 4 + j) * 72 + n * 16 + fr] = to_bf16(acc[m][n][j] * rs);
      }
      __builtin_amdgcn_sched_barrier(0);
#pragma unroll
      for (int ps = 0; ps < 2; ++ps) {
        const u32x4 o = *(const u32x4*)(scr + (ps * 8 + srow) * 72 + sch * 8);
        *(u32x4*)(qp + (size_t)(m * 16 + ps * 8) * 1536) = o;
      }
      __builtin_amdgcn_sched_barrier(0);
    }
  }
};

DI void norm0_phase(const float* __restrict__ x, bf16_t* __restrict__ hb, float* __restrict__ ssq) {
  const int tid = opaque_tid512();
  const int lane = tid & 63, gw = blockIdx.x * 8 + (tid >> 6), nw = gridDim.x * 8;
  for (int row = gw; row < T; row += nw) {
    const f32x4* xr = (const f32x4*)(x + (size_t)row * D);
    f32x4 v[4];
    float ss = 0.f;
#pragma unroll
    for (int c = 0; c < 4; ++c) { v[c] = __builtin_nontemporal_load(xr + c * 64 + lane); ss += v[c].x * v[c].x + v[c].y * v[c].y + v[c].z * v[c].z + v[c].w * v[c].w; }
    ss = red64(ss);
    if (lane == 0) ssq[row] = ss;
#pragma unroll
    for (int c = 0; c < 4; ++c) {
      u32x2 o; o.x = pack_bf16(v[c].x, v[c].y); o.y = pack_bf16(v[c].z, v[c].w);
      *(u32x2*)(hb + (size_t)row * LDH + (c * 64 + lane) * 4) = o;
    }
  }
}

template <int W>
DI void pool_rows(const float* __restrict__ x, const float* smr, bf16_t* __restrict__ pb, int t0, int s0, int tid) {
  const int tq0 = t0 - s0;
  const float* xq = x + tid * 4;
  f32x4 Sm = {0.f, 0.f, 0.f, 0.f};
#pragma unroll
  for (int i = 1; i < W; ++i) {
    int t = t0 - i; if (t < tq0) t = tq0;
    Sm += *(const f32x4*)(xq + (size_t)t * D) * smr[15 - i];
  }
#pragma unroll 8
  for (int tl = 0; tl < 64; ++tl) {
    const int t = t0 + tl, s = s0 + tl;
    int to = t - W + 1; if (to < tq0) to = tq0;
    const f32x4 hn = *(const f32x4*)(xq + (size_t)t * D) * smr[15 + tl];
    const f32x4 ho = *(const f32x4*)(xq + (size_t)to * D) * smr[15 + tl - W + 1];
    const int cnt = (s + 1 < W) ? (s + 1) : W;
    const float ic = 1.f / (float)cnt;
    Sm += hn;
    const f32x4 p = Sm * ic - hn;
    Sm -= ho;
    u32x2 o; o.x = pack_bf16(p.x, p.y); o.y = pack_bf16(p.z, p.w);
    *(u32x2*)(pb + (size_t)t * LDH + tid * 4) = o;
  }
}
DI void poolprep_phase(int vb, int nvb, const float* __restrict__ x, const float* __restrict__ ssq, bf16_t* __restrict__ pb, float* smf) {
  const int tid = opaque_tid(), wave = tid >> 6;
  for (int c0 = 0; c0 < T / 64; c0 += nvb) {
    const int ch = c0 + vb;
    const bool on = ch < T / 64;
    const int t0 = ch * 64, s0 = t0 & (S - 1);
    if (on && tid < 79) smf[tid] = (s0 + tid >= 15) ? rsqrtf(ssq[t0 - 15 + tid] * (1.f / D) + EPS) : 0.f;
    __syncthreads();
    if (on) {
      if (wave == 0) pool_rows<2>(x, smf, pb, t0, s0, tid);
      else if (wave == 1) pool_rows<4>(x, smf, pb, t0, s0, tid);
      else if (wave == 2) pool_rows<8>(x, smf, pb, t0, s0, tid);
      else pool_rows<16>(x, smf, pb, t0, s0, tid);
    }
    __syncthreads();
  }
}

constexpr int KLS = QKH + 8;
constexpr int VLS = 64 + 8;
constexpr int K_EL = 64 * KLS;
constexpr int ATT_STG_EL = K_EL + 128 * VLS;

DI void attn_phase(const bf16_t* __restrict__ qraw, const bf16_t* __restrict__ kbuf, const bf16_t* __restrict__ vtb, bf16_t* __restrict__ obuf,
                   const float* __restrict__ gq, const float* __restrict__ cosT, const float* __restrict__ sinT, bf16_t* sm, int x, int j) {
  const int nb = gridDim.x >> 3;
  for (int p = j; p < 64; p += nb) {
    const int bh = 2 * x + (p >> 5);
    const int b = bh >> 3, hd = bh & 7;
    for (int half = 0; half < 2; ++half) {
      const int tid = opaque_tid512(), lane = tid & 63, wave = tid >> 6, r = lane & 31, h = lane >> 5;
      const int qb = half ? (p & 31) : (63 - (p & 31));
      const int q0 = qb * 256 + wave * 32;
      const size_t tok = (size_t)b * S + q0 + r;
      bf16x8 qf[12];
      {
        const bf16_t* qp = qraw + tok * 1536 + hd * QKH + h * 8;
#pragma unroll
        for (int st = 0; st < 12; ++st) qf[st] = *(const bf16x8*)(qp + st * 16);
        float ss = 0.f;
#pragma unroll
        for (int st = 0; st < 12; ++st) {
#pragma unroll
          for (int e = 0; e < 8; ++e) { const float f = bf2f(qf[st][e]); ss += f * f; }
          u32x4 t = __builtin_bit_cast(u32x4, qf[st]);
          asm volatile("" : "+v"(t));
          qf[st] = __builtin_bit_cast(bf16x8, t);
        }
        ss += __shfl_xor(ss, 32);
        const float rq = rsqrtf(ss * (1.f / QKH) + EPS) * (0.07216878364870322f * 1.4426950408889634f);
        __builtin_amdgcn_sched_barrier(0);
#pragma unroll
        for (int st = 0; st < 8; ++st) {
          const f32x4 ga = *(const f32x4*)(gq + st * 16 + h * 8), gb = *(const f32x4*)(gq + st * 16 + h * 8 + 4);
          u32x4 o;
          o.x = pack_bf16(bf2f(qf[st][0]) * rq * ga.x, bf2f(qf[st][1]) * rq * ga.y);
          o.y = pack_bf16(bf2f(qf[st][2]) * rq * ga.z, bf2f(qf[st][3]) * rq * ga.w);
          o.z = pack_bf16(bf2f(qf[st][4]) * rq * gb.x, bf2f(qf[st][5]) * rq * gb.y);
          o.w = pack_bf16(bf2f(qf[st][6]) * rq * gb.z, bf2f(qf[st][7]) * rq * gb.w);
          asm volatile("" : "+v"(o));
          qf[st] = __builtin_bit_cast(bf16x8, o);
          __builtin_amdgcn_sched_barrier(0);
        }
#pragma unroll
        for (int st = 8; st < 10; ++st) {
          const int jb = (st - 8) * 16 + h * 8;
          u32x4 o1, o2;
#pragma unroll
          for (int hf = 0; hf < 2; ++hf) {
            const f32x4 g1 = *(const f32x4*)(gq + 128 + jb + 4 * hf), g2 = *(const f32x4*)(gq + 160 + jb + 4 * hf);
            const f32x4 cc = *(const f32x4*)(cosT + tok * 32 + jb + 4 * hf), sn = *(const f32x4*)(sinT + tok * 32 + jb + 4 * hf);
            float y1[4], y2[4];
#pragma unroll
            for (int e = 0; e < 4; ++e) {
              const float x1 = bf2f(qf[st][4 * hf + e]) * rq * g1[e], x2 = bf2f(qf[st + 2][4 * hf + e]) * rq * g2[e];
              y1[e] = x1 * cc[e] - x2 * sn[e]; y2[e] = x2 * cc[e] + x1 * sn[e];
            }
            if (hf == 0) { o1.x = pack_bf16(y1[0], y1[1]); o1.y = pack_bf16(y1[2], y1[3]); o2.x = pack_bf16(y2[0], y2[1]); o2.y = pack_bf16(y2[2], y2[3]); }
            else { o1.z = pack_bf16(y1[0], y1[1]); o1.w = pack_bf16(y1[2], y1[3]); o2.z = pack_bf16(y2[0], y2[1]); o2.w = pack_bf16(y2[2], y2[3]); }
          }
          asm volatile("" : "+v"(o1), "+v"(o2));
          qf[st] = __builtin_bit_cast(bf16x8, o1); qf[st + 2] = __builtin_bit_cast(bf16x8, o2);
          __builtin_amdgcn_sched_barrier(0);
        }
      }
      f32x16 oacc[4];
#pragma unroll
      for (int mt = 0; mt < 4; ++mt)
#pragma unroll
        for (int i = 0; i < 16; ++i) oacc[mt][i] = 0.f;
      float m_run = -1e30f, l_run = 0.f;
      const int nkt = 4 * qb + 4;
      const bf16_t* kg = kbuf + (size_t)bh * S * QKH;
      const bf16_t* vg = vtb + (size_t)bh * VH * SV;
      u32x4 rk[3], rv[2];
      const unsigned kg_off0 = (unsigned)(tid >> 3) * QKH + (unsigned)(tid & 7) * 8u;
      const unsigned vg_off0 = (unsigned)(tid >> 3) * (unsigned)SV + (unsigned)(tid & 7) * 8u;
      const unsigned kl_off = (unsigned)(tid >> 3) * KLS + (unsigned)(tid & 7) * 8u;
      const unsigned vl_off = (unsigned)(tid >> 3) * VLS + (unsigned)(tid & 7) * 8u;
#define ALOAD(kt_)                                                                                                     \
  {                                                                                                                    \
    const bf16_t* kgt_ = kg + (size_t)(kt_) * 64 * QKH; const bf16_t* vgt_ = vg + (kt_) * 64;                          \
    unsigned kg_off = kg_off0, vg_off = vg_off0; asm volatile("" : "+v"(kg_off), "+v"(vg_off));                        \
    _Pragma("unroll") for (int i = 0; i < 3; ++i) rk[i] = *(const u32x4*)(kgt_ + (kg_off + (unsigned)(i * 64)));       \
    _Pragma("unroll") for (int i = 0; i < 2; ++i) rv[i] = *(const u32x4*)(vgt_ + (vg_off + (unsigned)(i * 64) * (unsigned)SV)); \
  }
      ALOAD(0);
#define ASTORE(stg_)                                                                                                   \
  {                                                                                                                    \
    bf16_t* sk_ = sm + (stg_) * ATT_STG_EL; bf16_t* sv_ = sk_ + K_EL;                                                  \
    _Pragma("unroll") for (int i = 0; i < 3; ++i) *(u32x4*)(sk_ + kl_off + i * 64) = rk[i];                            \
    _Pragma("unroll") for (int i = 0; i < 2; ++i) *(u32x4*)(sv_ + vl_off + i * 64 * VLS) = rv[i];                      \
  }
      ASTORE(0);
      __syncthreads();
      for (int kt = 0; kt < nkt; ++kt) {
        const bf16_t* smk = sm + (kt & 1) * ATT_STG_EL;
        const bf16_t* smv = smk + K_EL;
        if (kt + 1 < nkt) ALOAD(kt + 1);
        __builtin_amdgcn_sched_barrier(0);
        if (kt * 64 <= q0 + 31) {
        f32x16 sacc[2];
#pragma unroll
        for (int mt = 0; mt < 2; ++mt)
#pragma unroll
          for (int i = 0; i < 16; ++i) sacc[mt][i] = 0.f;
        const bf16_t* kp = smk + r * KLS + h * 8;
        {
          bf16x8 ka = *(const bf16x8*)(kp), kb = *(const bf16x8*)(kp + 32 * KLS);
#pragma unroll
          for (int st = 0; st < 12; ++st) {
            bf16x8 na = ka, nbq = kb;
            if (st + 1 < 12) { na = *(const bf16x8*)(kp + (st + 1) * 16); nbq = *(const bf16x8*)(kp + 32 * KLS + (st + 1) * 16); }
            sacc[0] = MFMA(ka, qf[st], sacc[0]);
            sacc[1] = MFMA(kb, qf[st], sacc[1]);
            ka = na; kb = nbq;
            __builtin_amdgcn_sched_barrier(0);
          }
        }
        if (kt * 64 + 63 > q0) {
          const int qpos = q0 + r;
#pragma unroll
          for (int mt = 0; mt < 2; ++mt)
#pragma unroll
            for (int i = 0; i < 16; ++i) { const int key = kt * 64 + mt * 32 + crow(i, h); if (key > qpos) sacc[mt][i] = -INFINITY; }
        }
        float mx = sacc[0][0];
#pragma unroll
        for (int mt = 0; mt < 2; ++mt)
#pragma unroll
          for (int i = 0; i < 16; ++i) mx = fmaxf(mx, sacc[mt][i]);
        mx = fmaxf(mx, __shfl_xor(mx, 32));
        const float m_new = fmaxf(m_run, mx);
        const float alpha = __builtin_amdgcn_exp2f(m_run - m_new);
        m_run = m_new;
        float rs = 0.f;
#pragma unroll
        for (int mt = 0; mt < 2; ++mt)
#pragma unroll
          for (int i = 0; i < 16; ++i) { const float pv = __builtin_amdgcn_exp2f(sacc[mt][i] - m_new); sacc[mt][i] = pv; rs += pv; }
        rs += __shfl_xor(rs, 32);
        l_run = l_run * alpha + rs;
        if (__any(alpha != 1.f)) {
#pragma unroll
          for (int mt = 0; mt < 4; ++mt)
#pragma unroll
            for (int i = 0; i < 16; ++i) oacc[mt][i] *= alpha;
        }
        bf16x8 pf[4];
#pragma unroll
        for (int ks = 0; ks < 4; ++ks) {
          u32x4 o;
          o.x = pack_bf16(sacc[ks >> 1][8 * (ks & 1) + 0], sacc[ks >> 1][8 * (ks & 1) + 1]);
          o.y = pack_bf16(sacc[ks >> 1][8 * (ks & 1) + 2], sacc[ks >> 1][8 * (ks & 1) + 3]);
          o.z = pack_bf16(sacc[ks >> 1][8 * (ks & 1) + 4], sacc[ks >> 1][8 * (ks & 1) + 5]);
          o.w = pack_bf16(sacc[ks >> 1][8 * (ks & 1) + 6], sacc[ks >> 1][8 * (ks & 1) + 7]);
          pf[ks] = __builtin_bit_cast(bf16x8, o);
        }
        const bf16_t* vp = smv + r * VLS + h * 8;
        __builtin_amdgcn_sched_barrier(0);
#pragma unroll
        for (int ks = 0; ks < 4; ++ks) {
          const bf16x8 v0 = *(const bf16x8*)(vp + ks * 16), v1 = *(const bf16x8*)(vp + 32 * VLS + ks * 16);
          const bf16x8 v2 = *(const bf16x8*)(vp + 64 * VLS + ks * 16), v3 = *(const bf16x8*)(vp + 96 * VLS + ks * 16);
          oacc[0] = MFMA(v0, pf[ks], oacc[0]);
          oacc[1] = MFMA(v1, pf[ks], oacc[1]);
          oacc[2] = MFMA(v2, pf[ks], oacc[2]);
          oacc[3] = MFMA(v3, pf[ks], oacc[3]);
          __builtin_amdgcn_sched_barrier(0);
        }
        }
        if (kt + 1 < nkt) ASTORE((kt + 1) & 1);
        __syncthreads();
      }
#undef ALOAD
#undef ASTORE
      const float inv = 1.f / l_run;
      bf16_t* op = obuf + tok * LDH + hd * VH + 4 * h;
#pragma unroll
      for (int mt = 0; mt < 4; ++mt)
#pragma unroll
        for (int a = 0; a < 4; ++a) {
          u32x2 o;
          o.x = pack_bf16(oacc[mt][4 * a] * inv, oacc[mt][4 * a + 1] * inv);
          o.y = pack_bf16(oacc[mt][4 * a + 2] * inv, oacc[mt][4 * a + 3] * inv);
          *(u32x2*)(op + mt * 32 + 8 * a) = o;
        }
      __syncthreads();
    }
  }
}

typedef Cfg<4, 1, 1, 4, 64, 1> CR;

__global__ void __launch_bounds__(512, 2) fwd_megakernel(Params p) {
  cg::grid_group grid = cg::this_grid();
  unsigned char* ws = p.ws;
  const float* x_in = p.in[0];
  const int* positions = (const int*)p.in[1];
  float* out = p.out;
  bf16_t* wgu1 = (bf16_t*)(ws + OFF_WGU1); bf16_t* wdn1 = (bf16_t*)(ws + OFF_WDN1);
  bf16_t* wgu2 = (bf16_t*)(ws + OFF_WGU2); bf16_t* wdn2 = (bf16_t*)(ws + OFF_WDN2);
  bf16_t* wpool = (bf16_t*)(ws + OFF_WPOOL); bf16_t* win = (bf16_t*)(ws + OFF_WIN); bf16_t* wq = (bf16_t*)(ws + OFF_WQ);
  bf16_t* wkv = (bf16_t*)(ws + OFF_WKV); bf16_t* wout = (bf16_t*)(ws + OFF_WOUT);
  float* cosT = (float*)(ws + OFF_COS); float* sinT = (float*)(ws + OFF_SIN);
  float* ssq_all = (float*)(ws + OFF_SSQ);
  float* kpe = (float*)(ws + OFF_KPE);
  bf16_t* hb = (bf16_t*)(ws + OFF_HB);
  bf16_t* act = (bf16_t*)(ws + OFF_ACT); bf16_t* lat = (bf16_t*)(ws + OFF_LAT); bf16_t* qraw = (bf16_t*)(ws + OFF_QRAW);
  bf16_t* kbuf = (bf16_t*)(ws + OFF_K); bf16_t* vtb = (bf16_t*)(ws + OFF_VT);
  bf16_t* obuf = lat; bf16_t* pooled = (bf16_t*)(ws + OFF_POOLED);
  const int gt = blockIdx.x * 512 + threadIdx.x, gs = gridDim.x * 512;
  const int vhalf = __builtin_amdgcn_readfirstlane((int)(threadIdx.x >> 8));
  const int vb = blockIdx.x * 2 + vhalf, nvb = gridDim.x * 2;
  bf16_t* smh = (bf16_t*)(smem + vhalf * VHALF_BYTES);
  float* smf = (float*)(smem + vhalf * VHALF_BYTES);

  unsigned* ctl = (unsigned*)(ws + OFF_CTL);
  if (threadIdx.x == 0) {
    const unsigned xcc = (unsigned)__builtin_amdgcn_s_getreg((3 << 11) | 20) & 0x7u;
    const unsigned rank = atomicAdd(ctl + xcc, 1u);
    ((volatile int*)smem)[0] = (int)xcc; ((volatile int*)smem)[1] = (int)rank;
  }
  __syncthreads();
  int xs = __builtin_amdgcn_readfirstlane(((volatile int*)smem)[0]);
  int js = __builtin_amdgcn_readfirstlane(((volatile int*)smem)[1]);
  __syncthreads();

  for (int idx = gt; idx < T * 32; idx += gs) {
    const int t = idx >> 5, jf = idx & 31;
    const float inv_freq = exp2f(-(float)jf * 0.41524101186092029f);
    const float ang = (float)positions[t] * inv_freq;
    const double rev = (double)ang * 0.15915494309189535;
    const float fr = (float)(rev - rint(rev));
    cosT[idx] = __builtin_amdgcn_cosf(fr);
    sinT[idx] = __builtin_amdgcn_sinf(fr);
  }
  for (int i = gt; i < 15 * T; i += gs) ssq_all[T + i] = 0.f;
  norm0_phase(x_in, hb, ssq_all);
  for (int jl = 0; jl < 2; ++jl) {
    for (int g = 0; g < 4; ++g)
      prep_w(vb, nvb, p.in[7] + ((size_t)jl * 4 + g) * 65536, wpool + ((size_t)jl * 4 + g) * 256 * (256 + PADK), 256, 256, p.in[6] + (size_t)(2 * jl) * D + g * 256, p.in[8] + (size_t)jl * D + g * 256, 0, smf);
    prep_w(vb, nvb, p.in[9] + (size_t)jl * D * 1088, win + (size_t)jl * LATNP * (D + PADK), D, 1088, p.in[6] + (size_t)(2 * jl + 1) * D, nullptr, 0, smf);
    for (int i = gt; i < (LATNP - 1088) * (D + PADK) / 8; i += gs) ((u32x4*)(win + (size_t)jl * LATNP * (D + PADK) + (size_t)1088 * (D + PADK)))[i] = (u32x4){0u, 0u, 0u, 0u};
    prep_w(vb, nvb, p.in[11] + (size_t)jl * QL * 1536, wq + (size_t)jl * 1536 * (QL + PADK), QL, 1536, p.in[10] + (size_t)jl * QL, nullptr, 0, smf);
    prep_w(vb, nvb, p.in[13] + (size_t)jl * KVL * 2048, wkv + (size_t)jl * 2048 * (KVL + PADK), KVL, 2048, p.in[12] + (size_t)jl * KVL, nullptr, 3, smf);
    prep_w(vb, nvb, p.in[16] + (size_t)jl * D * D, wout + (size_t)jl * D * (D + PADK), D, D, nullptr, nullptr, 0, smf);
  }
#define PREP_FFN1(L_) { const size_t wo_ = (size_t)(L_) * D * FF; \
    prep_w(vb, nvb, p.in[3] + wo_, wgu1, D, FF, p.in[2] + (size_t)(L_) * D, nullptr, 1, smf); \
    prep_w(vb, nvb, p.in[4] + wo_, wgu1, D, FF, p.in[2] + (size_t)(L_) * D, nullptr, 2, smf); \
    prep_w(vb, nvb, p.in[5] + wo_, wdn1, FF, D, nullptr, nullptr, 0, smf); }
#define PREP_FFN2(L_) { const size_t wo_ = (size_t)(L_) * D * FF; \
    prep_w(vb, nvb, p.in[18] + wo_, wgu2, D, FF, p.in[17] + (size_t)(L_) * D, nullptr, 1, smf); \
    prep_w(vb, nvb, p.in[19] + wo_, wgu2, D, FF, p.in[17] + (size_t)(L_) * D, nullptr, 2, smf); \
    prep_w(vb, nvb, p.in[20] + wo_, wdn2, FF, D, nullptr, nullptr, 0, smf); }
  PREP_FFN1(0);
  PREP_FFN2(0);
  grid.sync();
  {
    bool even = true;
    for (int i = 0; i < 8; ++i) even = even && (__hip_atomic_load(ctl + i, __ATOMIC_RELAXED, __HIP_MEMORY_SCOPE_AGENT) == (gridDim.x >> 3));
    if (!even || js >= (int)(gridDim.x >> 3)) { xs = blockIdx.x & 7; js = blockIdx.x >> 3; }
  }
  unsigned bar_target = 0;
#define GBAR() { bar_target += gridDim.x; grid_bar(ctl + 32, bar_target); }
  unsigned xbar_target = 0;
#define XBAR() { xbar_target += (gridDim.x >> 3); grid_bar(ctl + 48 + xs, xbar_target); }
  const int jv = js * 2 + vhalf, nbv = (int)(gridDim.x >> 3) * 2;

  for (int layer = 0; layer < DEPTH; ++layer) {
    const float* xcur = (layer == 0) ? x_in : out;
    float* ssq0 = ssq_all + (size_t)(layer * 3 + 0) * T;
    float* ssq1 = ssq_all + (size_t)(layer * 3 + 1) * T;
    float* ssq2 = ssq_all + (size_t)(layer * 3 + 2) * T;
    float* ssq_next = ssq_all + (size_t)((layer + 1) * 3) * T;
    const int jl = layer >> 1;
    float* ssq_q = ssq_all + (size_t)(12 + jl) * T;
    float* ssq_kv = ssq_all + (size_t)(14 + jl) * T;
    if (layer > 0) PREP_FFN2(layer);
    gemm8_phase(xs, js, hb, LDH, wgu1, D, 2 * FF, 0, EpiGU8{act, ssq0});
    XBAR();
    gemm8_phase(xs, js, act, LDA, wdn1, FF, D, 0, EpiResid8{xcur, out, 0.5f, hb, ssq1});
    GBAR();
    if (layer + 1 < DEPTH) PREP_FFN1(layer + 1);
    if ((layer & 1) == 0) {
      poolprep_phase(vb, nvb, out, ssq1, pooled, smf);
      GBAR();
      gemm8_phase(xs, js, pooled, LDH, wpool + (size_t)jl * 1024 * (256 + PADK), 256, D, 256, EpiResid8{out, out, 1.0f, hb, ssq2});
      GBAR();
    } else {
      gemm8_phase(xs, js, hb, LDH, win + (size_t)jl * LATNP * (D + PADK), D, LATNP, 0, EpiLat8{lat, kpe, ssq_q, ssq_kv, ssq1});
      GBAR();
      gemm8_phase(xs, js, lat, LDH, wq + (size_t)jl * 1536 * (QL + PADK), QL, 1536, 0, EpiQraw8{qraw, ssq_q});
      gemm_phase<CR>(xs, jv, nbv, lat + QL, LDH, wkv + (size_t)jl * 2048 * (KVL + PADK), KVL, 2048, 0, EpiKV{ssq_kv, kpe, p.in[15] + (size_t)jl * QKH, cosT, sinT, kbuf, vtb}, smh);
      GBAR();
      attn_phase(qraw, kbuf, vtb, obuf, p.in[14] + (size_t)jl * QKH, cosT, sinT, (bf16_t*)smem, xs, js);
      GBAR();
      gemm8_phase(xs, js, obuf, LDH, wout + (size_t)jl * D * (D + PADK), D, D, 0, EpiResid8{out, out, 1.0f, hb, ssq2});
      GBAR();
    }
    gemm8_phase(xs, js, hb, LDH, wgu2, D, 2 * FF, 0, EpiGU8{act, ssq2});
    XBAR();
    const bool last = (layer + 1 == DEPTH);
    gemm8_phase(xs, js, act, LDA, wdn2, FF, D, 0, EpiResid8{out, out, 0.5f, last ? nullptr : hb, last ? nullptr : ssq_next});
    if (!last) GBAR();
  }
}

extern "C" void kernel_launch(void* const* d_in, const int* in_sizes, int n_in, void* d_out, int out_size, void* d_ws, size_t ws_size, hipStream_t stream) {
  static int grid_blocks = 0;
  if (!grid_blocks) {
    int dev = 0, cus = 0, per_cu = 0;
    (void)hipGetDevice(&dev);
    (void)hipDeviceGetAttribute(&cus, hipDeviceAttributeMultiprocessorCount, dev);
    (void)hipFuncSetAttribute((const void*)fwd_megakernel, hipFuncAttributeMaxDynamicSharedMemorySize, LDS_BYTES);
    (void)hipOccupancyMaxActiveBlocksPerMultiprocessor(&per_cu, fwd_megakernel, 512, LDS_BYTES);
    grid_blocks = cus;
    if (n_in != 21 || out_size != T * D || ws_size < WS_TOTAL || per_cu < 1) fprintf(stderr, "kernel_launch: unexpected n_in=%d out=%d ws=%zu (need %zu) per_cu=%d\n", n_in, out_size, ws_size, (size_t)WS_TOTAL, per_cu);
  }
  Params p{};
  for (int i = 0; i < 21; ++i) p.in[i] = (const float*)d_in[i];
  p.out = (float*)d_out; p.ws = (unsigned char*)d_ws;
  (void)hipMemsetAsync((unsigned char*)d_ws + OFF_CTL, 0, 256, stream);
  void* args[] = {&p};
  hipError_t e = hipLaunchCooperativeKernel((void*)fwd_megakernel, dim3(grid_blocks), dim3(512), args, LDS_BYTES, stream);
  if (e != hipSuccess) fprintf(stderr, "cooperative launch failed: %s (grid %d)\n", hipGetErrorString(e), grid_blocks);
}
```

```cpp
#include <hip/hip_runtime.h>
#include <hip/hip_cooperative_groups.h>
#include <cstdio>
#include <cstdint>
namespace cg = cooperative_groups;

#define DI __device__ __forceinline__
typedef unsigned short bf16_t;
typedef short bf16x8 __attribute__((ext_vector_type(8)));
typedef float f32x16 __attribute__((ext_vector_type(16)));
typedef float f32x4 __attribute__((ext_vector_type(4)));
typedef float f32x2 __attribute__((ext_vector_type(2)));
typedef unsigned u32x4 __attribute__((ext_vector_type(4)));
typedef unsigned u32x2 __attribute__((ext_vector_type(2)));
typedef __bf16 bf16v2 __attribute__((ext_vector_type(2)));

constexpr int NB = 2, S = 16384, T = NB * S, D = 1024, FF = 2816, NH = 8, DEPTH = 4;
constexpr int QL = 768, KVL = 256, QKH = 192, VH = 128;
constexpr int LATNP = 1280;
constexpr int LDH = D + 64;
constexpr int LDA = FF + 64;
constexpr int SV = S + 64;
constexpr int PADK = 64;
constexpr float EPS = 1e-6f;

constexpr size_t SZ_WGU = (size_t)2 * FF * (D + PADK) * 2, SZ_WDN = (size_t)D * (FF + PADK) * 2;
constexpr size_t OFF_WGU1 = 0, OFF_WDN1 = OFF_WGU1 + SZ_WGU, OFF_WGU2 = OFF_WDN1 + SZ_WDN, OFF_WDN2 = OFF_WGU2 + SZ_WGU;
constexpr size_t SZ_WPOOL = (size_t)1024 * (256 + PADK) * 2, SZ_WIN = (size_t)LATNP * (D + PADK) * 2, SZ_WQ = (size_t)1536 * (QL + PADK) * 2;
constexpr size_t SZ_WKV = (size_t)2048 * (KVL + PADK) * 2, SZ_WOUT = (size_t)D * (D + PADK) * 2;
constexpr size_t OFF_WPOOL = OFF_WDN2 + SZ_WDN;
constexpr size_t OFF_WIN = OFF_WPOOL + 2 * SZ_WPOOL;
constexpr size_t OFF_WQ = OFF_WIN + 2 * SZ_WIN;
constexpr size_t OFF_WKV = OFF_WQ + 2 * SZ_WQ;
constexpr size_t OFF_WOUT = OFF_WKV + 2 * SZ_WKV;
constexpr size_t OFF_COS = OFF_WOUT + 2 * SZ_WOUT;
constexpr size_t OFF_SIN = OFF_COS + (size_t)T * 32 * 4;
constexpr size_t OFF_SSQ = OFF_SIN + (size_t)T * 32 * 4;
constexpr size_t OFF_KPE = OFF_SSQ + (size_t)16 * T * 4;
constexpr size_t OFF_HB = OFF_KPE + (size_t)T * 64 * 4;
constexpr size_t OFF_BIG = OFF_HB + (size_t)T * LDH * 2;
constexpr size_t OFF_ACT = OFF_BIG;
constexpr size_t OFF_LAT = OFF_BIG;
constexpr size_t OFF_POOLED = OFF_BIG;
constexpr size_t OFF_QRAW = OFF_LAT + (size_t)T * LDH * 2;
constexpr size_t OFF_K = OFF_QRAW + (size_t)T * 1536 * 2;
constexpr size_t OFF_VT = OFF_K + (size_t)T * NH * QKH * 2;
constexpr size_t WS_END = OFF_VT + (size_t)NB * NH * VH * SV * 2;
static_assert(OFF_ACT + (size_t)T * LDA * 2 <= WS_END, "act must fit in the big region");
constexpr size_t OFF_CTL = WS_END;
constexpr size_t WS_TOTAL = OFF_CTL + 256;
static_assert(WS_TOTAL <= (size_t)536870912, "workspace budget (4 x largest tensor)");
constexpr int LDS_BYTES = 131072;
constexpr int VHALF_BYTES = 36864;

struct Params { const float* in[21]; float* out; unsigned char* ws; };
extern __shared__ __attribute__((aligned(1024))) unsigned char smem[];

DI unsigned pack_bf16(float lo, float hi) { f32x2 v = {lo, hi}; bf16v2 b = __builtin_convertvector(v, bf16v2); return __builtin_bit_cast(unsigned, b); }
DI bf16_t to_bf16(float x) { return (bf16_t)(pack_bf16(x, 0.f) & 0xffffu); }
DI float bf2f(short v) { return __uint_as_float(((unsigned)(unsigned short)v) << 16); }
DI int crow(int i, int h) { return (i & 3) + 8 * (i >> 2) + 4 * h; }
DI float red32(float v) { v += __shfl_xor(v, 1); v += __shfl_xor(v, 2); v += __shfl_xor(v, 4); v += __shfl_xor(v, 8); v += __shfl_xor(v, 16); return v; }
DI float red64(float v) { v = red32(v); v += __shfl_xor(v, 32); return v; }
DI int opaque_tid() { int t = threadIdx.x & 255; asm volatile("" : "+v"(t)); return t; }
DI int opaque_tid512() { int t = threadIdx.x; asm volatile("" : "+v"(t)); return t; }
#define MFMA(a, b, c) __builtin_amdgcn_mfma_f32_32x32x16_bf16((a), (b), (c), 0, 0, 0)
DI void grid_bar(unsigned* ctr, unsigned target) {
  asm volatile("s_waitcnt vmcnt(0)" ::: "memory");
  __syncthreads();
  if (threadIdx.x == 0) {
    __builtin_amdgcn_fence(__ATOMIC_RELEASE, "agent");
    asm volatile("s_waitcnt vmcnt(0)" ::: "memory");
    (void)__hip_atomic_fetch_add(ctr, 1u, __ATOMIC_RELAXED, __HIP_MEMORY_SCOPE_AGENT);
    while (__hip_atomic_load(ctr, __ATOMIC_RELAXED, __HIP_MEMORY_SCOPE_AGENT) < target) __builtin_amdgcn_s_sleep(1);
    __builtin_amdgcn_fence(__ATOMIC_ACQUIRE, "agent");
    asm volatile("s_waitcnt vmcnt(0)" ::: "memory");
  }
  __syncthreads();
}

DI void prep_w(int vb, int nvb, const float* __restrict__ W, bf16_t* __restrict__ Wt, int K, int N, const float* __restrict__ gk, const float* __restrict__ sn, int mode, float* smf) {
  const int ldt = K + PADK;
  const int tid = opaque_tid();
  const int ntn = N / 64, nt = (K / 64) * ntn;
  for (int t0 = 0; t0 < nt; t0 += nvb) {
    const int t = t0 + vb;
    const bool on = t < nt;
    const int k0 = (t / ntn) * 64, n0 = (t % ntn) * 64;
    if (on) {
#pragma unroll
      for (int i = 0; i < 16; ++i) {
        const int kk = i * 4 + (tid >> 6), nn = tid & 63;
        float v = __builtin_nontemporal_load(W + (size_t)(k0 + kk) * N + n0 + nn);
        if (gk) v *= gk[k0 + kk];
        if (sn) v *= sn[n0 + nn];
        smf[kk * 65 + nn] = v;
      }
    }
    __syncthreads();
    if (on) {
      const int nl = tid >> 2, kq = (tid & 3) * 16;
      u32x4 p0, p1;
      p0.x = pack_bf16(smf[(kq + 0) * 65 + nl], smf[(kq + 1) * 65 + nl]);
      p0.y = pack_bf16(smf[(kq + 2) * 65 + nl], smf[(kq + 3) * 65 + nl]);
      p0.z = pack_bf16(smf[(kq + 4) * 65 + nl], smf[(kq + 5) * 65 + nl]);
      p0.w = pack_bf16(smf[(kq + 6) * 65 + nl], smf[(kq + 7) * 65 + nl]);
      p1.x = pack_bf16(smf[(kq + 8) * 65 + nl], smf[(kq + 9) * 65 + nl]);
      p1.y = pack_bf16(smf[(kq + 10) * 65 + nl], smf[(kq + 11) * 65 + nl]);
      p1.z = pack_bf16(smf[(kq + 12) * 65 + nl], smf[(kq + 13) * 65 + nl]);
      p1.w = pack_bf16(smf[(kq + 14) * 65 + nl], smf[(kq + 15) * 65 + nl]);
      const int n = n0 + nl;
      int row = n;
      if (mode == 1) row = (n >> 4) * 32 + (n & 15);
      else if (mode == 2) row = (n >> 4) * 32 + 16 + (n & 15);
      else if (mode == 3) { const int hd = n >> 8, j = n & 255; row = (j < 128) ? (hd * 128 + j) : (1024 + hd * 128 + (j - 128)); }
      u32x4* dst = (u32x4*)(Wt + (size_t)row * ldt + k0 + kq);
      dst[0] = p0; dst[1] = p1;
    }
    __syncthreads();
  }
}

template <int WM_, int WN_, int MI_, int NI_, int BK_, int ST_>
struct Cfg {
  static constexpr int WM = WM_, WN = WN_, MI = MI_, NI = NI_, BK = BK_, ST = ST_;
  static constexpr int BM = WM * MI * 32, BN = WN * NI * 32;
  static constexpr int LS = BK + 8;
  static constexpr int A_EL = BM * LS, B_EL = BN * LS, STAGE_EL = A_EL + B_EL;
  static constexpr int CPR = BK / 8;
  static constexpr int A_CH = BM * CPR / 256, B_CH = BN * CPR / 256;
  static_assert(WM * WN == 4, "4 waves");
  static_assert(ST * STAGE_EL * 2 <= VHALF_BYTES, "LDS of a virtual half-block");
};

template <class C, class Epi>
DI void gemm_tile(const bf16_t* __restrict__ A, int lda, const bf16_t* __restrict__ Bt, int K, int m0, int n0, const Epi& epi, bf16_t* sm) {
  const int tid = opaque_tid(), lane = tid & 63, wave = tid >> 6, r = lane & 31, h = lane >> 5;
  const int wm = wave / C::WN, wn = wave % C::WN;
  f32x16 acc[C::MI][C::NI];
#pragma unroll
  for (int mi = 0; mi < C::MI; ++mi)
#pragma unroll
    for (int ni = 0; ni < C::NI; ++ni)
#pragma unroll
      for (int i = 0; i < 16; ++i) acc[mi][ni][i] = 0.f;
  const bf16_t* Ag = A + (size_t)m0 * lda;
  const int ldb = K + PADK;
  const bf16_t* Bg = Bt + (size_t)n0 * ldb;
  u32x4 ra[C::A_CH], rb[C::B_CH];
  const int nk = K / C::BK;
  constexpr int RPP = 256 / C::CPR;
  const unsigned a_off = (unsigned)(tid / C::CPR) * (unsigned)lda + (unsigned)(tid % C::CPR) * 8u;
  const unsigned b_off = (unsigned)(tid / C::CPR) * (unsigned)ldb + (unsigned)(tid % C::CPR) * 8u;
  const unsigned l_off = (unsigned)(tid / C::CPR) * C::LS + (unsigned)(tid % C::CPR) * 8u;
#define GLOAD(k0_)                                                                                   \
  {                                                                                                  \
    const bf16_t* ag_ = Ag + (k0_); const bf16_t* bg_ = Bg + (k0_);                                  \
    _Pragma("unroll") for (int i = 0; i < C::A_CH; ++i) ra[i] = *(const u32x4*)(ag_ + (a_off + (unsigned)(i * RPP) * (unsigned)lda)); \
    _Pragma("unroll") for (int i = 0; i < C::B_CH; ++i) rb[i] = *(const u32x4*)(bg_ + (b_off + (unsigned)(i * RPP) * (unsigned)ldb));   \
  }
#define LSTORE(buf_)                                                                                 \
  {                                                                                                  \
    bf16_t* sa_ = sm + (buf_) * C::STAGE_EL + l_off; bf16_t* sb_ = sa_ + C::A_EL;                    \
    _Pragma("unroll") for (int i = 0; i < C::A_CH; ++i) *(u32x4*)(sa_ + i * RPP * C::LS) = ra[i];   \
    _Pragma("unroll") for (int i = 0; i < C::B_CH; ++i) *(u32x4*)(sb_ + i * RPP * C::LS) = rb[i];   \
  }
  GLOAD(0);
  if (C::ST == 2) {
    LSTORE(0);
    __syncthreads();
  }
  for (int kt = 0; kt < nk; ++kt) {
    const int buf = (C::ST == 2) ? (kt & 1) : 0;
    if (C::ST == 1) {
      __syncthreads();
      LSTORE(0);
      __syncthreads();
    }
    if (kt + 1 < nk) GLOAD((kt + 1) * C::BK);
    __builtin_amdgcn_sched_barrier(0);
    const bf16_t* sa = sm + buf * C::STAGE_EL + (wm * C::MI * 32 + r) * C::LS + h * 8;
    const bf16_t* sb = sm + buf * C::STAGE_EL + C::A_EL + (wn * C::NI * 32 + r) * C::LS + h * 8;
#pragma unroll
    for (int ks = 0; ks < C::BK / 16; ++ks) {
      bf16x8 af[C::MI], bfr[C::NI];
#pragma unroll
      for (int mi = 0; mi < C::MI; ++mi) af[mi] = *(const bf16x8*)(sa + mi * 32 * C::LS + ks * 16);
#pragma unroll
      for (int ni = 0; ni < C::NI; ++ni) bfr[ni] = *(const bf16x8*)(sb + ni * 32 * C::LS + ks * 16);
#pragma unroll
      for (int mi = 0; mi < C::MI; ++mi)
#pragma unroll
        for (int ni = 0; ni < C::NI; ++ni) acc[mi][ni] = MFMA(af[mi], bfr[ni], acc[mi][ni]);
    }
    if (C::ST == 2) {
      if (kt + 1 < nk) LSTORE((kt + 1) & 1);
      __syncthreads();
    }
  }
  if (C::ST == 1) __syncthreads();
#undef GLOAD
#undef LSTORE
  epi.template run<C::MI, C::NI>(acc, m0 + wm * C::MI * 32, n0 + wn * C::NI * 32, r, h);
}

template <class C, class Epi>
DI void gemm_phase(int x, int j, int nb, const bf16_t* __restrict__ A, int lda, const bf16_t* __restrict__ Bt, int K, int N, int a_grp, const Epi& epi, bf16_t* sm) {
  static_assert(C::BM == 128 && (C::BN == 128 || C::BN == 256), "tile");
  constexpr int GN = (C::BN == 256) ? 4 : 8;
  const int nN = N / C::BN;
  const int total = 32 * nN;
  for (int u = j; u < total; u += nb) {
    const int ng = u / (32 * GN), rem = u % (32 * GN);
    int gn = nN - GN * ng; if (gn > GN) gn = GN;
    const int mg = rem / (8 * gn), jj = rem % (8 * gn);
    const int mt = 32 * x + 8 * mg + (jj & 7), nt = GN * ng + (jj >> 3);
    const int n0 = nt * C::BN;
    const bf16_t* Ap = a_grp ? (A + (n0 / a_grp) * K) : A;
    gemm_tile<C, Epi>(Ap, lda, Bt, K, mt * 128, n0, epi, sm);
  }
}

struct EpiGU {
  bf16_t* act; const float* ssq;
  template <int MI, int NI> DI void run(f32x16 (&acc)[MI][NI], int mb, int nb, int r, int h) const {
    static_assert((NI & 1) == 0, "gate/up pairs");
#pragma unroll
    for (int mi = 0; mi < MI; ++mi)
#pragma unroll
      for (int i = 0; i < 16; ++i) {
        const int row = mb + mi * 32 + crow(i, h);
        const float rs = rsqrtf(ssq[row] * (1.f / D) + EPS);
#pragma unroll
        for (int pi = 0; pi < NI / 2; ++pi) {
          const float g = acc[mi][2 * pi][i] * rs, u = acc[mi][2 * pi + 1][i] * rs;
          const float a = g / (1.f + __expf(-g)) * u;
          act[(size_t)row * LDA + (nb >> 1) + pi * 32 + r] = to_bf16(a);
        }
      }
  }
};
struct EpiResid {
  const float* xin; float* xout; float scale; bf16_t* xb; float* ssq;
  template <int MI, int NI> DI void run(f32x16 (&acc)[MI][NI], int mb, int nb, int r, int h) const {
#pragma unroll
    for (int mi = 0; mi < MI; ++mi)
#pragma unroll
      for (int hf = 0; hf < 2; ++hf) {
        float xv[8][NI];
#pragma unroll
        for (int i = 0; i < 8; ++i)
#pragma unroll
          for (int ni = 0; ni < NI; ++ni) xv[i][ni] = xin[(size_t)(mb + mi * 32 + crow(hf * 8 + i, h)) * D + nb + ni * 32 + r];
        __builtin_amdgcn_sched_barrier(0);
        float ssv[8];
#pragma unroll
        for (int i = 0; i < 8; ++i) {
          const int row = mb + mi * 32 + crow(hf * 8 + i, h);
          float ss = 0.f;
#pragma unroll
          for (int ni = 0; ni < NI; ++ni) {
            const float v = xv[i][ni] + scale * acc[mi][ni][hf * 8 + i];
            xout[(size_t)row * D + nb + ni * 32 + r] = v;
            if (xb) { xb[(size_t)row * LDH + nb + ni * 32 + r] = to_bf16(v); ss += v * v; }
          }
          ssv[i] = ss;
        }
        if (xb) {
#pragma unroll
          for (int i = 0; i < 8; ++i) { const float t = red32(ssv[i]); if (r == 0) atomicAdd(ssq + mb + mi * 32 + crow(hf * 8 + i, h), t); }
        }
        __builtin_amdgcn_sched_barrier(0);
      }
  }
};
struct EpiLat {
  bf16_t* lat; float* kpe; float* ssq_q; float* ssq_kv; const float* ssq_x;
  template <int MI, int NI> DI void run(f32x16 (&acc)[MI][NI], int mb, int nb, int r, int h) const {
    if (nb >= 1088) return;
    float* ssq = (nb < QL) ? ssq_q : ssq_kv;
#pragma unroll
    for (int mi = 0; mi < MI; ++mi) {
      float rsv[16];
#pragma unroll
      for (int i = 0; i < 16; ++i) rsv[i] = rsqrtf(ssq_x[mb + mi * 32 + crow(i, h)] * (1.f / D) + EPS);
      __builtin_amdgcn_sched_barrier(0);
      if (nb >= 1024) {
#pragma unroll
        for (int i = 0; i < 16; ++i)
#pragma unroll
          for (int ni = 0; ni < NI; ++ni) kpe[(size_t)(mb + mi * 32 + crow(i, h)) * 64 + (nb - 1024) + ni * 32 + r] = acc[mi][ni][i] * rsv[i];
      } else {
        float ssv[16];
#pragma unroll
        for (int i = 0; i < 16; ++i) {
          const int row = mb + mi * 32 + crow(i, h);
          float ss = 0.f;
#pragma unroll
          for (int ni = 0; ni < NI; ++ni) { const float v = acc[mi][ni][i] * rsv[i]; ss += v * v; lat[(size_t)row * LDH + nb + ni * 32 + r] = to_bf16(v); }
          ssv[i] = ss;
        }
#pragma unroll
        for (int i = 0; i < 16; ++i) { const float t = red32(ssv[i]); if (r == 0) atomicAdd(ssq + mb + mi * 32 + crow(i, h), t); }
      }
    }
  }
};
struct EpiQraw {
  bf16_t* q; const float* ssq_q;
  template <int MI, int NI> DI void run(f32x16 (&acc)[MI][NI], int mb, int nb, int r, int h) const {
#pragma unroll
    for (int mi = 0; mi < MI; ++mi)
#pragma unroll
      for (int i = 0; i < 16; ++i) {
        const int row = mb + mi * 32 + crow(i, h);
        const float rs = rsqrtf(ssq_q[row] * (1.f / QL) + EPS);
#pragma unroll
        for (int ni = 0; ni < NI; ++ni) q[(size_t)row * 1536 + nb + ni * 32 + r] = to_bf16(acc[mi][ni][i] * rs);
      }
  }
};
struct EpiKV {
  const float* ssq_kv; const float* kpe; const float* gk; const float* cosT; const float* sinT; bf16_t* kout; bf16_t* vt;
  template <int MI, int NI> DI void run(f32x16 (&acc)[MI][NI], int mb, int nb, int r, int h) const {
    static_assert(MI == 1 && NI == 4, "kv epilogue layout");
    const int b = mb / S, sb = mb % S;
    if (nb < 1024) {
      const int head = nb >> 7;
      const float g0 = gk[r], g1 = gk[32 + r], g2 = gk[64 + r], g3 = gk[96 + r], g4 = gk[128 + r], g5 = gk[160 + r];
#pragma unroll
      for (int i = 0; i < 16; ++i) {
        const int rw = crow(i, h), tok = mb + rw;
        const float rkv = rsqrtf(ssq_kv[tok] * (1.f / KVL) + EPS);
        const float v0 = acc[0][0][i] * rkv, v1 = acc[0][1][i] * rkv, v2 = acc[0][2][i] * rkv, v3 = acc[0][3][i] * rkv;
        const float p1 = kpe[(size_t)tok * 64 + r], p2 = kpe[(size_t)tok * 64 + 32 + r];
        float ss = v0 * v0 + v1 * v1 + v2 * v2 + v3 * v3 + p1 * p1 + p2 * p2;
        ss = red32(ss);
        const float rk = rsqrtf(ss * (1.f / QKH) + EPS);
        bf16_t* kr = kout + ((size_t)(b * NH + head) * S + sb + rw) * QKH;
        kr[r] = to_bf16(v0 * rk * g0); kr[32 + r] = to_bf16(v1 * rk * g1); kr[64 + r] = to_bf16(v2 * rk * g2); kr[96 + r] = to_bf16(v3 * rk * g3);
        const float c = cosT[(size_t)tok * 32 + r], sn = sinT[(size_t)tok * 32 + r];
        const float x1 = p1 * rk * g4, x2 = p2 * rk * g5;
        kr[128 + r] = to_bf16(x1 * c - x2 * sn); kr[160 + r] = to_bf16(x2 * c + x1 * sn);
      }
    } else {
      const int head = (nb - 1024) >> 7;
      float rkv[16];
#pragma unroll
      for (int i = 0; i < 16; ++i) rkv[i] = rsqrtf(ssq_kv[mb + crow(i, h)] * (1.f / KVL) + EPS);
#pragma unroll
      for (int ni = 0; ni < 4; ++ni) {
        bf16_t* vr = vt + ((size_t)(b * NH + head) * VH + ni * 32 + r) * SV + sb;
#pragma unroll
        for (int a = 0; a < 4; ++a) {
          u32x2 o;
          o.x = pack_bf16(acc[0][ni][4 * a] * rkv[4 * a], acc[0][ni][4 * a + 1] * rkv[4 * a + 1]);
          o.y = pack_bf16(acc[0][ni][4 * a + 2] * rkv[4 * a + 2], acc[0][ni][4 * a + 3] * rkv[4 * a + 3]);
          *(u32x2*)(vr + 16 * (a >> 1) + 8 * h + 4 * (a & 1)) = o;
        }
      }
    }
  }
};


DI int lds_byte2(int r, int c) { const int st = (r >> 4) * 2 + (c >> 5), ob = (r & 15) * 64 + (c & 31) * 2; return st * 1024 + (ob ^ (((ob >> 9) & 1) << 5)); }
DI void stage_rc2(int b, int& R, int& C) { const int st = b >> 10, sb = b & 1023, swz = sb ^ (((sb >> 9) & 1) << 5); R = (st >> 1) * 16 + swz / 64; C = (st & 1) * 32 + (swz % 64) / 2; }
#define MFMA16(a, b, c) __builtin_amdgcn_mfma_f32_16x16x32_bf16((a), (b), (c), 0, 0, 0)
constexpr int G8_TILE_B = 256 * 64 * 2, G8_STAGE_B = 2 * G8_TILE_B;

template <class Epi>
DI void gemm8_tile(const bf16_t* __restrict__ Ab, int lda, const bf16_t* __restrict__ Bb, int ldb, int K, int brow, int bcol, const Epi epi,
                   bool staged, bool has_next, const bf16_t* __restrict__ Abn, const bf16_t* __restrict__ Bbn) {
  const int tid = opaque_tid512(), wid = tid >> 6, lane = tid & 63, wr = wid >> 2, wc = wid & 3, fr = lane & 15, fq = lane >> 4;
  unsigned aoff[4], boff[4];
#pragma unroll
  for (int i = 0; i < 4; ++i) { int R, C; stage_rc2(wid * 1024 + i * 8192 + lane * 16, R, C); aoff[i] = (unsigned)R * (unsigned)lda + (unsigned)C; boff[i] = (unsigned)R * (unsigned)ldb + (unsigned)C; }
#define G8_STAGE_R(buf_, ap_, bp_, i0_, i1_)                                                                         \
  {                                                                                                                  \
    const bf16_t* ag_ = (ap_); const bf16_t* bg_ = (bp_);                                                            \
    _Pragma("unroll") for (int i = (i0_); i < (i1_); ++i) {                                                          \
      __builtin_amdgcn_global_load_lds((const unsigned*)(ag_ + aoff[i]), (unsigned*)(smem + (buf_) * G8_STAGE_B + wid * 1024 + i * 8192), 16, 0, 0);              \
      __builtin_amdgcn_global_load_lds((const unsigned*)(bg_ + boff[i]), (unsigned*)(smem + (buf_) * G8_STAGE_B + G8_TILE_B + wid * 1024 + i * 8192), 16, 0, 0);  \
    }                                                                                                                \
  }
#define G8_STAGE(buf_, ap_, bp_) G8_STAGE_R(buf_, ap_, bp_, 0, 4)
  f32x4 acc[8][4];
#pragma unroll
  for (int m = 0; m < 8; ++m)
#pragma unroll
    for (int n = 0; n < 4; ++n) acc[m][n] = (f32x4){0.f, 0.f, 0.f, 0.f};
  const int nt = K / 64;
  if (!staged) {
    G8_STAGE(0, Ab, Bb);
    asm volatile("s_waitcnt vmcnt(0)" ::: "memory");
    __syncthreads();
  }
  for (int t = 0; t < nt; ++t) {
    const int cur = t & 1;
    const unsigned char* sa = smem + cur * G8_STAGE_B;
    const unsigned char* sb = sa + G8_TILE_B;
#pragma unroll
    for (int ks = 0; ks < 2; ++ks) {
      bf16x8 At[8], Bf[4];
#pragma unroll
      for (int m = 0; m < 8; ++m) At[m] = *(const bf16x8*)(sa + lds_byte2(wr * 128 + m * 16 + fr, ks * 32 + fq * 8));
#pragma unroll
      for (int n = 0; n < 4; ++n) Bf[n] = *(const bf16x8*)(sb + lds_byte2(wc * 64 + n * 16 + fr, ks * 32 + fq * 8));
      {
        __builtin_amdgcn_sched_barrier(0);
        if (t + 1 < nt) { G8_STAGE_R(cur ^ 1, Ab + (t + 1) * 64, Bb + (t + 1) * 64, 2 * ks, 2 * ks + 2); }
        else if (has_next) { G8_STAGE_R(0, Abn, Bbn, 2 * ks, 2 * ks + 2); }
        __builtin_amdgcn_sched_barrier(0);
      }
#pragma unroll
      for (int m = 0; m < 8; ++m)
#pragma unroll
        for (int n = 0; n < 4; ++n) acc[m][n] = MFMA16(At[m], Bf[n], acc[m][n]);
      __builtin_amdgcn_sched_barrier(0);
    }
    asm volatile("s_waitcnt vmcnt(0)" ::: "memory");
    __syncthreads();
  }
#undef G8_STAGE
#undef G8_STAGE_R
  epi.run8(acc, brow + wr * 128, bcol + wc * 64, fr, fq);
  if (Epi::LDS_SCRATCH) __syncthreads();
}

DI void g8_decode(int u, int x, int nN, int& pm, int& pn) {
  const int ng = u >> 6, rem = u & 63;
  int gn = nN - 4 * ng; if (gn > 4) gn = 4;
  const int mg = rem / (8 * gn), jj = rem % (8 * gn);
  pm = 16 * x + 8 * mg + (jj & 7); pn = 4 * ng + (jj >> 3);
}
template <class Epi>
DI void gemm8_phase(int x, int j, const bf16_t* __restrict__ A, int lda, const bf16_t* __restrict__ Bt, int K, int N, int a_grp, const Epi epi) {
  const int nN = N / 256, nb = gridDim.x >> 3, ldb = K + PADK;
  const int total = 16 * nN;
  bool staged = false;
  for (int u = j; u < total; u += nb) {
    int pm, pn; g8_decode(u, x, nN, pm, pn);
    const int brow = pm * 256, bcol = pn * 256;
    const bf16_t* Ab = A + (size_t)brow * lda + (a_grp ? (bcol / a_grp) * K : 0);
    const bf16_t* Bb = Bt + (size_t)bcol * ldb;
    const bool has_next = (u + nb < total);
    const bf16_t* Abn = Ab; const bf16_t* Bbn = Bb;
    if (has_next) {
      int pm2, pn2; g8_decode(u + nb, x, nN, pm2, pn2);
      Abn = A + (size_t)(pm2 * 256) * lda + (a_grp ? ((pn2 * 256) / a_grp) * K : 0);
      Bbn = Bt + (size_t)(pn2 * 256) * ldb;
    }
    gemm8_tile<Epi>(Ab, lda, Bb, ldb, K, brow, bcol, epi, staged, has_next, Abn, Bbn);
    staged = has_next;
  }
}
DI float red16(float v) { v += __shfl_xor(v, 1); v += __shfl_xor(v, 2); v += __shfl_xor(v, 4); v += __shfl_xor(v, 8); return v; }

struct EpiGU8 {
  static constexpr bool LDS_SCRATCH = true;
  bf16_t* act; const float* ssq;
  DI void run8(f32x4 (&acc)[8][4], int rb, int cb, int fr, int fq) const {
    const int lane = fq * 16 + fr, wid = (int)(threadIdx.x >> 6);
    bf16_t* scr = (bf16_t*)(smem + G8_STAGE_B + wid * 1280);
    const int srow = lane >> 2, sch = lane & 3;
    bf16_t* ap = act + (size_t)(rb + srow) * LDA + (cb >> 1) + sch * 8;
    float rsv[8][4];
#pragma unroll
    for (int m = 0; m < 8; ++m)
#pragma unroll
      for (int j = 0; j < 4; ++j) rsv[m][j] = rsqrtf(ssq[rb + m * 16 + fq * 4 + j] * (1.f / D) + EPS);
#pragma unroll
    for (int m = 0; m < 8; ++m) {
#pragma unroll
      for (int j = 0; j < 4; ++j)
#pragma unroll
        for (int pi = 0; pi < 2; ++pi) {
          const float g = acc[m][2 * pi][j] * rsv[m][j], u = acc[m][2 * pi + 1][j] * rsv[m][j];
          const float a = g * __builtin_amdgcn_rcpf(1.f + __expf(-g)) * u;
          scr[(fq * 4 + j) * 40 + pi * 16 + fr] = to_bf16(a);
        }
      __builtin_amdgcn_sched_barrier(0);
      const u32x4 o = *(const u32x4*)(scr + srow * 40 + sch * 8);
      *(u32x4*)(ap + (size_t)(m * 16) * LDA) = o;
      __builtin_amdgcn_sched_barrier(0);
    }
  }
};
struct EpiResid8 {
  static constexpr bool LDS_SCRATCH = true;
  const float* xin; float* xout; float scale; bf16_t* xb; float* ssq;
  DI void run8(f32x4 (&acc)[8][4], int rb, int cb, int fr, int fq) const {
    const int lane = fq * 16 + fr, wid = (int)(threadIdx.x >> 6);
    const float sc = scale; bf16_t* const xbp = xb; float* const ssqp = ssq;
    float* scr = (float*)(smem + G8_STAGE_B + wid * 4352);
    const int prow = lane >> 4, c4 = lane & 15;
    const float* xp = xin + (size_t)(rb + prow) * D + cb + c4 * 4;
    float* op = xout + (size_t)(rb + prow) * D + cb + c4 * 4;
#pragma unroll
    for (int mh = 0; mh < 2; ++mh) {
      f32x4 xv[4][4];
#pragma unroll
      for (int mm = 0; mm < 4; ++mm)
#pragma unroll
        for (int ps = 0; ps < 4; ++ps) xv[mm][ps] = __builtin_nontemporal_load((const f32x4*)(xp + (size_t)((mh * 4 + mm) * 16 + ps * 4) * D));
      __builtin_amdgcn_sched_barrier(0);
#pragma unroll
      for (int mm = 0; mm < 4; ++mm) {
        const int m = mh * 4 + mm;
#pragma unroll
        for (int n = 0; n < 4; ++n)
#pragma unroll
          for (int j = 0; j < 4; ++j) scr[(fq * 4 + j) * 68 + n * 16 + fr] = acc[m][n][j];
        __builtin_amdgcn_sched_barrier(0);
#pragma unroll
        for (int ps = 0; ps < 4; ++ps) {
          const f32x4 a = *(const f32x4*)(scr + (ps * 4 + prow) * 68 + c4 * 4);
          f32x4 v;
          v.x = xv[mm][ps].x + a.x * sc; v.y = xv[mm][ps].y + a.y * sc; v.z = xv[mm][ps].z + a.z * sc; v.w = xv[mm][ps].w + a.w * sc;
          const int grow = rb + m * 16 + ps * 4 + prow;
          __builtin_nontemporal_store(v, (f32x4*)(op + (size_t)(m * 16 + ps * 4) * D));
          if (xbp) {
            u32x2 o; o.x = pack_bf16(v.x, v.y); o.y = pack_bf16(v.z, v.w);
            *(u32x2*)(xbp + (size_t)grow * LDH + cb + c4 * 4) = o;
            const float t = red16(v.x * v.x + v.y * v.y + v.z * v.z + v.w * v.w);
            if (c4 == 0) atomicAdd(ssqp + grow, t);
          }
        }
        __builtin_amdgcn_sched_barrier(0);
      }
    }
  }
};
struct EpiLat8 {
  static constexpr bool LDS_SCRATCH = false;
  bf16_t* lat; float* kpe; float* ssq_q; float* ssq_kv; const float* ssq_x;
  DI void run8(f32x4 (&acc)[8][4], int rb, int cb, int fr, int fq) const {
    if (cb >= 1088) return;
    float* ssq = (cb < QL) ? ssq_q : ssq_kv;
#pragma unroll
    for (int mp = 0; mp < 2; ++mp) {
      float rsv[4][4];
#pragma unroll
      for (int mm = 0; mm < 4; ++mm)
#pragma unroll
        for (int j = 0; j < 4; ++j) rsv[mm][j] = rsqrtf(ssq_x[rb + (4 * mp + mm) * 16 + fq * 4 + j] * (1.f / D) + EPS);
      __builtin_amdgcn_sched_barrier(0);
#pragma unroll
      for (int mm = 0; mm < 4; ++mm) {
        float ssv[4];
#pragma unroll
        for (int j = 0; j < 4; ++j) {
          const int row = rb + (4 * mp + mm) * 16 + fq * 4 + j;
          float ss = 0.f;
#pragma unroll
          for (int n = 0; n < 4; ++n) {
            const float v = acc[4 * mp + mm][n][j] * rsv[mm][j];
            if (cb >= 1024) kpe[(size_t)row * 64 + (cb - 1024) + n * 16 + fr] = v;
            else { lat[(size_t)row * LDH + cb + n * 16 + fr] = to_bf16(v); ss += v * v; }
          }
          ssv[j] = ss;
        }
        if (cb < 1024) {
#pragma unroll
          for (int j = 0; j < 4; ++j) { const float t = red16(ssv[j]); if (fr == 0) atomicAdd(ssq + rb + (4 * mp + mm) * 16 + fq * 4 + j, t); }
        }
      }
    }
  }
};
struct EpiQraw8 {
  static constexpr bool LDS_SCRATCH = false;
  bf16_t* q; const float* ssq_q;
  DI void run8(f32x4 (&acc)[8][4], int rb, int cb, int fr, int fq) const {
#pragma unroll
    for (int m = 0; m < 8; ++m)
#pragma unroll
      for (int j = 0; j < 4; ++j) {
        const int row = rb + m * 16 + fq * 4 + j;
        const float rs = rsqrtf(ssq_q[row] * (1.f / QL) + EPS);
#pragma unroll
        for (int n = 0; n < 4; ++n) q[(size_t)row * 1536 + cb + n * 16 + fr] = to_bf16(acc[m][n][j] * rs);
      }
  }
};

DI void norm0_phase(const float* __restrict__ x, bf16_t* __restrict__ hb, float* __restrict__ ssq) {
  const int tid = opaque_tid512();
  const int lane = tid & 63, gw = blockIdx.x * 8 + (tid >> 6), nw = gridDim.x * 8;
  for (int row = gw; row < T; row += nw) {
    const f32x4* xr = (const f32x4*)(x + (size_t)row * D);
    f32x4 v[4];
    float ss = 0.f;
#pragma unroll
    for (int c = 0; c < 4; ++c) { v[c] = __builtin_nontemporal_load(xr + c * 64 + lane); ss += v[c].x * v[c].x + v[c].y * v[c].y + v[c].z * v[c].z + v[c].w * v[c].w; }
    ss = red64(ss);
    if (lane == 0) ssq[row] = ss;
#pragma unroll
    for (int c = 0; c < 4; ++c) {
      u32x2 o; o.x = pack_bf16(v[c].x, v[c].y); o.y = pack_bf16(v[c].z, v[c].w);
      *(u32x2*)(hb + (size_t)row * LDH + (c * 64 + lane) * 4) = o;
    }
  }
}

template <int W>
DI void pool_rows(const float* __restrict__ x, const float* smr, bf16_t* __restrict__ pb, int t0, int s0, int tid) {
  const int tq0 = t0 - s0;
  const float* xq = x + tid * 4;
  f32x4 Sm = {0.f, 0.f, 0.f, 0.f};
#pragma unroll
  for (int i = 1; i < W; ++i) {
    int t = t0 - i; if (t < tq0) t = tq0;
    Sm += *(const f32x4*)(xq + (size_t)t * D) * smr[15 - i];
  }
#pragma unroll 8
  for (int tl = 0; tl < 64; ++tl) {
    const int t = t0 + tl, s = s0 + tl;
    int to = t - W + 1; if (to < tq0) to = tq0;
    const f32x4 hn = *(const f32x4*)(xq + (size_t)t * D) * smr[15 + tl];
    const f32x4 ho = *(const f32x4*)(xq + (size_t)to * D) * smr[15 + tl - W + 1];
    const int cnt = (s + 1 < W) ? (s + 1) : W;
    const float ic = 1.f / (float)cnt;
    Sm += hn;
    const f32x4 p = Sm * ic - hn;
    Sm -= ho;
    u32x2 o; o.x = pack_bf16(p.x, p.y); o.y = pack_bf16(p.z, p.w);
    *(u32x2*)(pb + (size_t)t * LDH + tid * 4) = o;
  }
}
DI void poolprep_phase(int vb, int nvb, const float* __restrict__ x, const float* __restrict__ ssq, bf16_t* __restrict__ pb, float* smf) {
  const int tid = opaque_tid(), wave = tid >> 6;
  for (int c0 = 0; c0 < T / 64; c0 += nvb) {
    const int ch = c0 + vb;
    const bool on = ch < T / 64;
    const int t0 = ch * 64, s0 = t0 & (S - 1);
    if (on && tid < 79) smf[tid] = (s0 + tid >= 15) ? rsqrtf(ssq[t0 - 15 + tid] * (1.f / D) + EPS) : 0.f;
    __syncthreads();
    if (on) {
      if (wave == 0) pool_rows<2>(x, smf, pb, t0, s0, tid);
      else if (wave == 1) pool_rows<4>(x, smf, pb, t0, s0, tid);
      else if (wave == 2) pool_rows<8>(x, smf, pb, t0, s0, tid);
      else pool_rows<16>(x, smf, pb, t0, s0, tid);
    }
    __syncthreads();
  }
}

constexpr int KLS = QKH + 8;
constexpr int VLS = 64 + 8;
constexpr int K_EL = 64 * KLS;
constexpr int ATT_STG_EL = K_EL + 128 * VLS;

DI void attn_phase(const bf16_t* __restrict__ qraw, const bf16_t* __restrict__ kbuf, const bf16_t* __restrict__ vtb, bf16_t* __restrict__ obuf,
                   const float* __restrict__ gq, const float* __restrict__ cosT, const float* __restrict__ sinT, bf16_t* sm, int x, int j) {
  const int nb = gridDim.x >> 3;
  for (int p = j; p < 64; p += nb) {
    const int bh = 2 * x + (p >> 5);
    const int b = bh >> 3, hd = bh & 7;
    for (int half = 0; half < 2; ++half) {
      const int tid = opaque_tid512(), lane = tid & 63, wave = tid >> 6, r = lane & 31, h = lane >> 5;
      const int qb = half ? (p & 31) : (63 - (p & 31));
      const int q0 = qb * 256 + wave * 32;
      const size_t tok = (size_t)b * S + q0 + r;
      bf16x8 qf[12];
      {
        const bf16_t* qp = qraw + tok * 1536 + hd * QKH + h * 8;
#pragma unroll
        for (int st = 0; st < 12; ++st) qf[st] = *(const bf16x8*)(qp + st * 16);
        float ss = 0.f;
#pragma unroll
        for (int st = 0; st < 12; ++st) {
#pragma unroll
          for (int e = 0; e < 8; ++e) { const float f = bf2f(qf[st][e]); ss += f * f; }
          u32x4 t = __builtin_bit_cast(u32x4, qf[st]);
          asm volatile("" : "+v"(t));
          qf[st] = __builtin_bit_cast(bf16x8, t);
        }
        ss += __shfl_xor(ss, 32);
        const float rq = rsqrtf(ss * (1.f / QKH) + EPS) * (0.07216878364870322f * 1.4426950408889634f);
        __builtin_amdgcn_sched_barrier(0);
#pragma unroll
        for (int st = 0; st < 8; ++st) {
          const f32x4 ga = *(const f32x4*)(gq + st * 16 + h * 8), gb = *(const f32x4*)(gq + st * 16 + h * 8 + 4);
          u32x4 o;
          o.x = pack_bf16(bf2f(qf[st][0]) * rq * ga.x, bf2f(qf[st][1]) * rq * ga.y);
          o.y = pack_bf16(bf2f(qf[st][2]) * rq * ga.z, bf2f(qf[st][3]) * rq * ga.w);
          o.z = pack_bf16(bf2f(qf[st][4]) * rq * gb.x, bf2f(qf[st][5]) * rq * gb.y);
          o.w = pack_bf16(bf2f(qf[st][6]) * rq * gb.z, bf2f(qf[st][7]) * rq * gb.w);
          asm volatile("" : "+v"(o));
          qf[st] = __builtin_bit_cast(bf16x8, o);
          __builtin_amdgcn_sched_barrier(0);
        }
#pragma unroll
        for (int st = 8; st < 10; ++st) {
          const int jb = (st - 8) * 16 + h * 8;
          u32x4 o1, o2;
#pragma unroll
          for (int hf = 0; hf < 2; ++hf) {
            const f32x4 g1 = *(const f32x4*)(gq + 128 + jb + 4 * hf), g2 = *(const f32x4*)(gq + 160 + jb + 4 * hf);
            const f32x4 cc = *(const f32x4*)(cosT + tok * 32 + jb + 4 * hf), sn = *(const f32x4*)(sinT + tok * 32 + jb + 4 * hf);
            float y1[4], y2[4];
#pragma unroll
            for (int e = 0; e < 4; ++e) {
              const float x1 = bf2f(qf[st][4 * hf + e]) * rq * g1[e], x2 = bf2f(qf[st + 2][4 * hf + e]) * rq * g2[e];
              y1[e] = x1 * cc[e] - x2 * sn[e]; y2[e] = x2 * cc[e] + x1 * sn[e];
            }
            if (hf == 0) { o1.x = pack_bf16(y1[0], y1[1]); o1.y = pack_bf16(y1[2], y1[3]); o2.x = pack_bf16(y2[0], y2[1]); o2.y = pack_bf16(y2[2], y2[3]); }
            else { o1.z = pack_bf16(y1[0], y1[1]); o1.w = pack_bf16(y1[2], y1[3]); o2.z = pack_bf16(y2[0], y2[1]); o2.w = pack_bf16(y2[2], y2[3]); }
          }
          asm volatile("" : "+v"(o1), "+v"(o2));
          qf[st] = __builtin_bit_cast(bf16x8, o1); qf[st + 2] = __builtin_bit_cast(bf16x8, o2);
          __builtin_amdgcn_sched_barrier(0);
        }
      }
      f32x16 oacc[4];
#pragma unroll
      for (int mt = 0; mt < 4; ++mt)
#pragma unroll
        for (int i = 0; i < 16; ++i) oacc[mt][i] = 0.f;
      float m_run = -1e30f, l_run = 0.f;
      const int nkt = 4 * qb + 4;
      const bf16_t* kg = kbuf + (size_t)bh * S * QKH;
      const bf16_t* vg = vtb + (size_t)bh * VH * SV;
      u32x4 rk[3], rv[2];
      const unsigned kg_off0 = (unsigned)(tid >> 3) * QKH + (unsigned)(tid & 7) * 8u;
      const unsigned vg_off0 = (unsigned)(tid >> 3) * (unsigned)SV + (unsigned)(tid & 7) * 8u;
      const unsigned kl_off = (unsigned)(tid >> 3) * KLS + (unsigned)(tid & 7) * 8u;
      const unsigned vl_off = (unsigned)(tid >> 3) * VLS + (unsigned)(tid & 7) * 8u;
#define ALOAD(kt_)                                                                                                     \
  {                                                                                                                    \
    const bf16_t* kgt_ = kg + (size_t)(kt_) * 64 * QKH; const bf16_t* vgt_ = vg + (kt_) * 64;                          \
    unsigned kg_off = kg_off0, vg_off = vg_off0; asm volatile("" : "+v"(kg_off), "+v"(vg_off));                        \
    _Pragma("unroll") for (int i = 0; i < 3; ++i) rk[i] = *(const u32x4*)(kgt_ + (kg_off + (unsigned)(i * 64)));       \
    _Pragma("unroll") for (int i = 0; i < 2; ++i) rv[i] = *(const u32x4*)(vgt_ + (vg_off + (unsigned)(i * 64) * (unsigned)SV)); \
  }
      ALOAD(0);
#define ASTORE(stg_)                                                                                                   \
  {                                                                                                                    \
    bf16_t* sk_ = sm + (stg_) * ATT_STG_EL; bf16_t* sv_ = sk_ + K_EL;                                                  \
    _Pragma("unroll") for (int i = 0; i < 3; ++i) *(u32x4*)(sk_ + kl_off + i * 64) = rk[i];                            \
    _Pragma("unroll") for (int i = 0; i < 2; ++i) *(u32x4*)(sv_ + vl_off + i * 64 * VLS) = rv[i];                      \
  }
      ASTORE(0);
      __syncthreads();
      for (int kt = 0; kt < nkt; ++kt) {
        const bf16_t* smk = sm + (kt & 1) * ATT_STG_EL;
        const bf16_t* smv = smk + K_EL;
        if (kt + 1 < nkt) ALOAD(kt + 1);
        __builtin_amdgcn_sched_barrier(0);
        if (kt * 64 <= q0 + 31) {
        f32x16 sacc[2];
#pragma unroll
        for (int mt = 0; mt < 2; ++mt)
#pragma unroll
          for (int i = 0; i < 16; ++i) sacc[mt][i] = 0.f;
        const bf16_t* kp = smk + r * KLS + h * 8;
        {
          bf16x8 ka = *(const bf16x8*)(kp), kb = *(const bf16x8*)(kp + 32 * KLS);
#pragma unroll
          for (int st = 0; st < 12; ++st) {
            bf16x8 na = ka, nbq = kb;
            if (st + 1 < 12) { na = *(const bf16x8*)(kp + (st + 1) * 16); nbq = *(const bf16x8*)(kp + 32 * KLS + (st + 1) * 16); }
            sacc[0] = MFMA(ka, qf[st], sacc[0]);
            sacc[1] = MFMA(kb, qf[st], sacc[1]);
            ka = na; kb = nbq;
            __builtin_amdgcn_sched_barrier(0);
          }
        }
        if (kt * 64 + 63 > q0) {
          const int qpos = q0 + r;
#pragma unroll
          for (int mt = 0; mt < 2; ++mt)
#pragma unroll
            for (int i = 0; i < 16; ++i) { const int key = kt * 64 + mt * 32 + crow(i, h); if (key > qpos) sacc[mt][i] = -INFINITY; }
        }
        float mx = sacc[0][0];
#pragma unroll
        for (int mt = 0; mt < 2; ++mt)
#pragma unroll
          for (int i = 0; i < 16; ++i) mx = fmaxf(mx, sacc[mt][i]);
        mx = fmaxf(mx, __shfl_xor(mx, 32));
        const float m_new = fmaxf(m_run, mx);
        const float alpha = __builtin_amdgcn_exp2f(m_run - m_new);
        m_run = m_new;
        float rs = 0.f;
#pragma unroll
        for (int mt = 0; mt < 2; ++mt)
#pragma unroll
          for (int i = 0; i < 16; ++i) { const float pv = __builtin_amdgcn_exp2f(sacc[mt][i] - m_new); sacc[mt][i] = pv; rs += pv; }
        rs += __shfl_xor(rs, 32);
        l_run = l_run * alpha + rs;
        if (__any(alpha != 1.f)) {
#pragma unroll
          for (int mt = 0; mt < 4; ++mt)
#pragma unroll
            for (int i = 0; i < 16; ++i) oacc[mt][i] *= alpha;
        }
        bf16x8 pf[4];
#pragma unroll
        for (int ks = 0; ks < 4; ++ks) {
          u32x4 o;
          o.x = pack_bf16(sacc[ks >> 1][8 * (ks & 1) + 0], sacc[ks >> 1][8 * (ks & 1) + 1]);
          o.y = pack_bf16(sacc[ks >> 1][8 * (ks & 1) + 2], sacc[ks >> 1][8 * (ks & 1) + 3]);
          o.z = pack_bf16(sacc[ks >> 1][8 * (ks & 1) + 4], sacc[ks >> 1][8 * (ks & 1) + 5]);
          o.w = pack_bf16(sacc[ks >> 1][8 * (ks & 1) + 6], sacc[ks >> 1][8 * (ks & 1) + 7]);
          pf[ks] = __builtin_bit_cast(bf16x8, o);
        }
        const bf16_t* vp = smv + r * VLS + h * 8;
        __builtin_amdgcn_sched_barrier(0);
        {
          bf16x8 va[2][4];
#pragma unroll
          for (int mt = 0; mt < 4; ++mt) va[0][mt] = *(const bf16x8*)(vp + mt * 32 * VLS);
#pragma unroll
          for (int ks = 0; ks < 4; ++ks) {
            if (ks + 1 < 4) {
#pragma unroll
              for (int mt = 0; mt < 4; ++mt) va[(ks + 1) & 1][mt] = *(const bf16x8*)(vp + mt * 32 * VLS + (ks + 1) * 16);
            }
#pragma unroll
            for (int mt = 0; mt < 4; ++mt) oacc[mt] = MFMA(va[ks & 1][mt], pf[ks], oacc[mt]);
            __builtin_amdgcn_sched_barrier(0);
          }
        }
        }
        if (kt + 1 < nkt) ASTORE((kt + 1) & 1);
        __syncthreads();
      }
#undef ALOAD
#undef ASTORE
      const float inv = 1.f / l_run;
      bf16_t* op = obuf + tok * LDH + hd * VH + 4 * h;
#pragma unroll
      for (int mt = 0; mt < 4; ++mt)
#pragma unroll
        for (int a = 0; a < 4; ++a) {
          u32x2 o;
          o.x = pack_bf16(oacc[mt][4 * a] * inv, oacc[mt][4 * a + 1] * inv);
          o.y = pack_bf16(oacc[mt][4 * a + 2] * inv, oacc[mt][4 * a + 3] * inv);
          *(u32x2*)(op + mt * 32 + 8 * a) = o;
        }
      __syncthreads();
    }
  }
}

typedef Cfg<4, 1, 1, 4, 64, 1> CR;

__global__ void __launch_bounds__(512, 2) fwd_megakernel(Params p) {
  cg::grid_group grid = cg::this_grid();
  unsigned char* ws = p.ws;
  const float* x_in = p.in[0];
  const int* positions = (const int*)p.in[1];
  float* out = p.out;
  bf16_t* wgu1 = (bf16_t*)(ws + OFF_WGU1); bf16_t* wdn1 = (bf16_t*)(ws + OFF_WDN1);
  bf16_t* wgu2 = (bf16_t*)(ws + OFF_WGU2); bf16_t* wdn2 = (bf16_t*)(ws + OFF_WDN2);
  bf16_t* wpool = (bf16_t*)(ws + OFF_WPOOL); bf16_t* win = (bf16_t*)(ws + OFF_WIN); bf16_t* wq = (bf16_t*)(ws + OFF_WQ);
  bf16_t* wkv = (bf16_t*)(ws + OFF_WKV); bf16_t* wout = (bf16_t*)(ws + OFF_WOUT);
  float* cosT = (float*)(ws + OFF_COS); float* sinT = (float*)(ws + OFF_SIN);
  float* ssq_all = (float*)(ws + OFF_SSQ);
  float* kpe = (float*)(ws + OFF_KPE);
  bf16_t* hb = (bf16_t*)(ws + OFF_HB);
  bf16_t* act = (bf16_t*)(ws + OFF_ACT); bf16_t* lat = (bf16_t*)(ws + OFF_LAT); bf16_t* qraw = (bf16_t*)(ws + OFF_QRAW);
  bf16_t* kbuf = (bf16_t*)(ws + OFF_K); bf16_t* vtb = (bf16_t*)(ws + OFF_VT);
  bf16_t* obuf = lat; bf16_t* pooled = (bf16_t*)(ws + OFF_POOLED);
  const int gt = blockIdx.x * 512 + threadIdx.x, gs = gridDim.x * 512;
  const int vhalf = __builtin_amdgcn_readfirstlane((int)(threadIdx.x >> 8));
  const int vb = blockIdx.x * 2 + vhalf, nvb = gridDim.x * 2;
  bf16_t* smh = (bf16_t*)(smem + vhalf * VHALF_BYTES);
  float* smf = (float*)(smem + vhalf * VHALF_BYTES);

  unsigned* ctl = (unsigned*)(ws + OFF_CTL);
  if (threadIdx.x == 0) {
    const unsigned xcc = (unsigned)__builtin_amdgcn_s_getreg((3 << 11) | 20) & 0x7u;
    const unsigned rank = atomicAdd(ctl + xcc, 1u);
    ((volatile int*)smem)[0] = (int)xcc; ((volatile int*)smem)[1] = (int)rank;
  }
  __syncthreads();
  int xs = __builtin_amdgcn_readfirstlane(((volatile int*)smem)[0]);
  int js = __builtin_amdgcn_readfirstlane(((volatile int*)smem)[1]);
  __syncthreads();

  for (int idx = gt; idx < T * 32; idx += gs) {
    const int t = idx >> 5, jf = idx & 31;
    const float inv_freq = exp2f(-(float)jf * 0.41524101186092029f);
    const float ang = (float)positions[t] * inv_freq;
    const double rev = (double)ang * 0.15915494309189535;
    const float fr = (float)(rev - rint(rev));
    cosT[idx] = __builtin_amdgcn_cosf(fr);
    sinT[idx] = __builtin_amdgcn_sinf(fr);
  }
  for (int i = gt; i < 15 * T; i += gs) ssq_all[T + i] = 0.f;
  norm0_phase(x_in, hb, ssq_all);
  for (int jl = 0; jl < 2; ++jl) {
    for (int g = 0; g < 4; ++g)
      prep_w(vb, nvb, p.in[7] + ((size_t)jl * 4 + g) * 65536, wpool + ((size_t)jl * 4 + g) * 256 * (256 + PADK), 256, 256, p.in[6] + (size_t)(2 * jl) * D + g * 256, p.in[8] + (size_t)jl * D + g * 256, 0, smf);
    prep_w(vb, nvb, p.in[9] + (size_t)jl * D * 1088, win + (size_t)jl * LATNP * (D + PADK), D, 1088, p.in[6] + (size_t)(2 * jl + 1) * D, nullptr, 0, smf);
    for (int i = gt; i < (LATNP - 1088) * (D + PADK) / 8; i += gs) ((u32x4*)(win + (size_t)jl * LATNP * (D + PADK) + (size_t)1088 * (D + PADK)))[i] = (u32x4){0u, 0u, 0u, 0u};
    prep_w(vb, nvb, p.in[11] + (size_t)jl * QL * 1536, wq + (size_t)jl * 1536 * (QL + PADK), QL, 1536, p.in[10] + (size_t)jl * QL, nullptr, 0, smf);
    prep_w(vb, nvb, p.in[13] + (size_t)jl * KVL * 2048, wkv + (size_t)jl * 2048 * (KVL + PADK), KVL, 2048, p.in[12] + (size_t)jl * KVL, nullptr, 3, smf);
    prep_w(vb, nvb, p.in[16] + (size_t)jl * D * D, wout + (size_t)jl * D * (D + PADK), D, D, nullptr, nullptr, 0, smf);
  }
#define PREP_FFN1(L_) { const size_t wo_ = (size_t)(L_) * D * FF; \
    prep_w(vb, nvb, p.in[3] + wo_, wgu1, D, FF, p.in[2] + (size_t)(L_) * D, nullptr, 1, smf); \
    prep_w(vb, nvb, p.in[4] + wo_, wgu1, D, FF, p.in[2] + (size_t)(L_) * D, nullptr, 2, smf); \
    prep_w(vb, nvb, p.in[5] + wo_, wdn1, FF, D, nullptr, nullptr, 0, smf); }
#define PREP_FFN2(L_) { const size_t wo_ = (size_t)(L_) * D * FF; \
    prep_w(vb, nvb, p.in[18] + wo_, wgu2, D, FF, p.in[17] + (size_t)(L_) * D, nullptr, 1, smf); \
    prep_w(vb, nvb, p.in[19] + wo_, wgu2, D, FF, p.in[17] + (size_t)(L_) * D, nullptr, 2, smf); \
    prep_w(vb, nvb, p.in[20] + wo_, wdn2, FF, D, nullptr, nullptr, 0, smf); }
  PREP_FFN1(0);
  PREP_FFN2(0);
  grid.sync();
  {
    bool even = true;
    for (int i = 0; i < 8; ++i) even = even && (__hip_atomic_load(ctl + i, __ATOMIC_RELAXED, __HIP_MEMORY_SCOPE_AGENT) == (gridDim.x >> 3));
    if (!even || js >= (int)(gridDim.x >> 3)) { xs = blockIdx.x & 7; js = blockIdx.x >> 3; }
  }
  unsigned bar_target = 0;
#define GBAR() { bar_target += gridDim.x; grid_bar(ctl + 32, bar_target); }
  unsigned xbar_target = 0;
#define XBAR() { xbar_target += (gridDim.x >> 3); grid_bar(ctl + 48 + xs, xbar_target); }
  const int jv = js * 2 + vhalf, nbv = (int)(gridDim.x >> 3) * 2;

  for (int layer = 0; layer < DEPTH; ++layer) {
    const float* xcur = (layer == 0) ? x_in : out;
    float* ssq0 = ssq_all + (size_t)(layer * 3 + 0) * T;
    float* ssq1 = ssq_all + (size_t)(layer * 3 + 1) * T;
    float* ssq2 = ssq_all + (size_t)(layer * 3 + 2) * T;
    float* ssq_next = ssq_all + (size_t)((layer + 1) * 3) * T;
    const int jl = layer >> 1;
    float* ssq_q = ssq_all + (size_t)(12 + jl) * T;
    float* ssq_kv = ssq_all + (size_t)(14 + jl) * T;
    if (layer > 0) PREP_FFN2(layer);
    gemm8_phase(xs, js, hb, LDH, wgu1, D, 2 * FF, 0, EpiGU8{act, ssq0});
    XBAR();
    gemm8_phase(xs, js, act, LDA, wdn1, FF, D, 0, EpiResid8{xcur, out, 0.5f, hb, ssq1});
    GBAR();
    if (layer + 1 < DEPTH) PREP_FFN1(layer + 1);
    if ((layer & 1) == 0) {
      poolprep_phase(vb, nvb, out, ssq1, pooled, smf);
      GBAR();
      gemm8_phase(xs, js, pooled, LDH, wpool + (size_t)jl * 1024 * (256 + PADK), 256, D, 256, EpiResid8{out, out, 1.0f, hb, ssq2});
      GBAR();
    } else {
      gemm8_phase(xs, js, hb, LDH, win + (size_t)jl * LATNP * (D + PADK), D, LATNP, 0, EpiLat8{lat, kpe, ssq_q, ssq_kv, ssq1});
      GBAR();
      gemm8_phase(xs, js, lat, LDH, wq + (size_t)jl * 1536 * (QL + PADK), QL, 1536, 0, EpiQraw8{qraw, ssq_q});
      gemm_phase<CR>(xs, jv, nbv, lat + QL, LDH, wkv + (size_t)jl * 2048 * (KVL + PADK), KVL, 2048, 0, EpiKV{ssq_kv, kpe, p.in[15] + (size_t)jl * QKH, cosT, sinT, kbuf, vtb}, smh);
      GBAR();
      attn_phase(qraw, kbuf, vtb, obuf, p.in[14] + (size_t)jl * QKH, cosT, sinT, (bf16_t*)smem, xs, js);
      GBAR();
      gemm8_phase(xs, js, obuf, LDH, wout + (size_t)jl * D * (D + PADK), D, D, 0, EpiResid8{out, out, 1.0f, hb, ssq2});
      GBAR();
    }
    gemm8_phase(xs, js, hb, LDH, wgu2, D, 2 * FF, 0, EpiGU8{act, ssq2});
    XBAR();
    const bool last = (layer + 1 == DEPTH);
    gemm8_phase(xs, js, act, LDA, wdn2, FF, D, 0, EpiResid8{out, out, 0.5f, last ? nullptr : hb, last ? nullptr : ssq_next});
    if (!last) GBAR();
  }
}

extern "C" void kernel_launch(void* const* d_in, const int* in_sizes, int n_in, void* d_out, int out_size, void* d_ws, size_t ws_size, hipStream_t stream) {
  static int grid_blocks = 0;
  if (!grid_blocks) {
    int dev = 0, cus = 0, per_cu = 0;
    (void)hipGetDevice(&dev);
    (void)hipDeviceGetAttribute(&cus, hipDeviceAttributeMultiprocessorCount, dev);
    (void)hipFuncSetAttribute((const void*)fwd_megakernel, hipFuncAttributeMaxDynamicSharedMemorySize, LDS_BYTES);
    (void)hipOccupancyMaxActiveBlocksPerMultiprocessor(&per_cu, fwd_megakernel, 512, LDS_BYTES);
    grid_blocks = cus;
    if (n_in != 21 || out_size != T * D || ws_size < WS_TOTAL || per_cu < 1) fprintf(stderr, "kernel_launch: unexpected n_in=%d out=%d ws=%zu (need %zu) per_cu=%d\n", n_in, out_size, ws_size, (size_t)WS_TOTAL, per_cu);
  }
  Params p{};
  for (int i = 0; i < 21; ++i) p.in[i] = (const float*)d_in[i];
  p.out = (float*)d_out; p.ws = (unsigned char*)d_ws;
  (void)hipMemsetAsync((unsigned char*)d_ws + OFF_CTL, 0, 256, stream);
  void* args[] = {&p};
  hipError_t e = hipLaunchCooperativeKernel((void*)fwd_megakernel, dim3(grid_blocks), dim3(512), args, LDS_BYTES, stream);
  if (e != hipSuccess) fprintf(stderr, "cooperative launch failed: %s (grid %d)\n", hipGetErrorString(e), grid_blocks);
}
```

```cpp
#include <hip/hip_runtime.h>
#include <hip/hip_cooperative_groups.h>
#include <cstdio>
#include <cstdint>
namespace cg = cooperative_groups;

#define DI __device__ __forceinline__
typedef unsigned short bf16_t;
typedef short bf16x8 __attribute__((ext_vector_type(8)));
typedef float f32x16 __attribute__((ext_vector_type(16)));
typedef float f32x4 __attribute__((ext_vector_type(4)));
typedef float f32x2 __attribute__((ext_vector_type(2)));
typedef unsigned u32x4 __attribute__((ext_vector_type(4)));
typedef unsigned u32x2 __attribute__((ext_vector_type(2)));
typedef __bf16 bf16v2 __attribute__((ext_vector_type(2)));

constexpr int NB = 2, S = 16384, T = NB * S, D = 1024, FF = 2816, NH = 8, DEPTH = 4;
constexpr int QL = 768, KVL = 256, QKH = 192, VH = 128;
constexpr int LATNP = 1280;
constexpr int LDH = D + 64;
constexpr int LDA = FF + 64;
constexpr int SV = S + 64;
constexpr int PADK = 64;
constexpr float EPS = 1e-6f;

constexpr size_t SZ_WGU = (size_t)2 * FF * (D + PADK) * 2, SZ_WDN = (size_t)D * (FF + PADK) * 2;
constexpr size_t OFF_WGU1 = 0, OFF_WDN1 = OFF_WGU1 + SZ_WGU, OFF_WGU2 = OFF_WDN1 + SZ_WDN, OFF_WDN2 = OFF_WGU2 + SZ_WGU;
constexpr size_t SZ_WPOOL = (size_t)1024 * (256 + PADK) * 2, SZ_WIN = (size_t)LATNP * (D + PADK) * 2, SZ_WQ = (size_t)1536 * (QL + PADK) * 2;
constexpr size_t SZ_WKV = (size_t)2048 * (KVL + PADK) * 2, SZ_WOUT = (size_t)D * (D + PADK) * 2;
constexpr size_t OFF_WPOOL = OFF_WDN2 + SZ_WDN;
constexpr size_t OFF_WIN = OFF_WPOOL + 2 * SZ_WPOOL;
constexpr size_t OFF_WQ = OFF_WIN + 2 * SZ_WIN;
constexpr size_t OFF_WKV = OFF_WQ + 2 * SZ_WQ;
constexpr size_t OFF_WOUT = OFF_WKV + 2 * SZ_WKV;
constexpr size_t OFF_COS = OFF_WOUT + 2 * SZ_WOUT;
constexpr size_t OFF_SIN = OFF_COS + (size_t)T * 32 * 4;
constexpr size_t OFF_SSQ = OFF_SIN + (size_t)T * 32 * 4;
constexpr size_t OFF_KPE = OFF_SSQ + (size_t)16 * T * 4;
constexpr size_t OFF_HB = OFF_KPE + (size_t)T * 64 * 4;
constexpr size_t OFF_BIG = OFF_HB + (size_t)T * LDH * 2;
constexpr size_t OFF_ACT = OFF_BIG;
constexpr size_t OFF_LAT = OFF_BIG;
constexpr size_t OFF_POOLED = OFF_BIG;
constexpr size_t OFF_QRAW = OFF_LAT + (size_t)T * LDH * 2;
constexpr size_t OFF_K = OFF_QRAW + (size_t)T * 1536 * 2;
constexpr size_t OFF_VT = OFF_K + (size_t)T * NH * QKH * 2;
constexpr size_t WS_END = OFF_VT + (size_t)NB * NH * VH * SV * 2;
static_assert(OFF_ACT + (size_t)T * LDA * 2 <= WS_END, "act must fit in the big region");
constexpr size_t OFF_CTL = WS_END;
constexpr size_t WS_TOTAL = OFF_CTL + 256;
static_assert(WS_TOTAL <= (size_t)536870912, "workspace budget (4 x largest tensor)");
constexpr int LDS_BYTES = 131072;
constexpr int VHALF_BYTES = 36864;

struct Params { const float* in[21]; float* out; unsigned char* ws; };
extern __shared__ __attribute__((aligned(1024))) unsigned char smem[];

DI unsigned pack_bf16(float lo, float hi) { f32x2 v = {lo, hi}; bf16v2 b = __builtin_convertvector(v, bf16v2); return __builtin_bit_cast(unsigned, b); }
DI bf16_t to_bf16(float x) { return (bf16_t)(pack_bf16(x, 0.f) & 0xffffu); }
DI float bf2f(short v) { return __uint_as_float(((unsigned)(unsigned short)v) << 16); }
DI int crow(int i, int h) { return (i & 3) + 8 * (i >> 2) + 4 * h; }
DI float red32(float v) { v += __shfl_xor(v, 1); v += __shfl_xor(v, 2); v += __shfl_xor(v, 4); v += __shfl_xor(v, 8); v += __shfl_xor(v, 16); return v; }
DI float red64(float v) { v = red32(v); v += __shfl_xor(v, 32); return v; }
DI int opaque_tid() { int t = threadIdx.x & 255; asm volatile("" : "+v"(t)); return t; }
DI int opaque_tid512() { int t = threadIdx.x; asm volatile("" : "+v"(t)); return t; }
#define MFMA(a, b, c) __builtin_amdgcn_mfma_f32_32x32x16_bf16((a), (b), (c), 0, 0, 0)
DI void grid_bar(unsigned* ctr, unsigned target) {
  asm volatile("s_waitcnt vmcnt(0)" ::: "memory");
  __syncthreads();
  if (threadIdx.x == 0) {
    __builtin_amdgcn_fence(__ATOMIC_RELEASE, "agent");
    asm volatile("s_waitcnt vmcnt(0)" ::: "memory");
    (void)__hip_atomic_fetch_add(ctr, 1u, __ATOMIC_RELAXED, __HIP_MEMORY_SCOPE_AGENT);
    while (__hip_atomic_load(ctr, __ATOMIC_RELAXED, __HIP_MEMORY_SCOPE_AGENT) < target) __builtin_amdgcn_s_sleep(1);
    __builtin_amdgcn_fence(__ATOMIC_ACQUIRE, "agent");
    asm volatile("s_waitcnt vmcnt(0)" ::: "memory");
  }
  __syncthreads();
}

DI void prep_w(int vb, int nvb, const float* __restrict__ W, bf16_t* __restrict__ Wt, int K, int N, const float* __restrict__ gk, const float* __restrict__ sn, int mode, float* smf) {
  const int ldt = K + PADK;
  const int tid = opaque_tid();
  const int ntn = N / 64, nt = (K / 64) * ntn;
  for (int t0 = 0; t0 < nt; t0 += nvb) {
    const int t = t0 + vb;
    const bool on = t < nt;
    const int k0 = (t / ntn) * 64, n0 = (t % ntn) * 64;
    if (on) {
#pragma unroll
      for (int i = 0; i < 16; ++i) {
        const int kk = i * 4 + (tid >> 6), nn = tid & 63;
        float v = __builtin_nontemporal_load(W + (size_t)(k0 + kk) * N + n0 + nn);
        if (gk) v *= gk[k0 + kk];
        if (sn) v *= sn[n0 + nn];
        smf[kk * 65 + nn] = v;
      }
    }
    __syncthreads();
    if (on) {
      const int nl = tid >> 2, kq = (tid & 3) * 16;
      u32x4 p0, p1;
      p0.x = pack_bf16(smf[(kq + 0) * 65 + nl], smf[(kq + 1) * 65 + nl]);
      p0.y = pack_bf16(smf[(kq + 2) * 65 + nl], smf[(kq + 3) * 65 + nl]);
      p0.z = pack_bf16(smf[(kq + 4) * 65 + nl], smf[(kq + 5) * 65 + nl]);
      p0.w = pack_bf16(smf[(kq + 6) * 65 + nl], smf[(kq + 7) * 65 + nl]);
      p1.x = pack_bf16(smf[(kq + 8) * 65 + nl], smf[(kq + 9) * 65 + nl]);
      p1.y = pack_bf16(smf[(kq + 10) * 65 + nl], smf[(kq + 11) * 65 + nl]);
      p1.z = pack_bf16(smf[(kq + 12) * 65 + nl], smf[(kq + 13) * 65 + nl]);
      p1.w = pack_bf16(smf[(kq + 14) * 65 + nl], smf[(kq + 15) * 65 + nl]);
      const int n = n0 + nl;
      int row = n;
      if (mode == 1) row = (n >> 4) * 32 + (n & 15);
      else if (mode == 2) row = (n >> 4) * 32 + 16 + (n & 15);
      else if (mode == 3) { const int hd = n >> 8, j = n & 255; row = (j < 128) ? (hd * 128 + j) : (1024 + hd * 128 + (j - 128)); }
      u32x4* dst = (u32x4*)(Wt + (size_t)row * ldt + k0 + kq);
      dst[0] = p0; dst[1] = p1;
    }
    __syncthreads();
  }
}

template <int WM_, int WN_, int MI_, int NI_, int BK_, int ST_>
struct Cfg {
  static constexpr int WM = WM_, WN = WN_, MI = MI_, NI = NI_, BK = BK_, ST = ST_;
  static constexpr int BM = WM * MI * 32, BN = WN * NI * 32;
  static constexpr int LS = BK + 8;
  static constexpr int A_EL = BM * LS, B_EL = BN * LS, STAGE_EL = A_EL + B_EL;
  static constexpr int CPR = BK / 8;
  static constexpr int A_CH = BM * CPR / 256, B_CH = BN * CPR / 256;
  static_assert(WM * WN == 4, "4 waves");
  static_assert(ST * STAGE_EL * 2 <= VHALF_BYTES, "LDS of a virtual half-block");
};

template <class C, class Epi>
DI void gemm_tile(const bf16_t* __restrict__ A, int lda, const bf16_t* __restrict__ Bt, int K, int m0, int n0, const Epi& epi, bf16_t* sm) {
  const int tid = opaque_tid(), lane = tid & 63, wave = tid >> 6, r = lane & 31, h = lane >> 5;
  const int wm = wave / C::WN, wn = wave % C::WN;
  f32x16 acc[C::MI][C::NI];
#pragma unroll
  for (int mi = 0; mi < C::MI; ++mi)
#pragma unroll
    for (int ni = 0; ni < C::NI; ++ni)
#pragma unroll
      for (int i = 0; i < 16; ++i) acc[mi][ni][i] = 0.f;
  const bf16_t* Ag = A + (size_t)m0 * lda;
  const int ldb = K + PADK;
  const bf16_t* Bg = Bt + (size_t)n0 * ldb;
  u32x4 ra[C::A_CH], rb[C::B_CH];
  const int nk = K / C::BK;
  constexpr int RPP = 256 / C::CPR;
  const unsigned a_off = (unsigned)(tid / C::CPR) * (unsigned)lda + (unsigned)(tid % C::CPR) * 8u;
  const unsigned b_off = (unsigned)(tid / C::CPR) * (unsigned)ldb + (unsigned)(tid % C::CPR) * 8u;
  const unsigned l_off = (unsigned)(tid / C::CPR) * C::LS + (unsigned)(tid % C::CPR) * 8u;
#define GLOAD(k0_)                                                                                   \
  {                                                                                                  \
    const bf16_t* ag_ = Ag + (k0_); const bf16_t* bg_ = Bg + (k0_);                                  \
    _Pragma("unroll") for (int i = 0; i < C::A_CH; ++i) ra[i] = *(const u32x4*)(ag_ + (a_off + (unsigned)(i * RPP) * (unsigned)lda)); \
    _Pragma("unroll") for (int i = 0; i < C::B_CH; ++i) rb[i] = *(const u32x4*)(bg_ + (b_off + (unsigned)(i * RPP) * (unsigned)ldb));   \
  }
#define LSTORE(buf_)                                                                                 \
  {                                                                                                  \
    bf16_t* sa_ = sm + (buf_) * C::STAGE_EL + l_off; bf16_t* sb_ = sa_ + C::A_EL;                    \
    _Pragma("unroll") for (int i = 0; i < C::A_CH; ++i) *(u32x4*)(sa_ + i * RPP * C::LS) = ra[i];   \
    _Pragma("unroll") for (int i = 0; i < C::B_CH; ++i) *(u32x4*)(sb_ + i * RPP * C::LS) = rb[i];   \
  }
  GLOAD(0);
  if (C::ST == 2) {
    LSTORE(0);
    __syncthreads();
  }
  for (int kt = 0; kt < nk; ++kt) {
    const int buf = (C::ST == 2) ? (kt & 1) : 0;
    if (C::ST == 1) {
      __syncthreads();
      LSTORE(0);
      __syncthreads();
    }
    if (kt + 1 < nk) GLOAD((kt + 1) * C::BK);
    __builtin_amdgcn_sched_barrier(0);
    const bf16_t* sa = sm + buf * C::STAGE_EL + (wm * C::MI * 32 + r) * C::LS + h * 8;
    const bf16_t* sb = sm + buf * C::STAGE_EL + C::A_EL + (wn * C::NI * 32 + r) * C::LS + h * 8;
#pragma unroll
    for (int ks = 0; ks < C::BK / 16; ++ks) {
      bf16x8 af[C::MI], bfr[C::NI];
#pragma unroll
      for (int mi = 0; mi < C::MI; ++mi) af[mi] = *(const bf16x8*)(sa + mi * 32 * C::LS + ks * 16);
#pragma unroll
      for (int ni = 0; ni < C::NI; ++ni) bfr[ni] = *(const bf16x8*)(sb + ni * 32 * C::LS + ks * 16);
#pragma unroll
      for (int mi = 0; mi < C::MI; ++mi)
#pragma unroll
        for (int ni = 0; ni < C::NI; ++ni) acc[mi][ni] = MFMA(af[mi], bfr[ni], acc[mi][ni]);
    }
    if (C::ST == 2) {
      if (kt + 1 < nk) LSTORE((kt + 1) & 1);
      __syncthreads();
    }
  }
  if (C::ST == 1) __syncthreads();
#undef GLOAD
#undef LSTORE
  epi.template run<C::MI, C::NI>(acc, m0 + wm * C::MI * 32, n0 + wn * C::NI * 32, r, h);
}

template <class C, class Epi>
DI void gemm_phase(int x, int j, int nb, const bf16_t* __restrict__ A, int lda, const bf16_t* __restrict__ Bt, int K, int N, int a_grp, const Epi& epi, bf16_t* sm) {
  static_assert(C::BM == 128 && (C::BN == 128 || C::BN == 256), "tile");
  constexpr int GN = (C::BN == 256) ? 4 : 8;
  const int nN = N / C::BN;
  const int total = 32 * nN;
  for (int u = j; u < total; u += nb) {
    const int ng = u / (32 * GN), rem = u % (32 * GN);
    int gn = nN - GN * ng; if (gn > GN) gn = GN;
    const int mg = rem / (8 * gn), jj = rem % (8 * gn);
    const int mt = 32 * x + 8 * mg + (jj & 7), nt = GN * ng + (jj >> 3);
    const int n0 = nt * C::BN;
    const bf16_t* Ap = a_grp ? (A + (n0 / a_grp) * K) : A;
    gemm_tile<C, Epi>(Ap, lda, Bt, K, mt * 128, n0, epi, sm);
  }
}

struct EpiGU {
  bf16_t* act; const float* ssq;
  template <int MI, int NI> DI void run(f32x16 (&acc)[MI][NI], int mb, int nb, int r, int h) const {
    static_assert((NI & 1) == 0, "gate/up pairs");
#pragma unroll
    for (int mi = 0; mi < MI; ++mi)
#pragma unroll
      for (int i = 0; i < 16; ++i) {
        const int row = mb + mi * 32 + crow(i, h);
        const float rs = rsqrtf(ssq[row] * (1.f / D) + EPS);
#pragma unroll
        for (int pi = 0; pi < NI / 2; ++pi) {
          const float g = acc[mi][2 * pi][i] * rs, u = acc[mi][2 * pi + 1][i] * rs;
          const float a = g / (1.f + __expf(-g)) * u;
          act[(size_t)row * LDA + (nb >> 1) + pi * 32 + r] = to_bf16(a);
        }
      }
  }
};
struct EpiResid {
  const float* xin; float* xout; float scale; bf16_t* xb; float* ssq;
  template <int MI, int NI> DI void run(f32x16 (&acc)[MI][NI], int mb, int nb, int r, int h) const {
#pragma unroll
    for (int mi = 0; mi < MI; ++mi)
#pragma unroll
      for (int hf = 0; hf < 2; ++hf) {
        float xv[8][NI];
#pragma unroll
        for (int i = 0; i < 8; ++i)
#pragma unroll
          for (int ni = 0; ni < NI; ++ni) xv[i][ni] = xin[(size_t)(mb + mi * 32 + crow(hf * 8 + i, h)) * D + nb + ni * 32 + r];
        __builtin_amdgcn_sched_barrier(0);
        float ssv[8];
#pragma unroll
        for (int i = 0; i < 8; ++i) {
          const int row = mb + mi * 32 + crow(hf * 8 + i, h);
          float ss = 0.f;
#pragma unroll
          for (int ni = 0; ni < NI; ++ni) {
            const float v = xv[i][ni] + scale * acc[mi][ni][hf * 8 + i];
            xout[(size_t)row * D + nb + ni * 32 + r] = v;
            if (xb) { xb[(size_t)row * LDH + nb + ni * 32 + r] = to_bf16(v); ss += v * v; }
          }
          ssv[i] = ss;
        }
        if (xb) {
#pragma unroll
          for (int i = 0; i < 8; ++i) { const float t = red32(ssv[i]); if (r == 0) atomicAdd(ssq + mb + mi * 32 + crow(hf * 8 + i, h), t); }
        }
        __builtin_amdgcn_sched_barrier(0);
      }
  }
};
struct EpiLat {
  bf16_t* lat; float* kpe; float* ssq_q; float* ssq_kv; const float* ssq_x;
  template <int MI, int NI> DI void run(f32x16 (&acc)[MI][NI], int mb, int nb, int r, int h) const {
    if (nb >= 1088) return;
    float* ssq = (nb < QL) ? ssq_q : ssq_kv;
#pragma unroll
    for (int mi = 0; mi < MI; ++mi) {
      float rsv[16];
#pragma unroll
      for (int i = 0; i < 16; ++i) rsv[i] = rsqrtf(ssq_x[mb + mi * 32 + crow(i, h)] * (1.f / D) + EPS);
      __builtin_amdgcn_sched_barrier(0);
      if (nb >= 1024) {
#pragma unroll
        for (int i = 0; i < 16; ++i)
#pragma unroll
          for (int ni = 0; ni < NI; ++ni) kpe[(size_t)(mb + mi * 32 + crow(i, h)) * 64 + (nb - 1024) + ni * 32 + r] = acc[mi][ni][i] * rsv[i];
      } else {
        float ssv[16];
#pragma unroll
        for (int i = 0; i < 16; ++i) {
          const int row = mb + mi * 32 + crow(i, h);
          float ss = 0.f;
#pragma unroll
          for (int ni = 0; ni < NI; ++ni) { const float v = acc[mi][ni][i] * rsv[i]; ss += v * v; lat[(size_t)row * LDH + nb + ni * 32 + r] = to_bf16(v); }
          ssv[i] = ss;
        }
#pragma unroll
        for (int i = 0; i < 16; ++i) { const float t = red32(ssv[i]); if (r == 0) atomicAdd(ssq + mb + mi * 32 + crow(i, h), t); }
      }
    }
  }
};
struct EpiQraw {
  bf16_t* q; const float* ssq_q;
  template <int MI, int NI> DI void run(f32x16 (&acc)[MI][NI], int mb, int nb, int r, int h) const {
#pragma unroll
    for (int mi = 0; mi < MI; ++mi)
#pragma unroll
      for (int i = 0; i < 16; ++i) {
        const int row = mb + mi * 32 + crow(i, h);
        const float rs = rsqrtf(ssq_q[row] * (1.f / QL) + EPS);
#pragma unroll
        for (int ni = 0; ni < NI; ++ni) q[(size_t)row * 1536 + nb + ni * 32 + r] = to_bf16(acc[mi][ni][i] * rs);
      }
  }
};
struct EpiKV {
  const float* ssq_kv; const float* kpe; const float* gk; const float* cosT; const float* sinT; bf16_t* kout; bf16_t* vt;
  template <int MI, int NI> DI void run(f32x16 (&acc)[MI][NI], int mb, int nb, int r, int h) const {
    static_assert(MI == 1 && NI == 4, "kv epilogue layout");
    const int b = mb / S, sb = mb % S;
    if (nb < 1024) {
      const int head = nb >> 7;
      const float g0 = gk[r], g1 = gk[32 + r], g2 = gk[64 + r], g3 = gk[96 + r], g4 = gk[128 + r], g5 = gk[160 + r];
#pragma unroll
      for (int i = 0; i < 16; ++i) {
        const int rw = crow(i, h), tok = mb + rw;
        const float rkv = rsqrtf(ssq_kv[tok] * (1.f / KVL) + EPS);
        const float v0 = acc[0][0][i] * rkv, v1 = acc[0][1][i] * rkv, v2 = acc[0][2][i] * rkv, v3 = acc[0][3][i] * rkv;
        const float p1 = kpe[(size_t)tok * 64 + r], p2 = kpe[(size_t)tok * 64 + 32 + r];
        float ss = v0 * v0 + v1 * v1 + v2 * v2 + v3 * v3 + p1 * p1 + p2 * p2;
        ss = red32(ss);
        const float rk = rsqrtf(ss * (1.f / QKH) + EPS);
        bf16_t* kr = kout + ((size_t)(b * NH + head) * S + sb + rw) * QKH;
        kr[r] = to_bf16(v0 * rk * g0); kr[32 + r] = to_bf16(v1 * rk * g1); kr[64 + r] = to_bf16(v2 * rk * g2); kr[96 + r] = to_bf16(v3 * rk * g3);
        const float c = cosT[(size_t)tok * 32 + r], sn = sinT[(size_t)tok * 32 + r];
        const float x1 = p1 * rk * g4, x2 = p2 * rk * g5;
        kr[128 + r] = to_bf16(x1 * c - x2 * sn); kr[160 + r] = to_bf16(x2 * c + x1 * sn);
      }
    } else {
      const int head = (nb - 1024) >> 7;
      float rkv[16];
#pragma unroll
      for (int i = 0; i < 16; ++i) rkv[i] = rsqrtf(ssq_kv[mb + crow(i, h)] * (1.f / KVL) + EPS);
#pragma unroll
      for (int ni = 0; ni < 4; ++ni) {
        bf16_t* vr = vt + ((size_t)(b * NH + head) * VH + ni * 32 + r) * SV + sb;
#pragma unroll
        for (int a = 0; a < 4; ++a) {
          u32x2 o;
          o.x = pack_bf16(acc[0][ni][4 * a] * rkv[4 * a], acc[0][ni][4 * a + 1] * rkv[4 * a + 1]);
          o.y = pack_bf16(acc[0][ni][4 * a + 2] * rkv[4 * a + 2], acc[0][ni][4 * a + 3] * rkv[4 * a + 3]);
          *(u32x2*)(vr + 16 * (a >> 1) + 8 * h + 4 * (a & 1)) = o;
        }
      }
    }
  }
};


DI int lds_byte2(int r, int c) { const int st = (r >> 4) * 2 + (c >> 5), ob = (r & 15) * 64 + (c & 31) * 2; return st * 1024 + (ob ^ (((ob >> 9) & 1) << 5)); }
DI void stage_rc2(int b, int& R, int& C) { const int st = b >> 10, sb = b & 1023, swz = sb ^ (((sb >> 9) & 1) << 5); R = (st >> 1) * 16 + swz / 64; C = (st & 1) * 32 + (swz % 64) / 2; }
#define MFMA16(a, b, c) __builtin_amdgcn_mfma_f32_16x16x32_bf16((a), (b), (c), 0, 0, 0)
constexpr int G8_TILE_B = 256 * 64 * 2, G8_STAGE_B = 2 * G8_TILE_B;

template <class Epi>
DI void gemm8_tile(const bf16_t* __restrict__ Ab, int lda, const bf16_t* __restrict__ Bb, int ldb, int K, int brow, int bcol, const Epi epi,
                   bool staged, bool has_next, const bf16_t* __restrict__ Abn, const bf16_t* __restrict__ Bbn) {
  const int tid = opaque_tid512(), wid = tid >> 6, lane = tid & 63, wr = wid >> 2, wc = wid & 3, fr = lane & 15, fq = lane >> 4;
  unsigned aoff[4], boff[4];
#pragma unroll
  for (int i = 0; i < 4; ++i) { int R, C; stage_rc2(wid * 1024 + i * 8192 + lane * 16, R, C); aoff[i] = (unsigned)R * (unsigned)lda + (unsigned)C; boff[i] = (unsigned)R * (unsigned)ldb + (unsigned)C; }
#define G8_STAGE_R(buf_, ap_, bp_, i0_, i1_)                                                                         \
  {                                                                                                                  \
    const bf16_t* ag_ = (ap_); const bf16_t* bg_ = (bp_);                                                            \
    _Pragma("unroll") for (int i = (i0_); i < (i1_); ++i) {                                                          \
      __builtin_amdgcn_global_load_lds((const unsigned*)(ag_ + aoff[i]), (unsigned*)(smem + (buf_) * G8_STAGE_B + wid * 1024 + i * 8192), 16, 0, 0);              \
      __builtin_amdgcn_global_load_lds((const unsigned*)(bg_ + boff[i]), (unsigned*)(smem + (buf_) * G8_STAGE_B + G8_TILE_B + wid * 1024 + i * 8192), 16, 0, 0);  \
    }                                                                                                                \
  }
#define G8_STAGE(buf_, ap_, bp_) G8_STAGE_R(buf_, ap_, bp_, 0, 4)
  f32x4 acc[8][4];
#pragma unroll
  for (int m = 0; m < 8; ++m)
#pragma unroll
    for (int n = 0; n < 4; ++n) acc[m][n] = (f32x4){0.f, 0.f, 0.f, 0.f};
  const int nt = K / 64;
  if (!staged) {
    G8_STAGE(0, Ab, Bb);
    asm volatile("s_waitcnt vmcnt(0)" ::: "memory");
    __syncthreads();
  }
  for (int t = 0; t < nt; ++t) {
    const int cur = t & 1;
    const unsigned char* sa = smem + cur * G8_STAGE_B;
    const unsigned char* sb = sa + G8_TILE_B;
#pragma unroll
    for (int ks = 0; ks < 2; ++ks) {
      bf16x8 At[8], Bf[4];
#pragma unroll
      for (int m = 0; m < 8; ++m) At[m] = *(const bf16x8*)(sa + lds_byte2(wr * 128 + m * 16 + fr, ks * 32 + fq * 8));
#pragma unroll
      for (int n = 0; n < 4; ++n) Bf[n] = *(const bf16x8*)(sb + lds_byte2(wc * 64 + n * 16 + fr, ks * 32 + fq * 8));
      {
        __builtin_amdgcn_sched_barrier(0);
        if (t + 1 < nt) { G8_STAGE_R(cur ^ 1, Ab + (t + 1) * 64, Bb + (t + 1) * 64, 2 * ks, 2 * ks + 2); }
        else if (has_next) { G8_STAGE_R(0, Abn, Bbn, 2 * ks, 2 * ks + 2); }
        __builtin_amdgcn_sched_barrier(0);
      }
#pragma unroll
      for (int m = 0; m < 8; ++m)
#pragma unroll
        for (int n = 0; n < 4; ++n) acc[m][n] = MFMA16(At[m], Bf[n], acc[m][n]);
      __builtin_amdgcn_sched_barrier(0);
    }
    asm volatile("s_waitcnt vmcnt(0)" ::: "memory");
    __syncthreads();
  }
#undef G8_STAGE
#undef G8_STAGE_R
  epi.run8(acc, brow + wr * 128, bcol + wc * 64, fr, fq);
  if (Epi::LDS_SCRATCH) __syncthreads();
}

DI void g8_decode(int u, int x, int nN, int& pm, int& pn) {
  const int ng = u >> 6, rem = u & 63;
  int gn = nN - 4 * ng; if (gn > 4) gn = 4;
  const int mg = rem / (8 * gn), jj = rem % (8 * gn);
  pm = 16 * x + 8 * mg + (jj & 7); pn = 4 * ng + (jj >> 3);
}
template <class Epi>
DI void gemm8_phase(int x, int j, const bf16_t* __restrict__ A, int lda, const bf16_t* __restrict__ Bt, int K, int N, int a_grp, const Epi epi) {
  const int nN = N / 256, nb = gridDim.x >> 3, ldb = K + PADK;
  const int total = 16 * nN;
  bool staged = false;
  for (int u = j; u < total; u += nb) {
    int pm, pn; g8_decode(u, x, nN, pm, pn);
    const int brow = pm * 256, bcol = pn * 256;
    const bf16_t* Ab = A + (size_t)brow * lda + (a_grp ? (bcol / a_grp) * K : 0);
    const bf16_t* Bb = Bt + (size_t)bcol * ldb;
    const bool has_next = (u + nb < total);
    const bf16_t* Abn = Ab; const bf16_t* Bbn = Bb;
    if (has_next) {
      int pm2, pn2; g8_decode(u + nb, x, nN, pm2, pn2);
      Abn = A + (size_t)(pm2 * 256) * lda + (a_grp ? ((pn2 * 256) / a_grp) * K : 0);
      Bbn = Bt + (size_t)(pn2 * 256) * ldb;
    }
    gemm8_tile<Epi>(Ab, lda, Bb, ldb, K, brow, bcol, epi, staged, has_next, Abn, Bbn);
    staged = has_next;
  }
}
DI float red16(float v) { v += __shfl_xor(v, 1); v += __shfl_xor(v, 2); v += __shfl_xor(v, 4); v += __shfl_xor(v, 8); return v; }

struct EpiGU8 {
  static constexpr bool LDS_SCRATCH = true;
  bf16_t* act; const float* ssq;
  DI void run8(f32x4 (&acc)[8][4], int rb, int cb, int fr, int fq) const {
    const int lane = fq * 16 + fr, wid = (int)(threadIdx.x >> 6);
    bf16_t* scr = (bf16_t*)(smem + G8_STAGE_B + wid * 1280);
    const int srow = lane >> 2, sch = lane & 3;
    bf16_t* ap = act + (size_t)(rb + srow) * LDA + (cb >> 1) + sch * 8;
    float rsv[8][4];
#pragma unroll
    for (int m = 0; m < 8; ++m)
#pragma unroll
      for (int j = 0; j < 4; ++j) rsv[m][j] = rsqrtf(ssq[rb + m * 16 + fq * 4 + j] * (1.f / D) + EPS);
#pragma unroll
    for (int m = 0; m < 8; ++m) {
#pragma unroll
      for (int j = 0; j < 4; ++j)
#pragma unroll
        for (int pi = 0; pi < 2; ++pi) {
          const float g = acc[m][2 * pi][j] * rsv[m][j], u = acc[m][2 * pi + 1][j] * rsv[m][j];
          const float a = g * __builtin_amdgcn_rcpf(1.f + __expf(-g)) * u;
          scr[(fq * 4 + j) * 40 + pi * 16 + fr] = to_bf16(a);
        }
      __builtin_amdgcn_sched_barrier(0);
      const u32x4 o = *(const u32x4*)(scr + srow * 40 + sch * 8);
      *(u32x4*)(ap + (size_t)(m * 16) * LDA) = o;
      __builtin_amdgcn_sched_barrier(0);
    }
  }
};
struct EpiResid8 {
  static constexpr bool LDS_SCRATCH = true;
  const float* xin; float* xout; float scale; bf16_t* xb; float* ssq;
  DI void run8(f32x4 (&acc)[8][4], int rb, int cb, int fr, int fq) const {
    const int lane = fq * 16 + fr, wid = (int)(threadIdx.x >> 6);
    const float sc = scale; bf16_t* const xbp = xb; float* const ssqp = ssq;
    float* scr = (float*)(smem + G8_STAGE_B + wid * 4352);
    const int prow = lane >> 4, c4 = lane & 15;
    const float* xp = xin + (size_t)(rb + prow) * D + cb + c4 * 4;
    float* op = xout + (size_t)(rb + prow) * D + cb + c4 * 4;
#pragma unroll
    for (int mh = 0; mh < 2; ++mh) {
      f32x4 xv[4][4];
#pragma unroll
      for (int mm = 0; mm < 4; ++mm)
#pragma unroll
        for (int ps = 0; ps < 4; ++ps) xv[mm][ps] = __builtin_nontemporal_load((const f32x4*)(xp + (size_t)((mh * 4 + mm) * 16 + ps * 4) * D));
      __builtin_amdgcn_sched_barrier(0);
#pragma unroll
      for (int mm = 0; mm < 4; ++mm) {
        const int m = mh * 4 + mm;
#pragma unroll
        for (int n = 0; n < 4; ++n)
#pragma unroll
          for (int j = 0; j < 4; ++j) scr[(fq * 4 + j) * 68 + n * 16 + fr] = acc[m][n][j];
        __builtin_amdgcn_sched_barrier(0);
#pragma unroll
        for (int ps = 0; ps < 4; ++ps) {
          const f32x4 a = *(const f32x4*)(scr + (ps * 4 + prow) * 68 + c4 * 4);
          f32x4 v;
          v.x = xv[mm][ps].x + a.x * sc; v.y = xv[mm][ps].y + a.y * sc; v.z = xv[mm][ps].z + a.z * sc; v.w = xv[mm][ps].w + a.w * sc;
          const int grow = rb + m * 16 + ps * 4 + prow;
          __builtin_nontemporal_store(v, (f32x4*)(op + (size_t)(m * 16 + ps * 4) * D));
          if (xbp) {
            u32x2 o; o.x = pack_bf16(v.x, v.y); o.y = pack_bf16(v.z, v.w);
            *(u32x2*)(xbp + (size_t)grow * LDH + cb + c4 * 4) = o;
            const float t = red16(v.x * v.x + v.y * v.y + v.z * v.z + v.w * v.w);
            if (c4 == 0) atomicAdd(ssqp + grow, t);
          }
        }
        __builtin_amdgcn_sched_barrier(0);
      }
    }
  }
};
struct EpiLat8 {
  static constexpr bool LDS_SCRATCH = false;
  bf16_t* lat; float* kpe; float* ssq_q; float* ssq_kv; const float* ssq_x;
  DI void run8(f32x4 (&acc)[8][4], int rb, int cb, int fr, int fq) const {
    if (cb >= 1088) return;
    float* ssq = (cb < QL) ? ssq_q : ssq_kv;
#pragma unroll
    for (int mp = 0; mp < 2; ++mp) {
      float rsv[4][4];
#pragma unroll
      for (int mm = 0; mm < 4; ++mm)
#pragma unroll
        for (int j = 0; j < 4; ++j) rsv[mm][j] = rsqrtf(ssq_x[rb + (4 * mp + mm) * 16 + fq * 4 + j] * (1.f / D) + EPS);
      __builtin_amdgcn_sched_barrier(0);
#pragma unroll
      for (int mm = 0; mm < 4; ++mm) {
        float ssv[4];
#pragma unroll
        for (int j = 0; j < 4; ++j) {
          const int row = rb + (4 * mp + mm) * 16 + fq * 4 + j;
          float ss = 0.f;
#pragma unroll
          for (int n = 0; n < 4; ++n) {
            const float v = acc[4 * mp + mm][n][j] * rsv[mm][j];
            if (cb >= 1024) kpe[(size_t)row * 64 + (cb - 1024) + n * 16 + fr] = v;
            else { lat[(size_t)row * LDH + cb + n * 16 + fr] = to_bf16(v); ss += v * v; }
          }
          ssv[j] = ss;
        }
        if (cb < 1024) {
#pragma unroll
          for (int j = 0; j < 4; ++j) { const float t = red16(ssv[j]); if (fr == 0) atomicAdd(ssq + rb + (4 * mp + mm) * 16 + fq * 4 + j, t); }
        }
      }
    }
  }
};
struct EpiQraw8 {
  static constexpr bool LDS_SCRATCH = false;
  bf16_t* q; const float* ssq_q;
  DI void run8(f32x4 (&acc)[8][4], int rb, int cb, int fr, int fq) const {
#pragma unroll
    for (int m = 0; m < 8; ++m)
#pragma unroll
      for (int j = 0; j < 4; ++j) {
        const int row = rb + m * 16 + fq * 4 + j;
        const float rs = rsqrtf(ssq_q[row] * (1.f / QL) + EPS);
#pragma unroll
        for (int n = 0; n < 4; ++n) q[(size_t)row * 1536 + cb + n * 16 + fr] = to_bf16(acc[m][n][j] * rs);
      }
  }
};

DI void norm0_phase(const float* __restrict__ x, bf16_t* __restrict__ hb, float* __restrict__ ssq) {
  const int tid = opaque_tid512();
  const int lane = tid & 63, gw = blockIdx.x * 8 + (tid >> 6), nw = gridDim.x * 8;
  for (int row = gw; row < T; row += nw) {
    const f32x4* xr = (const f32x4*)(x + (size_t)row * D);
    f32x4 v[4];
    float ss = 0.f;
#pragma unroll
    for (int c = 0; c < 4; ++c) { v[c] = __builtin_nontemporal_load(xr + c * 64 + lane); ss += v[c].x * v[c].x + v[c].y * v[c].y + v[c].z * v[c].z + v[c].w * v[c].w; }
    ss = red64(ss);
    if (lane == 0) ssq[row] = ss;
#pragma unroll
    for (int c = 0; c < 4; ++c) {
      u32x2 o; o.x = pack_bf16(v[c].x, v[c].y); o.y = pack_bf16(v[c].z, v[c].w);
      *(u32x2*)(hb + (size_t)row * LDH + (c * 64 + lane) * 4) = o;
    }
  }
}

template <int W>
DI void pool_rows(const float* __restrict__ x, const float* smr, bf16_t* __restrict__ pb, int t0, int s0, int tid) {
  const int tq0 = t0 - s0;
  const float* xq = x + tid * 4;
  f32x4 Sm = {0.f, 0.f, 0.f, 0.f};
#pragma unroll
  for (int i = 1; i < W; ++i) {
    int t = t0 - i; if (t < tq0) t = tq0;
    Sm += *(const f32x4*)(xq + (size_t)t * D) * smr[15 - i];
  }
#pragma unroll 8
  for (int tl = 0; tl < 64; ++tl) {
    const int t = t0 + tl, s = s0 + tl;
    int to = t - W + 1; if (to < tq0) to = tq0;
    const f32x4 hn = *(const f32x4*)(xq + (size_t)t * D) * smr[15 + tl];
    const f32x4 ho = *(const f32x4*)(xq + (size_t)to * D) * smr[15 + tl - W + 1];
    const int cnt = (s + 1 < W) ? (s + 1) : W;
    const float ic = 1.f / (float)cnt;
    Sm += hn;
    const f32x4 p = Sm * ic - hn;
    Sm -= ho;
    u32x2 o; o.x = pack_bf16(p.x, p.y); o.y = pack_bf16(p.z, p.w);
    *(u32x2*)(pb + (size_t)t * LDH + tid * 4) = o;
  }
}
DI void poolprep_phase(int vb, int nvb, const float* __restrict__ x, const float* __restrict__ ssq, bf16_t* __restrict__ pb, float* smf) {
  const int tid = opaque_tid(), wave = tid >> 6;
  for (int c0 = 0; c0 < T / 64; c0 += nvb) {
    const int ch = c0 + vb;
    const bool on = ch < T / 64;
    const int t0 = ch * 64, s0 = t0 & (S - 1);
    if (on && tid < 79) smf[tid] = (s0 + tid >= 15) ? rsqrtf(ssq[t0 - 15 + tid] * (1.f / D) + EPS) : 0.f;
    __syncthreads();
    if (on) {
      if (wave == 0) pool_rows<2>(x, smf, pb, t0, s0, tid);
      else if (wave == 1) pool_rows<4>(x, smf, pb, t0, s0, tid);
      else if (wave == 2) pool_rows<8>(x, smf, pb, t0, s0, tid);
      else pool_rows<16>(x, smf, pb, t0, s0, tid);
    }
    __syncthreads();
  }
}

constexpr int KLS = QKH + 8;
constexpr int VLS = 64 + 8;
constexpr int K_EL = 64 * KLS;
constexpr int ATT_STG_EL = K_EL + 128 * VLS;

DI void attn_phase(const bf16_t* __restrict__ qraw, const bf16_t* __restrict__ kbuf, const bf16_t* __restrict__ vtb, bf16_t* __restrict__ obuf,
                   const float* __restrict__ gq, const float* __restrict__ cosT, const float* __restrict__ sinT, bf16_t* sm, int x, int j) {
  const int nb = gridDim.x >> 3;
  for (int p = j; p < 64; p += nb) {
    const int bh = 2 * x + (p >> 5);
    const int b = bh >> 3, hd = bh & 7;
    for (int half = 0; half < 2; ++half) {
      const int tid = opaque_tid512(), lane = tid & 63, wave = tid >> 6, r = lane & 31, h = lane >> 5;
      const int qb = half ? (p & 31) : (63 - (p & 31));
      const int q0 = qb * 256 + wave * 32;
      const size_t tok = (size_t)b * S + q0 + r;
      bf16x8 qf[12];
      {
        const bf16_t* qp = qraw + tok * 1536 + hd * QKH + h * 8;
#pragma unroll
        for (int st = 0; st < 12; ++st) qf[st] = *(const bf16x8*)(qp + st * 16);
        float ss = 0.f;
#pragma unroll
        for (int st = 0; st < 12; ++st) {
#pragma unroll
          for (int e = 0; e < 8; ++e) { const float f = bf2f(qf[st][e]); ss += f * f; }
          u32x4 t = __builtin_bit_cast(u32x4, qf[st]);
          asm volatile("" : "+v"(t));
          qf[st] = __builtin_bit_cast(bf16x8, t);
        }
        ss += __shfl_xor(ss, 32);
        const float rq = rsqrtf(ss * (1.f / QKH) + EPS) * (0.07216878364870322f * 1.4426950408889634f);
        __builtin_amdgcn_sched_barrier(0);
#pragma unroll
        for (int st = 0; st < 8; ++st) {
          const f32x4 ga = *(const f32x4*)(gq + st * 16 + h * 8), gb = *(const f32x4*)(gq + st * 16 + h * 8 + 4);
          u32x4 o;
          o.x = pack_bf16(bf2f(qf[st][0]) * rq * ga.x, bf2f(qf[st][1]) * rq * ga.y);
          o.y = pack_bf16(bf2f(qf[st][2]) * rq * ga.z, bf2f(qf[st][3]) * rq * ga.w);
          o.z = pack_bf16(bf2f(qf[st][4]) * rq * gb.x, bf2f(qf[st][5]) * rq * gb.y);
          o.w = pack_bf16(bf2f(qf[st][6]) * rq * gb.z, bf2f(qf[st][7]) * rq * gb.w);
          asm volatile("" : "+v"(o));
          qf[st] = __builtin_bit_cast(bf16x8, o);
          __builtin_amdgcn_sched_barrier(0);
        }
#pragma unroll
        for (int st = 8; st < 10; ++st) {
          const int jb = (st - 8) * 16 + h * 8;
          u32x4 o1, o2;
#pragma unroll
          for (int hf = 0; hf < 2; ++hf) {
            const f32x4 g1 = *(const f32x4*)(gq + 128 + jb + 4 * hf), g2 = *(const f32x4*)(gq + 160 + jb + 4 * hf);
            const f32x4 cc = *(const f32x4*)(cosT + tok * 32 + jb + 4 * hf), sn = *(const f32x4*)(sinT + tok * 32 + jb + 4 * hf);
            float y1[4], y2[4];
#pragma unroll
            for (int e = 0; e < 4; ++e) {
              const float x1 = bf2f(qf[st][4 * hf + e]) * rq * g1[e], x2 = bf2f(qf[st + 2][4 * hf + e]) * rq * g2[e];
              y1[e] = x1 * cc[e] - x2 * sn[e]; y2[e] = x2 * cc[e] + x1 * sn[e];
            }
            if (hf == 0) { o1.x = pack_bf16(y1[0], y1[1]); o1.y = pack_bf16(y1[2], y1[3]); o2.x = pack_bf16(y2[0], y2[1]); o2.y = pack_bf16(y2[2], y2[3]); }
            else { o1.z = pack_bf16(y1[0], y1[1]); o1.w = pack_bf16(y1[2], y1[3]); o2.z = pack_bf16(y2[0], y2[1]); o2.w = pack_bf16(y2[2], y2[3]); }
          }
          asm volatile("" : "+v"(o1), "+v"(o2));
          qf[st] = __builtin_bit_cast(bf16x8, o1); qf[st + 2] = __builtin_bit_cast(bf16x8, o2);
          __builtin_amdgcn_sched_barrier(0);
        }
      }
      f32x16 oacc[4];
#pragma unroll
      for (int mt = 0; mt < 4; ++mt)
#pragma unroll
        for (int i = 0; i < 16; ++i) oacc[mt][i] = 0.f;
      float m_run = -1e30f, l_run = 0.f;
      const int nkt = 4 * qb + 4;
      const bf16_t* kg = kbuf + (size_t)bh * S * QKH;
      const bf16_t* vg = vtb + (size_t)bh * VH * SV;
      u32x4 rk[3], rv[2];
      const unsigned kg_off0 = (unsigned)(tid >> 3) * QKH + (unsigned)(tid & 7) * 8u;
      const unsigned vg_off0 = (unsigned)(tid >> 3) * (unsigned)SV + (unsigned)(tid & 7) * 8u;
      const unsigned kl_off = (unsigned)(tid >> 3) * KLS + (unsigned)(tid & 7) * 8u;
      const unsigned vl_off = (unsigned)(tid >> 3) * VLS + (unsigned)(tid & 7) * 8u;
#define ALOAD(kt_)                                                                                                     \
  {                                                                                                                    \
    const bf16_t* kgt_ = kg + (size_t)(kt_) * 64 * QKH; const bf16_t* vgt_ = vg + (kt_) * 64;                          \
    unsigned kg_off = kg_off0, vg_off = vg_off0; asm volatile("" : "+v"(kg_off), "+v"(vg_off));                        \
    _Pragma("unroll") for (int i = 0; i < 3; ++i) rk[i] = *(const u32x4*)(kgt_ + (kg_off + (unsigned)(i * 64)));       \
    _Pragma("unroll") for (int i = 0; i < 2; ++i) rv[i] = *(const u32x4*)(vgt_ + (vg_off + (unsigned)(i * 64) * (unsigned)SV)); \
  }
      ALOAD(0);
#define ASTORE(stg_)                                                                                                   \
  {                                                                                                                    \
    bf16_t* sk_ = sm + (stg_) * ATT_STG_EL; bf16_t* sv_ = sk_ + K_EL;                                                  \
    _Pragma("unroll") for (int i = 0; i < 3; ++i) *(u32x4*)(sk_ + kl_off + i * 64) = rk[i];                            \
    _Pragma("unroll") for (int i = 0; i < 2; ++i) *(u32x4*)(sv_ + vl_off + i * 64 * VLS) = rv[i];                      \
  }
      ASTORE(0);
      __syncthreads();
      for (int kt = 0; kt < nkt; ++kt) {
        const bf16_t* smk = sm + (kt & 1) * ATT_STG_EL;
        const bf16_t* smv = smk + K_EL;
        if (kt + 1 < nkt) ALOAD(kt + 1);
        __builtin_amdgcn_sched_barrier(0);
        if (kt * 64 <= q0 + 31) {
        f32x16 sacc[2];
#pragma unroll
        for (int mt = 0; mt < 2; ++mt)
#pragma unroll
          for (int i = 0; i < 16; ++i) sacc[mt][i] = 0.f;
        const bf16_t* kp = smk + r * KLS + h * 8;
        {
          bf16x8 ka = *(const bf16x8*)(kp), kb = *(const bf16x8*)(kp + 32 * KLS);
#pragma unroll
          for (int st = 0; st < 12; ++st) {
            bf16x8 na = ka, nbq = kb;
            if (st + 1 < 12) { na = *(const bf16x8*)(kp + (st + 1) * 16); nbq = *(const bf16x8*)(kp + 32 * KLS + (st + 1) * 16); }
            sacc[0] = MFMA(ka, qf[st], sacc[0]);
            sacc[1] = MFMA(kb, qf[st], sacc[1]);
            ka = na; kb = nbq;
            __builtin_amdgcn_sched_barrier(0);
          }
        }
        bf16x8 va[2][4];
        {
          const bf16_t* vp0 = smv + r * VLS + h * 8;
#pragma unroll
          for (int mt = 0; mt < 4; ++mt) va[0][mt] = *(const bf16x8*)(vp0 + mt * 32 * VLS);
        }
        if (kt * 64 + 63 > q0) {
          const int qpos = q0 + r;
#pragma unroll
          for (int mt = 0; mt < 2; ++mt)
#pragma unroll
            for (int i = 0; i < 16; ++i) { const int key = kt * 64 + mt * 32 + crow(i, h); if (key > qpos) sacc[mt][i] = -INFINITY; }
        }
        float mx = sacc[0][0];
#pragma unroll
        for (int mt = 0; mt < 2; ++mt)
#pragma unroll
          for (int i = 0; i < 16; ++i) mx = fmaxf(mx, sacc[mt][i]);
        mx = fmaxf(mx, __shfl_xor(mx, 32));
        const float m_new = fmaxf(m_run, mx);
        const float alpha = __builtin_amdgcn_exp2f(m_run - m_new);
        m_run = m_new;
        float rs = 0.f;
#pragma unroll
        for (int mt = 0; mt < 2; ++mt)
#pragma unroll
          for (int i = 0; i < 16; ++i) { const float pv = __builtin_amdgcn_exp2f(sacc[mt][i] - m_new); sacc[mt][i] = pv; rs += pv; }
        rs += __shfl_xor(rs, 32);
        l_run = l_run * alpha + rs;
        if (__any(alpha != 1.f)) {
#pragma unroll
          for (int mt = 0; mt < 4; ++mt)
#pragma unroll
            for (int i = 0; i < 16; ++i) oacc[mt][i] *= alpha;
        }
        bf16x8 pf[4];
#pragma unroll
        for (int ks = 0; ks < 4; ++ks) {
          u32x4 o;
          o.x = pack_bf16(sacc[ks >> 1][8 * (ks & 1) + 0], sacc[ks >> 1][8 * (ks & 1) + 1]);
          o.y = pack_bf16(sacc[ks >> 1][8 * (ks & 1) + 2], sacc[ks >> 1][8 * (ks & 1) + 3]);
          o.z = pack_bf16(sacc[ks >> 1][8 * (ks & 1) + 4], sacc[ks >> 1][8 * (ks & 1) + 5]);
          o.w = pack_bf16(sacc[ks >> 1][8 * (ks & 1) + 6], sacc[ks >> 1][8 * (ks & 1) + 7]);
          pf[ks] = __builtin_bit_cast(bf16x8, o);
        }
        const bf16_t* vp = smv + r * VLS + h * 8;
        __builtin_amdgcn_sched_barrier(0);
        {
#pragma unroll
          for (int ks = 0; ks < 4; ++ks) {
            if (ks + 1 < 4) {
#pragma unroll
              for (int mt = 0; mt < 4; ++mt) va[(ks + 1) & 1][mt] = *(const bf16x8*)(vp + mt * 32 * VLS + (ks + 1) * 16);
            }
#pragma unroll
            for (int mt = 0; mt < 4; ++mt) oacc[mt] = MFMA(va[ks & 1][mt], pf[ks], oacc[mt]);
            __builtin_amdgcn_sched_barrier(0);
          }
        }
        }
        if (kt + 1 < nkt) ASTORE((kt + 1) & 1);
        __syncthreads();
      }
#undef ALOAD
#undef ASTORE
      const float inv = 1.f / l_run;
      bf16_t* op = obuf + tok * LDH + hd * VH + 4 * h;
#pragma unroll
      for (int mt = 0; mt < 4; ++mt)
#pragma unroll
        for (int a = 0; a < 4; ++a) {
          u32x2 o;
          o.x = pack_bf16(oacc[mt][4 * a] * inv, oacc[mt][4 * a + 1] * inv);
          o.y = pack_bf16(oacc[mt][4 * a + 2] * inv, oacc[mt][4 * a + 3] * inv);
          *(u32x2*)(op + mt * 32 + 8 * a) = o;
        }
      __syncthreads();
    }
  }
}

typedef Cfg<4, 1, 1, 4, 64, 1> CR;

__global__ void __launch_bounds__(512, 2) fwd_megakernel(Params p) {
  cg::grid_group grid = cg::this_grid();
  unsigned char* ws = p.ws;
  const float* x_in = p.in[0];
  const int* positions = (const int*)p.in[1];
  float* out = p.out;
  bf16_t* wgu1 = (bf16_t*)(ws + OFF_WGU1); bf16_t* wdn1 = (bf16_t*)(ws + OFF_WDN1);
  bf16_t* wgu2 = (bf16_t*)(ws + OFF_WGU2); bf16_t* wdn2 = (bf16_t*)(ws + OFF_WDN2);
  bf16_t* wpool = (bf16_t*)(ws + OFF_WPOOL); bf16_t* win = (bf16_t*)(ws + OFF_WIN); bf16_t* wq = (bf16_t*)(ws + OFF_WQ);
  bf16_t* wkv = (bf16_t*)(ws + OFF_WKV); bf16_t* wout = (bf16_t*)(ws + OFF_WOUT);
  float* cosT = (float*)(ws + OFF_COS); float* sinT = (float*)(ws + OFF_SIN);
  float* ssq_all = (float*)(ws + OFF_SSQ);
  float* kpe = (float*)(ws + OFF_KPE);
  bf16_t* hb = (bf16_t*)(ws + OFF_HB);
  bf16_t* act = (bf16_t*)(ws + OFF_ACT); bf16_t* lat = (bf16_t*)(ws + OFF_LAT); bf16_t* qraw = (bf16_t*)(ws + OFF_QRAW);
  bf16_t* kbuf = (bf16_t*)(ws + OFF_K); bf16_t* vtb = (bf16_t*)(ws + OFF_VT);
  bf16_t* obuf = lat; bf16_t* pooled = (bf16_t*)(ws + OFF_POOLED);
  const int gt = blockIdx.x * 512 + threadIdx.x, gs = gridDim.x * 512;
  const int vhalf = __builtin_amdgcn_readfirstlane((int)(threadIdx.x >> 8));
  const int vb = blockIdx.x * 2 + vhalf, nvb = gridDim.x * 2;
  bf16_t* smh = (bf16_t*)(smem + vhalf * VHALF_BYTES);
  float* smf = (float*)(smem + vhalf * VHALF_BYTES);

  unsigned* ctl = (unsigned*)(ws + OFF_CTL);
  if (threadIdx.x == 0) {
    const unsigned xcc = (unsigned)__builtin_amdgcn_s_getreg((3 << 11) | 20) & 0x7u;
    const unsigned rank = atomicAdd(ctl + xcc, 1u);
    ((volatile int*)smem)[0] = (int)xcc; ((volatile int*)smem)[1] = (int)rank;
  }
  __syncthreads();
  int xs = __builtin_amdgcn_readfirstlane(((volatile int*)smem)[0]);
  int js = __builtin_amdgcn_readfirstlane(((volatile int*)smem)[1]);
  __syncthreads();

  for (int idx = gt; idx < T * 32; idx += gs) {
    const int t = idx >> 5, jf = idx & 31;
    const float inv_freq = exp2f(-(float)jf * 0.41524101186092029f);
    const float ang = (float)positions[t] * inv_freq;
    const double rev = (double)ang * 0.15915494309189535;
    const float fr = (float)(rev - rint(rev));
    cosT[idx] = __builtin_amdgcn_cosf(fr);
    sinT[idx] = __builtin_amdgcn_sinf(fr);
  }
  for (int i = gt; i < 15 * T; i += gs) ssq_all[T + i] = 0.f;
  norm0_phase(x_in, hb, ssq_all);
  for (int jl = 0; jl < 2; ++jl) {
    for (int g = 0; g < 4; ++g)
      prep_w(vb, nvb, p.in[7] + ((size_t)jl * 4 + g) * 65536, wpool + ((size_t)jl * 4 + g) * 256 * (256 + PADK), 256, 256, p.in[6] + (size_t)(2 * jl) * D + g * 256, p.in[8] + (size_t)jl * D + g * 256, 0, smf);
    prep_w(vb, nvb, p.in[9] + (size_t)jl * D * 1088, win + (size_t)jl * LATNP * (D + PADK), D, 1088, p.in[6] + (size_t)(2 * jl + 1) * D, nullptr, 0, smf);
    for (int i = gt; i < (LATNP - 1088) * (D + PADK) / 8; i += gs) ((u32x4*)(win + (size_t)jl * LATNP * (D + PADK) + (size_t)1088 * (D + PADK)))[i] = (u32x4){0u, 0u, 0u, 0u};
    prep_w(vb, nvb, p.in[11] + (size_t)jl * QL * 1536, wq + (size_t)jl * 1536 * (QL + PADK), QL, 1536, p.in[10] + (size_t)jl * QL, nullptr, 0, smf);
    prep_w(vb, nvb, p.in[13] + (size_t)jl * KVL * 2048, wkv + (size_t)jl * 2048 * (KVL + PADK), KVL, 2048, p.in[12] + (size_t)jl * KVL, nullptr, 3, smf);
    prep_w(vb, nvb, p.in[16] + (size_t)jl * D * D, wout + (size_t)jl * D * (D + PADK), D, D, nullptr, nullptr, 0, smf);
  }
#define PREP_FFN1(L_) { const size_t wo_ = (size_t)(L_) * D * FF; \
    prep_w(vb, nvb, p.in[3] + wo_, wgu1, D, FF, p.in[2] + (size_t)(L_) * D, nullptr, 1, smf); \
    prep_w(vb, nvb, p.in[4] + wo_, wgu1, D, FF, p.in[2] + (size_t)(L_) * D, nullptr, 2, smf); \
    prep_w(vb, nvb, p.in[5] + wo_, wdn1, FF, D, nullptr, nullptr, 0, smf); }
#define PREP_FFN2(L_) { const size_t wo_ = (size_t)(L_) * D * FF; \
    prep_w(vb, nvb, p.in[18] + wo_, wgu2, D, FF, p.in[17] + (size_t)(L_) * D, nullptr, 1, smf); \
    prep_w(vb, nvb, p.in[19] + wo_, wgu2, D, FF, p.in[17] + (size_t)(L_) * D, nullptr, 2, smf); \
    prep_w(vb, nvb, p.in[20] + wo_, wdn2, FF, D, nullptr, nullptr, 0, smf); }
  PREP_FFN1(0);
  PREP_FFN2(0);
  grid.sync();
  {
    bool even = true;
    for (int i = 0; i < 8; ++i) even = even && (__hip_atomic_load(ctl + i, __ATOMIC_RELAXED, __HIP_MEMORY_SCOPE_AGENT) == (gridDim.x >> 3));
    if (!even || js >= (int)(gridDim.x >> 3)) { xs = blockIdx.x & 7; js = blockIdx.x >> 3; }
  }
  unsigned bar_target = 0;
#define GBAR() { bar_target += gridDim.x; grid_bar(ctl + 32, bar_target); }
  unsigned xbar_target = 0;
#define XBAR() { xbar_target += (gridDim.x >> 3); grid_bar(ctl + 48 + xs, xbar_target); }
  const int jv = js * 2 + vhalf, nbv = (int)(gridDim.x >> 3) * 2;

  for (int layer = 0; layer < DEPTH; ++layer) {
    const float* xcur = (layer == 0) ? x_in : out;
    float* ssq0 = ssq_all + (size_t)(layer * 3 + 0) * T;
    float* ssq1 = ssq_all + (size_t)(layer * 3 + 1) * T;
    float* ssq2 = ssq_all + (size_t)(layer * 3 + 2) * T;
    float* ssq_next = ssq_all + (size_t)((layer + 1) * 3) * T;
    const int jl = layer >> 1;
    float* ssq_q = ssq_all + (size_t)(12 + jl) * T;
    float* ssq_kv = ssq_all + (size_t)(14 + jl) * T;
    if (layer > 0) PREP_FFN2(layer);
    gemm8_phase(xs, js, hb, LDH, wgu1, D, 2 * FF, 0, EpiGU8{act, ssq0});
    XBAR();
    gemm8_phase(xs, js, act, LDA, wdn1, FF, D, 0, EpiResid8{xcur, out, 0.5f, hb, ssq1});
    GBAR();
    if (layer + 1 < DEPTH) PREP_FFN1(layer + 1);
    if ((layer & 1) == 0) {
      poolprep_phase(vb, nvb, out, ssq1, pooled, smf);
      GBAR();
      gemm8_phase(xs, js, pooled, LDH, wpool + (size_t)jl * 1024 * (256 + PADK), 256, D, 256, EpiResid8{out, out, 1.0f, hb, ssq2});
      GBAR();
    } else {
      gemm8_phase(xs, js, hb, LDH, win + (size_t)jl * LATNP * (D + PADK), D, LATNP, 0, EpiLat8{lat, kpe, ssq_q, ssq_kv, ssq1});
      GBAR();
      gemm8_phase(xs, js, lat, LDH, wq + (size_t)jl * 1536 * (QL + PADK), QL, 1536, 0, EpiQraw8{qraw, ssq_q});
      gemm_phase<CR>(xs, jv, nbv, lat + QL, LDH, wkv + (size_t)jl * 2048 * (KVL + PADK), KVL, 2048, 0, EpiKV{ssq_kv, kpe, p.in[15] + (size_t)jl * QKH, cosT, sinT, kbuf, vtb}, smh);
      GBAR();
      attn_phase(qraw, kbuf, vtb, obuf, p.in[14] + (size_t)jl * QKH, cosT, sinT, (bf16_t*)smem, xs, js);
      GBAR();
      gemm8_phase(xs, js, obuf, LDH, wout + (size_t)jl * D * (D + PADK), D, D, 0, EpiResid8{out, out, 1.0f, hb, ssq2});
      GBAR();
    }
    gemm8_phase(xs, js, hb, LDH, wgu2, D, 2 * FF, 0, EpiGU8{act, ssq2});
    XBAR();
    const bool last = (layer + 1 == DEPTH);
    gemm8_phase(xs, js, act, LDA, wdn2, FF, D, 0, EpiResid8{out, out, 0.5f, last ? nullptr : hb, last ? nullptr : ssq_next});
    if (!last) GBAR();
  }
}

extern "C" void kernel_launch(void* const* d_in, const int* in_sizes, int n_in, void* d_out, int out_size, void* d_ws, size_t ws_size, hipStream_t stream) {
  static int grid_blocks = 0;
  if (!grid_blocks) {
    int dev = 0, cus = 0, per_cu = 0;
    (void)hipGetDevice(&dev);
    (void)hipDeviceGetAttribute(&cus, hipDeviceAttributeMultiprocessorCount, dev);
    (void)hipFuncSetAttribute((const void*)fwd_megakernel, hipFuncAttributeMaxDynamicSharedMemorySize, LDS_BYTES);
    (void)hipOccupancyMaxActiveBlocksPerMultiprocessor(&per_cu, fwd_megakernel, 512, LDS_BYTES);
    grid_blocks = cus;
    if (n_in != 21 || out_size != T * D || ws_size < WS_TOTAL || per_cu < 1) fprintf(stderr, "kernel_launch: unexpected n_in=%d out=%d ws=%zu (need %zu) per_cu=%d\n", n_in, out_size, ws_size, (size_t)WS_TOTAL, per_cu);
  }
  Params p{};
  for (int i = 0; i < 21; ++i) p.in[i] = (const float*)d_in[i];
  p.out = (float*)d_out; p.ws = (unsigned char*)d_ws;
  (void)hipMemsetAsync((unsigned char*)d_ws + OFF_CTL, 0, 256, stream);
  void* args[] = {&p};
  hipError_t e = hipLaunchCooperativeKernel((void*)fwd_megakernel, dim3(grid_blocks), dim3(512), args, LDS_BYTES, stream);
  if (e != hipSuccess) fprintf(stderr, "cooperative launch failed: %s (grid %d)\n", hipGetErrorString(e), grid_blocks);
}
```

```cpp
#include <hip/hip_runtime.h>
#include <hip/hip_cooperative_groups.h>
#include <cstdio>
#include <cstdint>
namespace cg = cooperative_groups;

#define DI __device__ __forceinline__
typedef unsigned short bf16_t;
typedef short bf16x8 __attribute__((ext_vector_type(8)));
typedef float f32x16 __attribute__((ext_vector_type(16)));
typedef float f32x4 __attribute__((ext_vector_type(4)));
typedef float f32x2 __attribute__((ext_vector_type(2)));
typedef unsigned u32x4 __attribute__((ext_vector_type(4)));
typedef unsigned u32x2 __attribute__((ext_vector_type(2)));
typedef __bf16 bf16v2 __attribute__((ext_vector_type(2)));

constexpr int NB = 2, S = 16384, T = NB * S, D = 1024, FF = 2816, NH = 8, DEPTH = 4;
constexpr int QL = 768, KVL = 256, QKH = 192, VH = 128;
constexpr int LATNP = 1280;
constexpr int LDH = D + 64;
constexpr int LDA = FF + 64;
constexpr int SV = S + 64;
constexpr int PADK = 64;
constexpr float EPS = 1e-6f;

constexpr size_t SZ_WGU = (size_t)2 * FF * (D + PADK) * 2, SZ_WDN = (size_t)D * (FF + PADK) * 2;
constexpr size_t OFF_WGU1 = 0, OFF_WDN1 = OFF_WGU1 + SZ_WGU, OFF_WGU2 = OFF_WDN1 + SZ_WDN, OFF_WDN2 = OFF_WGU2 + SZ_WGU;
constexpr size_t SZ_WPOOL = (size_t)1024 * (256 + PADK) * 2, SZ_WIN = (size_t)LATNP * (D + PADK) * 2, SZ_WQ = (size_t)1536 * (QL + PADK) * 2;
constexpr size_t SZ_WKV = (size_t)2048 * (KVL + PADK) * 2, SZ_WOUT = (size_t)D * (D + PADK) * 2;
constexpr size_t OFF_WPOOL = OFF_WDN2 + SZ_WDN;
constexpr size_t OFF_WIN = OFF_WPOOL + 2 * SZ_WPOOL;
constexpr size_t OFF_WQ = OFF_WIN + 2 * SZ_WIN;
constexpr size_t OFF_WKV = OFF_WQ + 2 * SZ_WQ;
constexpr size_t OFF_WOUT = OFF_WKV + 2 * SZ_WKV;
constexpr size_t OFF_COS = OFF_WOUT + 2 * SZ_WOUT;
constexpr size_t OFF_SIN = OFF_COS + (size_t)T * 32 * 4;
constexpr size_t OFF_SSQ = OFF_SIN + (size_t)T * 32 * 4;
constexpr size_t OFF_KPE = OFF_SSQ + (size_t)16 * T * 4;
constexpr size_t OFF_HB = OFF_KPE + (size_t)T * 64 * 4;
constexpr size_t OFF_BIG = OFF_HB + (size_t)T * LDH * 2;
constexpr size_t OFF_ACT = OFF_BIG;
constexpr size_t OFF_LAT = OFF_BIG;
constexpr size_t OFF_POOLED = OFF_BIG;
constexpr size_t OFF_QRAW = OFF_LAT + (size_t)T * LDH * 2;
constexpr size_t OFF_K = OFF_QRAW + (size_t)T * 1536 * 2;
constexpr size_t OFF_VT = OFF_K + (size_t)T * NH * QKH * 2;
constexpr size_t WS_END = OFF_VT + (size_t)NB * NH * VH * SV * 2;
static_assert(OFF_ACT + (size_t)T * LDA * 2 <= WS_END, "act must fit in the big region");
constexpr size_t OFF_CTL = WS_END;
constexpr size_t WS_TOTAL = OFF_CTL + 256;
static_assert(WS_TOTAL <= (size_t)536870912, "workspace budget (4 x largest tensor)");
constexpr int LDS_BYTES = 131072;
constexpr int VHALF_BYTES = 36864;

struct Params { const float* in[21]; float* out; unsigned char* ws; };
extern __shared__ __attribute__((aligned(1024))) unsigned char smem[];

DI unsigned pack_bf16(float lo, float hi) { f32x2 v = {lo, hi}; bf16v2 b = __builtin_convertvector(v, bf16v2); return __builtin_bit_cast(unsigned, b); }
DI bf16_t to_bf16(float x) { return (bf16_t)(pack_bf16(x, 0.f) & 0xffffu); }
DI float bf2f(short v) { return __uint_as_float(((unsigned)(unsigned short)v) << 16); }
DI int crow(int i, int h) { return (i & 3) + 8 * (i >> 2) + 4 * h; }
DI float red32(float v) { v += __shfl_xor(v, 1); v += __shfl_xor(v, 2); v += __shfl_xor(v, 4); v += __shfl_xor(v, 8); v += __shfl_xor(v, 16); return v; }
DI float red64(float v) { v = red32(v); v += __shfl_xor(v, 32); return v; }
DI float xmax32(float v) { const u32x2 r = __builtin_amdgcn_permlane32_swap(__float_as_uint(v), __float_as_uint(v), false, false); return fmaxf(__uint_as_float(r.x), __uint_as_float(r.y)); }
DI float xsum32(float v) { const u32x2 r = __builtin_amdgcn_permlane32_swap(__float_as_uint(v), __float_as_uint(v), false, false); return __uint_as_float(r.x) + __uint_as_float(r.y); }
DI int opaque_tid() { int t = threadIdx.x & 255; asm volatile("" : "+v"(t)); return t; }
DI int opaque_tid512() { int t = threadIdx.x; asm volatile("" : "+v"(t)); return t; }
#define MFMA(a, b, c) __builtin_amdgcn_mfma_f32_32x32x16_bf16((a), (b), (c), 0, 0, 0)
DI void grid_bar(unsigned* ctr, unsigned target) {
  asm volatile("s_waitcnt vmcnt(0)" ::: "memory");
  __syncthreads();
  if (threadIdx.x == 0) {
    __builtin_amdgcn_fence(__ATOMIC_RELEASE, "agent");
    asm volatile("s_waitcnt vmcnt(0)" ::: "memory");
    (void)__hip_atomic_fetch_add(ctr, 1u, __ATOMIC_RELAXED, __HIP_MEMORY_SCOPE_AGENT);
    while (__hip_atomic_load(ctr, __ATOMIC_RELAXED, __HIP_MEMORY_SCOPE_AGENT) < target) __builtin_amdgcn_s_sleep(1);
    __builtin_amdgcn_fence(__ATOMIC_ACQUIRE, "agent");
    asm volatile("s_waitcnt vmcnt(0)" ::: "memory");
  }
  __syncthreads();
}

DI void prep_w(int vb, int nvb, const float* __restrict__ W, bf16_t* __restrict__ Wt, int K, int N, const float* __restrict__ gk, const float* __restrict__ sn, int mode, float* smf) {
  const int ldt = K + PADK;
  const int tid = opaque_tid();
  const int ntn = N / 64, nt = (K / 64) * ntn;
  for (int t0 = 0; t0 < nt; t0 += nvb) {
    const int t = t0 + vb;
    const bool on = t < nt;
    const int k0 = (t / ntn) * 64, n0 = (t % ntn) * 64;
    if (on) {
#pragma unroll
      for (int i = 0; i < 16; ++i) {
        const int kk = i * 4 + (tid >> 6), nn = tid & 63;
        float v = __builtin_nontemporal_load(W + (size_t)(k0 + kk) * N + n0 + nn);
        if (gk) v *= gk[k0 + kk];
        if (sn) v *= sn[n0 + nn];
        smf[kk * 65 + nn] = v;
      }
    }
    __syncthreads();
    if (on) {
      const int nl = tid >> 2, kq = (tid & 3) * 16;
      u32x4 p0, p1;
      p0.x = pack_bf16(smf[(kq + 0) * 65 + nl], smf[(kq + 1) * 65 + nl]);
      p0.y = pack_bf16(smf[(kq + 2) * 65 + nl], smf[(kq + 3) * 65 + nl]);
      p0.z = pack_bf16(smf[(kq + 4) * 65 + nl], smf[(kq + 5) * 65 + nl]);
      p0.w = pack_bf16(smf[(kq + 6) * 65 + nl], smf[(kq + 7) * 65 + nl]);
      p1.x = pack_bf16(smf[(kq + 8) * 65 + nl], smf[(kq + 9) * 65 + nl]);
      p1.y = pack_bf16(smf[(kq + 10) * 65 + nl], smf[(kq + 11) * 65 + nl]);
      p1.z = pack_bf16(smf[(kq + 12) * 65 + nl], smf[(kq + 13) * 65 + nl]);
      p1.w = pack_bf16(smf[(kq + 14) * 65 + nl], smf[(kq + 15) * 65 + nl]);
      const int n = n0 + nl;
      int row = n;
      if (mode == 1) row = (n >> 4) * 32 + (n & 15);
      else if (mode == 2) row = (n >> 4) * 32 + 16 + (n & 15);
      else if (mode == 3) { const int hd = n >> 8, j = n & 255; row = (j < 128) ? (hd * 128 + j) : (1024 + hd * 128 + (j - 128)); }
      u32x4* dst = (u32x4*)(Wt + (size_t)row * ldt + k0 + kq);
      dst[0] = p0; dst[1] = p1;
    }
    __syncthreads();
  }
}

template <int WM_, int WN_, int MI_, int NI_, int BK_, int ST_>
struct Cfg {
  static constexpr int WM = WM_, WN = WN_, MI = MI_, NI = NI_, BK = BK_, ST = ST_;
  static constexpr int BM = WM * MI * 32, BN = WN * NI * 32;
  static constexpr int LS = BK + 8;
  static constexpr int A_EL = BM * LS, B_EL = BN * LS, STAGE_EL = A_EL + B_EL;
  static constexpr int CPR = BK / 8;
  static constexpr int A_CH = BM * CPR / 256, B_CH = BN * CPR / 256;
  static_assert(WM * WN == 4, "4 waves");
  static_assert(ST * STAGE_EL * 2 <= VHALF_BYTES, "LDS of a virtual half-block");
};

template <class C, class Epi>
DI void gemm_tile(const bf16_t* __restrict__ A, int lda, const bf16_t* __restrict__ Bt, int K, int m0, int n0, const Epi& epi, bf16_t* sm) {
  const int tid = opaque_tid(), lane = tid & 63, wave = tid >> 6, r = lane & 31, h = lane >> 5;
  const int wm = wave / C::WN, wn = wave % C::WN;
  f32x16 acc[C::MI][C::NI];
#pragma unroll
  for (int mi = 0; mi < C::MI; ++mi)
#pragma unroll
    for (int ni = 0; ni < C::NI; ++ni)
#pragma unroll
      for (int i = 0; i < 16; ++i) acc[mi][ni][i] = 0.f;
  const bf16_t* Ag = A + (size_t)m0 * lda;
  const int ldb = K + PADK;
  const bf16_t* Bg = Bt + (size_t)n0 * ldb;
  u32x4 ra[C::A_CH], rb[C::B_CH];
  const int nk = K / C::BK;
  constexpr int RPP = 256 / C::CPR;
  const unsigned a_off = (unsigned)(tid / C::CPR) * (unsigned)lda + (unsigned)(tid % C::CPR) * 8u;
  const unsigned b_off = (unsigned)(tid / C::CPR) * (unsigned)ldb + (unsigned)(tid % C::CPR) * 8u;
  const unsigned l_off = (unsigned)(tid / C::CPR) * C::LS + (unsigned)(tid % C::CPR) * 8u;
#define GLOAD(k0_)                                                                                   \
  {                                                                                                  \
    const bf16_t* ag_ = Ag + (k0_); const bf16_t* bg_ = Bg + (k0_);                                  \
    _Pragma("unroll") for (int i = 0; i < C::A_CH; ++i) ra[i] = *(const u32x4*)(ag_ + (a_off + (unsigned)(i * RPP) * (unsigned)lda)); \
    _Pragma("unroll") for (int i = 0; i < C::B_CH; ++i) rb[i] = *(const u32x4*)(bg_ + (b_off + (unsigned)(i * RPP) * (unsigned)ldb));   \
  }
#define LSTORE(buf_)                                                                                 \
  {                                                                                                  \
    bf16_t* sa_ = sm + (buf_) * C::STAGE_EL + l_off; bf16_t* sb_ = sa_ + C::A_EL;                    \
    _Pragma("unroll") for (int i = 0; i < C::A_CH; ++i) *(u32x4*)(sa_ + i * RPP * C::LS) = ra[i];   \
    _Pragma("unroll") for (int i = 0; i < C::B_CH; ++i) *(u32x4*)(sb_ + i * RPP * C::LS) = rb[i];   \
  }
  GLOAD(0);
  if (C::ST == 2) {
    LSTORE(0);
    __syncthreads();
  }
  for (int kt = 0; kt < nk; ++kt) {
    const int buf = (C::ST == 2) ? (kt & 1) : 0;
    if (C::ST == 1) {
      __syncthreads();
      LSTORE(0);
      __syncthreads();
    }
    if (kt + 1 < nk) GLOAD((kt + 1) * C::BK);
    __builtin_amdgcn_sched_barrier(0);
    const bf16_t* sa = sm + buf * C::STAGE_EL + (wm * C::MI * 32 + r) * C::LS + h * 8;
    const bf16_t* sb = sm + buf * C::STAGE_EL + C::A_EL + (wn * C::NI * 32 + r) * C::LS + h * 8;
#pragma unroll
    for (int ks = 0; ks < C::BK / 16; ++ks) {
      bf16x8 af[C::MI], bfr[C::NI];
#pragma unroll
      for (int mi = 0; mi < C::MI; ++mi) af[mi] = *(const bf16x8*)(sa + mi * 32 * C::LS + ks * 16);
#pragma unroll
      for (int ni = 0; ni < C::NI; ++ni) bfr[ni] = *(const bf16x8*)(sb + ni * 32 * C::LS + ks * 16);
#pragma unroll
      for (int mi = 0; mi < C::MI; ++mi)
#pragma unroll
        for (int ni = 0; ni < C::NI; ++ni) acc[mi][ni] = MFMA(af[mi], bfr[ni], acc[mi][ni]);
    }
    if (C::ST == 2) {
      if (kt + 1 < nk) LSTORE((kt + 1) & 1);
      __syncthreads();
    }
  }
  if (C::ST == 1) __syncthreads();
#undef GLOAD
#undef LSTORE
  epi.template run<C::MI, C::NI>(acc, m0 + wm * C::MI * 32, n0 + wn * C::NI * 32, r, h);
}

template <class C, class Epi>
DI void gemm_phase(int x, int j, int nb, const bf16_t* __restrict__ A, int lda, const bf16_t* __restrict__ Bt, int K, int N, int a_grp, const Epi& epi, bf16_t* sm) {
  static_assert(C::BM == 128 && (C::BN == 128 || C::BN == 256), "tile");
  constexpr int GN = (C::BN == 256) ? 4 : 8;
  const int nN = N / C::BN;
  const int total = 32 * nN;
  for (int u = j; u < total; u += nb) {
    const int ng = u / (32 * GN), rem = u % (32 * GN);
    int gn = nN - GN * ng; if (gn > GN) gn = GN;
    const int mg = rem / (8 * gn), jj = rem % (8 * gn);
    const int mt = 32 * x + 8 * mg + (jj & 7), nt = GN * ng + (jj >> 3);
    const int n0 = nt * C::BN;
    const bf16_t* Ap = a_grp ? (A + (n0 / a_grp) * K) : A;
    gemm_tile<C, Epi>(Ap, lda, Bt, K, mt * 128, n0, epi, sm);
  }
}

struct EpiGU {
  bf16_t* act; const float* ssq;
  template <int MI, int NI> DI void run(f32x16 (&acc)[MI][NI], int mb, int nb, int r, int h) const {
    static_assert((NI & 1) == 0, "gate/up pairs");
#pragma unroll
    for (int mi = 0; mi < MI; ++mi)
#pragma unroll
      for (int i = 0; i < 16; ++i) {
        const int row = mb + mi * 32 + crow(i, h);
        const float rs = rsqrtf(ssq[row] * (1.f / D) + EPS);
#pragma unroll
        for (int pi = 0; pi < NI / 2; ++pi) {
          const float g = acc[mi][2 * pi][i] * rs, u = acc[mi][2 * pi + 1][i] * rs;
          const float a = g / (1.f + __expf(-g)) * u;
          act[(size_t)row * LDA + (nb >> 1) + pi * 32 + r] = to_bf16(a);
        }
      }
  }
};
struct EpiResid {
  const float* xin; float* xout; float scale; bf16_t* xb; float* ssq;
  template <int MI, int NI> DI void run(f32x16 (&acc)[MI][NI], int mb, int nb, int r, int h) const {
#pragma unroll
    for (int mi = 0; mi < MI; ++mi)
#pragma unroll
      for (int hf = 0; hf < 2; ++hf) {
        float xv[8][NI];
#pragma unroll
        for (int i = 0; i < 8; ++i)
#pragma unroll
          for (int ni = 0; ni < NI; ++ni) xv[i][ni] = xin[(size_t)(mb + mi * 32 + crow(hf * 8 + i, h)) * D + nb + ni * 32 + r];
        __builtin_amdgcn_sched_barrier(0);
        float ssv[8];
#pragma unroll
        for (int i = 0; i < 8; ++i) {
          const int row = mb + mi * 32 + crow(hf * 8 + i, h);
          float ss = 0.f;
#pragma unroll
          for (int ni = 0; ni < NI; ++ni) {
            const float v = xv[i][ni] + scale * acc[mi][ni][hf * 8 + i];
            xout[(size_t)row * D + nb + ni * 32 + r] = v;
            if (xb) { xb[(size_t)row * LDH + nb + ni * 32 + r] = to_bf16(v); ss += v * v; }
          }
          ssv[i] = ss;
        }
        if (xb) {
#pragma unroll
          for (int i = 0; i < 8; ++i) { const float t = red32(ssv[i]); if (r == 0) atomicAdd(ssq + mb + mi * 32 + crow(hf * 8 + i, h), t); }
        }
        __builtin_amdgcn_sched_barrier(0);
      }
  }
};
struct EpiLat {
  bf16_t* lat; float* kpe; float* ssq_q; float* ssq_kv; const float* ssq_x;
  template <int MI, int NI> DI void run(f32x16 (&acc)[MI][NI], int mb, int nb, int r, int h) const {
    if (nb >= 1088) return;
    float* ssq = (nb < QL) ? ssq_q : ssq_kv;
#pragma unroll
    for (int mi = 0; mi < MI; ++mi) {
      float rsv[16];
#pragma unroll
      for (int i = 0; i < 16; ++i) rsv[i] = rsqrtf(ssq_x[mb + mi * 32 + crow(i, h)] * (1.f / D) + EPS);
      __builtin_amdgcn_sched_barrier(0);
      if (nb >= 1024) {
#pragma unroll
        for (int i = 0; i < 16; ++i)
#pragma unroll
          for (int ni = 0; ni < NI; ++ni) kpe[(size_t)(mb + mi * 32 + crow(i, h)) * 64 + (nb - 1024) + ni * 32 + r] = acc[mi][ni][i] * rsv[i];
      } else {
        float ssv[16];
#pragma unroll
        for (int i = 0; i < 16; ++i) {
          const int row = mb + mi * 32 + crow(i, h);
          float ss = 0.f;
#pragma unroll
          for (int ni = 0; ni < NI; ++ni) { const float v = acc[mi][ni][i] * rsv[i]; ss += v * v; lat[(size_t)row * LDH + nb + ni * 32 + r] = to_bf16(v); }
          ssv[i] = ss;
        }
#pragma unroll
        for (int i = 0; i < 16; ++i) { const float t = red32(ssv[i]); if (r == 0) atomicAdd(ssq + mb + mi * 32 + crow(i, h), t); }
      }
    }
  }
};
struct EpiQraw {
  bf16_t* q; const float* ssq_q;
  template <int MI, int NI> DI void run(f32x16 (&acc)[MI][NI], int mb, int nb, int r, int h) const {
#pragma unroll
    for (int mi = 0; mi < MI; ++mi)
#pragma unroll
      for (int i = 0; i < 16; ++i) {
        const int row = mb + mi * 32 + crow(i, h);
        const float rs = rsqrtf(ssq_q[row] * (1.f / QL) + EPS);
#pragma unroll
        for (int ni = 0; ni < NI; ++ni) q[(size_t)row * 1536 + nb + ni * 32 + r] = to_bf16(acc[mi][ni][i] * rs);
      }
  }
};
struct EpiKV {
  const float* ssq_kv; const float* kpe; const float* gk; const float* cosT; const float* sinT; bf16_t* kout; bf16_t* vt;
  template <int MI, int NI> DI void run(f32x16 (&acc)[MI][NI], int mb, int nb, int r, int h) const {
    static_assert(MI == 1 && NI == 4, "kv epilogue layout");
    const int b = mb / S, sb = mb % S;
    if (nb < 1024) {
      const int head = nb >> 7;
      const float g0 = gk[r], g1 = gk[32 + r], g2 = gk[64 + r], g3 = gk[96 + r], g4 = gk[128 + r], g5 = gk[160 + r];
#pragma unroll
      for (int i = 0; i < 16; ++i) {
        const int rw = crow(i, h), tok = mb + rw;
        const float rkv = rsqrtf(ssq_kv[tok] * (1.f / KVL) + EPS);
        const float v0 = acc[0][0][i] * rkv, v1 = acc[0][1][i] * rkv, v2 = acc[0][2][i] * rkv, v3 = acc[0][3][i] * rkv;
        const float p1 = kpe[(size_t)tok * 64 + r], p2 = kpe[(size_t)tok * 64 + 32 + r];
        float ss = v0 * v0 + v1 * v1 + v2 * v2 + v3 * v3 + p1 * p1 + p2 * p2;
        ss = red32(ss);
        const float rk = rsqrtf(ss * (1.f / QKH) + EPS);
        bf16_t* kr = kout + ((size_t)(b * NH + head) * S + sb + rw) * QKH;
        kr[r] = to_bf16(v0 * rk * g0); kr[32 + r] = to_bf16(v1 * rk * g1); kr[64 + r] = to_bf16(v2 * rk * g2); kr[96 + r] = to_bf16(v3 * rk * g3);
        const float c = cosT[(size_t)tok * 32 + r], sn = sinT[(size_t)tok * 32 + r];
        const float x1 = p1 * rk * g4, x2 = p2 * rk * g5;
        kr[128 + r] = to_bf16(x1 * c - x2 * sn); kr[160 + r] = to_bf16(x2 * c + x1 * sn);
      }
    } else {
      const int head = (nb - 1024) >> 7;
      float rkv[16];
#pragma unroll
      for (int i = 0; i < 16; ++i) rkv[i] = rsqrtf(ssq_kv[mb + crow(i, h)] * (1.f / KVL) + EPS);
#pragma unroll
      for (int ni = 0; ni < 4; ++ni) {
        bf16_t* vr = vt + ((size_t)(b * NH + head) * VH + ni * 32 + r) * SV + sb;
#pragma unroll
        for (int a = 0; a < 4; ++a) {
          u32x2 o;
          o.x = pack_bf16(acc[0][ni][4 * a] * rkv[4 * a], acc[0][ni][4 * a + 1] * rkv[4 * a + 1]);
          o.y = pack_bf16(acc[0][ni][4 * a + 2] * rkv[4 * a + 2], acc[0][ni][4 * a + 3] * rkv[4 * a + 3]);
          *(u32x2*)(vr + 16 * (a >> 1) + 8 * h + 4 * (a & 1)) = o;
        }
      }
    }
  }
};


DI int lds_byte2(int r, int c) { const int st = (r >> 4) * 2 + (c >> 5), ob = (r & 15) * 64 + (c & 31) * 2; return st * 1024 + (ob ^ (((ob >> 9) & 1) << 5)); }
DI void stage_rc2(int b, int& R, int& C) { const int st = b >> 10, sb = b & 1023, swz = sb ^ (((sb >> 9) & 1) << 5); R = (st >> 1) * 16 + swz / 64; C = (st & 1) * 32 + (swz % 64) / 2; }
#define MFMA16(a, b, c) __builtin_amdgcn_mfma_f32_16x16x32_bf16((a), (b), (c), 0, 0, 0)
constexpr int G8_TILE_B = 256 * 64 * 2, G8_STAGE_B = 2 * G8_TILE_B;

template <class Epi>
DI void gemm8_tile(const bf16_t* __restrict__ Ab, int lda, const bf16_t* __restrict__ Bb, int ldb, int K, int brow, int bcol, const Epi epi,
                   bool staged, bool has_next, const bf16_t* __restrict__ Abn, const bf16_t* __restrict__ Bbn) {
  const int tid = opaque_tid512(), wid = tid >> 6, lane = tid & 63, wr = wid >> 2, wc = wid & 3, fr = lane & 15, fq = lane >> 4;
  unsigned aoff[4], boff[4];
#pragma unroll
  for (int i = 0; i < 4; ++i) { int R, C; stage_rc2(wid * 1024 + i * 8192 + lane * 16, R, C); aoff[i] = (unsigned)R * (unsigned)lda + (unsigned)C; boff[i] = (unsigned)R * (unsigned)ldb + (unsigned)C; }
#define G8_STAGE_R(buf_, ap_, bp_, i0_, i1_)                                                                         \
  {                                                                                                                  \
    const bf16_t* ag_ = (ap_); const bf16_t* bg_ = (bp_);                                                            \
    _Pragma("unroll") for (int i = (i0_); i < (i1_); ++i) {                                                          \
      __builtin_amdgcn_global_load_lds((const unsigned*)(ag_ + aoff[i]), (unsigned*)(smem + (buf_) * G8_STAGE_B + wid * 1024 + i * 8192), 16, 0, 0);              \
      __builtin_amdgcn_global_load_lds((const unsigned*)(bg_ + boff[i]), (unsigned*)(smem + (buf_) * G8_STAGE_B + G8_TILE_B + wid * 1024 + i * 8192), 16, 0, 0);  \
    }                                                                                                                \
  }
#define G8_STAGE(buf_, ap_, bp_) G8_STAGE_R(buf_, ap_, bp_, 0, 4)
  f32x4 acc[8][4];
#pragma unroll
  for (int m = 0; m < 8; ++m)
#pragma unroll
    for (int n = 0; n < 4; ++n) acc[m][n] = (f32x4){0.f, 0.f, 0.f, 0.f};
  const int nt = K / 64;
  if (!staged) {
    G8_STAGE(0, Ab, Bb);
    asm volatile("s_waitcnt vmcnt(0)" ::: "memory");
    __syncthreads();
  }
  for (int t = 0; t < nt; ++t) {
    const int cur = t & 1;
    const unsigned char* sa = smem + cur * G8_STAGE_B;
    const unsigned char* sb = sa + G8_TILE_B;
#pragma unroll
    for (int ks = 0; ks < 2; ++ks) {
      bf16x8 At[8], Bf[4];
#pragma unroll
      for (int m = 0; m < 8; ++m) At[m] = *(const bf16x8*)(sa + lds_byte2(wr * 128 + m * 16 + fr, ks * 32 + fq * 8));
#pragma unroll
      for (int n = 0; n < 4; ++n) Bf[n] = *(const bf16x8*)(sb + lds_byte2(wc * 64 + n * 16 + fr, ks * 32 + fq * 8));
      {
        __builtin_amdgcn_sched_barrier(0);
        if (t + 1 < nt) { G8_STAGE_R(cur ^ 1, Ab + (t + 1) * 64, Bb + (t + 1) * 64, 2 * ks, 2 * ks + 2); }
        else if (has_next) { G8_STAGE_R(0, Abn, Bbn, 2 * ks, 2 * ks + 2); }
        __builtin_amdgcn_sched_barrier(0);
      }
#pragma unroll
      for (int m = 0; m < 8; ++m)
#pragma unroll
        for (int n = 0; n < 4; ++n) acc[m][n] = MFMA16(At[m], Bf[n], acc[m][n]);
      __builtin_amdgcn_sched_barrier(0);
    }
    asm volatile("s_waitcnt vmcnt(0)" ::: "memory");
    __syncthreads();
  }
#undef G8_STAGE
#undef G8_STAGE_R
  epi.run8(acc, brow + wr * 128, bcol + wc * 64, fr, fq);
  if (Epi::LDS_SCRATCH) __syncthreads();
}

DI void g8_decode(int u, int x, int nN, int& pm, int& pn) {
  const int ng = u >> 6, rem = u & 63;
  int gn = nN - 4 * ng; if (gn > 4) gn = 4;
  const int mg = rem / (8 * gn), jj = rem % (8 * gn);
  pm = 16 * x + 8 * mg + (jj & 7); pn = 4 * ng + (jj >> 3);
}
template <class Epi>
DI void gemm8_phase(int x, int j, const bf16_t* __restrict__ A, int lda, const bf16_t* __restrict__ Bt, int K, int N, int a_grp, const Epi epi) {
  const int nN = N / 256, nb = gridDim.x >> 3, ldb = K + PADK;
  const int total = 16 * nN;
  bool staged = false;
  for (int u = j; u < total; u += nb) {
    int pm, pn; g8_decode(u, x, nN, pm, pn);
    const int brow = pm * 256, bcol = pn * 256;
    const bf16_t* Ab = A + (size_t)brow * lda + (a_grp ? (bcol / a_grp) * K : 0);
    const bf16_t* Bb = Bt + (size_t)bcol * ldb;
    const bool has_next = (u + nb < total);
    const bf16_t* Abn = Ab; const bf16_t* Bbn = Bb;
    if (has_next) {
      int pm2, pn2; g8_decode(u + nb, x, nN, pm2, pn2);
      Abn = A + (size_t)(pm2 * 256) * lda + (a_grp ? ((pn2 * 256) / a_grp) * K : 0);
      Bbn = Bt + (size_t)(pn2 * 256) * ldb;
    }
    gemm8_tile<Epi>(Ab, lda, Bb, ldb, K, brow, bcol, epi, staged, has_next, Abn, Bbn);
    staged = has_next;
  }
}
DI float red16(float v) { v += __shfl_xor(v, 1); v += __shfl_xor(v, 2); v += __shfl_xor(v, 4); v += __shfl_xor(v, 8); return v; }

struct EpiGU8 {
  static constexpr bool LDS_SCRATCH = true;
  bf16_t* act; const float* ssq;
  DI void run8(f32x4 (&acc)[8][4], int rb, int cb, int fr, int fq) const {
    const int lane = fq * 16 + fr, wid = (int)(threadIdx.x >> 6);
    bf16_t* scr = (bf16_t*)(smem + G8_STAGE_B + wid * 1280);
    const int srow = lane >> 2, sch = lane & 3;
    bf16_t* ap = act + (size_t)(rb + srow) * LDA + (cb >> 1) + sch * 8;
    float rsv[8][4];
#pragma unroll
    for (int m = 0; m < 8; ++m)
#pragma unroll
      for (int j = 0; j < 4; ++j) rsv[m][j] = rsqrtf(ssq[rb + m * 16 + fq * 4 + j] * (1.f / D) + EPS);
#pragma unroll
    for (int m = 0; m < 8; ++m) {
#pragma unroll
      for (int j = 0; j < 4; ++j)
#pragma unroll
        for (int pi = 0; pi < 2; ++pi) {
          const float g = acc[m][2 * pi][j] * rsv[m][j], u = acc[m][2 * pi + 1][j] * rsv[m][j];
          const float a = g * __builtin_amdgcn_rcpf(1.f + __expf(-g)) * u;
          scr[(fq * 4 + j) * 40 + pi * 16 + fr] = to_bf16(a);
        }
      __builtin_amdgcn_sched_barrier(0);
      const u32x4 o = *(const u32x4*)(scr + srow * 40 + sch * 8);
      *(u32x4*)(ap + (size_t)(m * 16) * LDA) = o;
      __builtin_amdgcn_sched_barrier(0);
    }
  }
};
struct EpiResid8 {
  static constexpr bool LDS_SCRATCH = true;
  const float* xin; float* xout; float scale; bf16_t* xb; float* ssq;
  DI void run8(f32x4 (&acc)[8][4], int rb, int cb, int fr, int fq) const {
    const int lane = fq * 16 + fr, wid = (int)(threadIdx.x >> 6);
    const float sc = scale; bf16_t* const xbp = xb; float* const ssqp = ssq;
    float* scr = (float*)(smem + G8_STAGE_B + wid * 4352);
    const int prow = lane >> 4, c4 = lane & 15;
    const float* xp = xin + (size_t)(rb + prow) * D + cb + c4 * 4;
    float* op = xout + (size_t)(rb + prow) * D + cb + c4 * 4;
#pragma unroll
    for (int mh = 0; mh < 2; ++mh) {
      f32x4 xv[4][4];
#pragma unroll
      for (int mm = 0; mm < 4; ++mm)
#pragma unroll
        for (int ps = 0; ps < 4; ++ps) xv[mm][ps] = __builtin_nontemporal_load((const f32x4*)(xp + (size_t)((mh * 4 + mm) * 16 + ps * 4) * D));
      __builtin_amdgcn_sched_barrier(0);
#pragma unroll
      for (int mm = 0; mm < 4; ++mm) {
        const int m = mh * 4 + mm;
#pragma unroll
        for (int n = 0; n < 4; ++n)
#pragma unroll
          for (int j = 0; j < 4; ++j) scr[(fq * 4 + j) * 68 + n * 16 + fr] = acc[m][n][j];
        __builtin_amdgcn_sched_barrier(0);
#pragma unroll
        for (int ps = 0; ps < 4; ++ps) {
          const f32x4 a = *(const f32x4*)(scr + (ps * 4 + prow) * 68 + c4 * 4);
          f32x4 v;
          v.x = xv[mm][ps].x + a.x * sc; v.y = xv[mm][ps].y + a.y * sc; v.z = xv[mm][ps].z + a.z * sc; v.w = xv[mm][ps].w + a.w * sc;
          const int grow = rb + m * 16 + ps * 4 + prow;
          __builtin_nontemporal_store(v, (f32x4*)(op + (size_t)(m * 16 + ps * 4) * D));
          if (xbp) {
            u32x2 o; o.x = pack_bf16(v.x, v.y); o.y = pack_bf16(v.z, v.w);
            *(u32x2*)(xbp + (size_t)grow * LDH + cb + c4 * 4) = o;
            const float t = red16(v.x * v.x + v.y * v.y + v.z * v.z + v.w * v.w);
            if (c4 == 0) atomicAdd(ssqp + grow, t);
          }
        }
        __builtin_amdgcn_sched_barrier(0);
      }
    }
  }
};
struct EpiLat8 {
  static constexpr bool LDS_SCRATCH = false;
  bf16_t* lat; float* kpe; float* ssq_q; float* ssq_kv; const float* ssq_x;
  DI void run8(f32x4 (&acc)[8][4], int rb, int cb, int fr, int fq) const {
    if (cb >= 1088) return;
    float* ssq = (cb < QL) ? ssq_q : ssq_kv;
#pragma unroll
    for (int mp = 0; mp < 2; ++mp) {
      float rsv[4][4];
#pragma unroll
      for (int mm = 0; mm < 4; ++mm)
#pragma unroll
        for (int j = 0; j < 4; ++j) rsv[mm][j] = rsqrtf(ssq_x[rb + (4 * mp + mm) * 16 + fq * 4 + j] * (1.f / D) + EPS);
      __builtin_amdgcn_sched_barrier(0);
#pragma unroll
      for (int mm = 0; mm < 4; ++mm) {
        float ssv[4];
#pragma unroll
        for (int j = 0; j < 4; ++j) {
          const int row = rb + (4 * mp + mm) * 16 + fq * 4 + j;
          float ss = 0.f;
#pragma unroll
          for (int n = 0; n < 4; ++n) {
            const float v = acc[4 * mp + mm][n][j] * rsv[mm][j];
            if (cb >= 1024) kpe[(size_t)row * 64 + (cb - 1024) + n * 16 + fr] = v;
            else { lat[(size_t)row * LDH + cb + n * 16 + fr] = to_bf16(v); ss += v * v; }
          }
          ssv[j] = ss;
        }
        if (cb < 1024) {
#pragma unroll
          for (int j = 0; j < 4; ++j) { const float t = red16(ssv[j]); if (fr == 0) atomicAdd(ssq + rb + (4 * mp + mm) * 16 + fq * 4 + j, t); }
        }
      }
    }
  }
};
struct EpiQraw8 {
  static constexpr bool LDS_SCRATCH = false;
  bf16_t* q; const float* ssq_q;
  DI void run8(f32x4 (&acc)[8][4], int rb, int cb, int fr, int fq) const {
#pragma unroll
    for (int m = 0; m < 8; ++m)
#pragma unroll
      for (int j = 0; j < 4; ++j) {
        const int row = rb + m * 16 + fq * 4 + j;
        const float rs = rsqrtf(ssq_q[row] * (1.f / QL) + EPS);
#pragma unroll
        for (int n = 0; n < 4; ++n) q[(size_t)row * 1536 + cb + n * 16 + fr] = to_bf16(acc[m][n][j] * rs);
      }
  }
};

DI void norm0_phase(const float* __restrict__ x, bf16_t* __restrict__ hb, float* __restrict__ ssq) {
  const int tid = opaque_tid512();
  const int lane = tid & 63, gw = blockIdx.x * 8 + (tid >> 6), nw = gridDim.x * 8;
  for (int row = gw; row < T; row += nw) {
    const f32x4* xr = (const f32x4*)(x + (size_t)row * D);
    f32x4 v[4];
    float ss = 0.f;
#pragma unroll
    for (int c = 0; c < 4; ++c) { v[c] = __builtin_nontemporal_load(xr + c * 64 + lane); ss += v[c].x * v[c].x + v[c].y * v[c].y + v[c].z * v[c].z + v[c].w * v[c].w; }
    ss = red64(ss);
    if (lane == 0) ssq[row] = ss;
#pragma unroll
    for (int c = 0; c < 4; ++c) {
      u32x2 o; o.x = pack_bf16(v[c].x, v[c].y); o.y = pack_bf16(v[c].z, v[c].w);
      *(u32x2*)(hb + (size_t)row * LDH + (c * 64 + lane) * 4) = o;
    }
  }
}

template <int W>
DI void pool_rows(const float* __restrict__ x, const float* smr, bf16_t* __restrict__ pb, int t0, int s0, int tid) {
  const int tq0 = t0 - s0;
  const float* xq = x + tid * 4;
  f32x4 Sm = {0.f, 0.f, 0.f, 0.f};
#pragma unroll
  for (int i = 1; i < W; ++i) {
    int t = t0 - i; if (t < tq0) t = tq0;
    Sm += *(const f32x4*)(xq + (size_t)t * D) * smr[15 - i];
  }
#pragma unroll 8
  for (int tl = 0; tl < 64; ++tl) {
    const int t = t0 + tl, s = s0 + tl;
    int to = t - W + 1; if (to < tq0) to = tq0;
    const f32x4 hn = *(const f32x4*)(xq + (size_t)t * D) * smr[15 + tl];
    const f32x4 ho = *(const f32x4*)(xq + (size_t)to * D) * smr[15 + tl - W + 1];
    const int cnt = (s + 1 < W) ? (s + 1) : W;
    const float ic = 1.f / (float)cnt;
    Sm += hn;
    const f32x4 p = Sm * ic - hn;
    Sm -= ho;
    u32x2 o; o.x = pack_bf16(p.x, p.y); o.y = pack_bf16(p.z, p.w);
    *(u32x2*)(pb + (size_t)t * LDH + tid * 4) = o;
  }
}
DI void poolprep_phase(int vb, int nvb, const float* __restrict__ x, const float* __restrict__ ssq, bf16_t* __restrict__ pb, float* smf) {
  const int tid = opaque_tid(), wave = tid >> 6;
  for (int c0 = 0; c0 < T / 64; c0 += nvb) {
    const int ch = c0 + vb;
    const bool on = ch < T / 64;
    const int t0 = ch * 64, s0 = t0 & (S - 1);
    if (on && tid < 79) smf[tid] = (s0 + tid >= 15) ? rsqrtf(ssq[t0 - 15 + tid] * (1.f / D) + EPS) : 0.f;
    __syncthreads();
    if (on) {
      if (wave == 0) pool_rows<2>(x, smf, pb, t0, s0, tid);
      else if (wave == 1) pool_rows<4>(x, smf, pb, t0, s0, tid);
      else if (wave == 2) pool_rows<8>(x, smf, pb, t0, s0, tid);
      else pool_rows<16>(x, smf, pb, t0, s0, tid);
    }
    __syncthreads();
  }
}

constexpr int KLS = QKH + 8;
constexpr int VLS = 64 + 8;
constexpr int K_EL = 64 * KLS;
constexpr int ATT_STG_EL = K_EL + 128 * VLS;

DI void attn_phase(const bf16_t* __restrict__ qraw, const bf16_t* __restrict__ kbuf, const bf16_t* __restrict__ vtb, bf16_t* __restrict__ obuf,
                   const float* __restrict__ gq, const float* __restrict__ cosT, const float* __restrict__ sinT, bf16_t* sm, int x, int j) {
  const int nb = gridDim.x >> 3;
  for (int p = j; p < 64; p += nb) {
    const int bh = 2 * x + (p >> 5);
    const int b = bh >> 3, hd = bh & 7;
    for (int half = 0; half < 2; ++half) {
      const int tid = opaque_tid512(), lane = tid & 63, wave = tid >> 6, r = lane & 31, h = lane >> 5;
      const int qb = half ? (p & 31) : (63 - (p & 31));
      const int q0 = qb * 256 + wave * 32;
      const size_t tok = (size_t)b * S + q0 + r;
      bf16x8 qf[12];
      {
        const bf16_t* qp = qraw + tok * 1536 + hd * QKH + h * 8;
#pragma unroll
        for (int st = 0; st < 12; ++st) qf[st] = *(const bf16x8*)(qp + st * 16);
        float ss = 0.f;
#pragma unroll
        for (int st = 0; st < 12; ++st) {
#pragma unroll
          for (int e = 0; e < 8; ++e) { const float f = bf2f(qf[st][e]); ss += f * f; }
          u32x4 t = __builtin_bit_cast(u32x4, qf[st]);
          asm volatile("" : "+v"(t));
          qf[st] = __builtin_bit_cast(bf16x8, t);
        }
        ss += __shfl_xor(ss, 32);
        const float rq = rsqrtf(ss * (1.f / QKH) + EPS) * (0.07216878364870322f * 1.4426950408889634f);
        __builtin_amdgcn_sched_barrier(0);
#pragma unroll
        for (int st = 0; st < 8; ++st) {
          const f32x4 ga = *(const f32x4*)(gq + st * 16 + h * 8), gb = *(const f32x4*)(gq + st * 16 + h * 8 + 4);
          u32x4 o;
          o.x = pack_bf16(bf2f(qf[st][0]) * rq * ga.x, bf2f(qf[st][1]) * rq * ga.y);
          o.y = pack_bf16(bf2f(qf[st][2]) * rq * ga.z, bf2f(qf[st][3]) * rq * ga.w);
          o.z = pack_bf16(bf2f(qf[st][4]) * rq * gb.x, bf2f(qf[st][5]) * rq * gb.y);
          o.w = pack_bf16(bf2f(qf[st][6]) * rq * gb.z, bf2f(qf[st][7]) * rq * gb.w);
          asm volatile("" : "+v"(o));
          qf[st] = __builtin_bit_cast(bf16x8, o);
          __builtin_amdgcn_sched_barrier(0);
        }
#pragma unroll
        for (int st = 8; st < 10; ++st) {
          const int jb = (st - 8) * 16 + h * 8;
          u32x4 o1, o2;
#pragma unroll
          for (int hf = 0; hf < 2; ++hf) {
            const f32x4 g1 = *(const f32x4*)(gq + 128 + jb + 4 * hf), g2 = *(const f32x4*)(gq + 160 + jb + 4 * hf);
            const f32x4 cc = *(const f32x4*)(cosT + tok * 32 + jb + 4 * hf), sn = *(const f32x4*)(sinT + tok * 32 + jb + 4 * hf);
            float y1[4], y2[4];
#pragma unroll
            for (int e = 0; e < 4; ++e) {
              const float x1 = bf2f(qf[st][4 * hf + e]) * rq * g1[e], x2 = bf2f(qf[st + 2][4 * hf + e]) * rq * g2[e];
              y1[e] = x1 * cc[e] - x2 * sn[e]; y2[e] = x2 * cc[e] + x1 * sn[e];
            }
            if (hf == 0) { o1.x = pack_bf16(y1[0], y1[1]); o1.y = pack_bf16(y1[2], y1[3]); o2.x = pack_bf16(y2[0], y2[1]); o2.y = pack_bf16(y2[2], y2[3]); }
            else { o1.z = pack_bf16(y1[0], y1[1]); o1.w = pack_bf16(y1[2], y1[3]); o2.z = pack_bf16(y2[0], y2[1]); o2.w = pack_bf16(y2[2], y2[3]); }
          }
          asm volatile("" : "+v"(o1), "+v"(o2));
          qf[st] = __builtin_bit_cast(bf16x8, o1); qf[st + 2] = __builtin_bit_cast(bf16x8, o2);
          __builtin_amdgcn_sched_barrier(0);
        }
      }
      f32x16 oacc[4];
#pragma unroll
      for (int mt = 0; mt < 4; ++mt)
#pragma unroll
        for (int i = 0; i < 16; ++i) oacc[mt][i] = 0.f;
      float m_run = -1e30f, l_run = 0.f;
      const int nkt = 4 * qb + 4;
      const bf16_t* kg = kbuf + (size_t)bh * S * QKH;
      const bf16_t* vg = vtb + (size_t)bh * VH * SV;
      u32x4 rk[3], rv[2];
      const unsigned kg_off0 = (unsigned)(tid >> 3) * QKH + (unsigned)(tid & 7) * 8u;
      const unsigned vg_off0 = (unsigned)(tid >> 3) * (unsigned)SV + (unsigned)(tid & 7) * 8u;
      const unsigned kl_off = (unsigned)(tid >> 3) * KLS + (unsigned)(tid & 7) * 8u;
      const unsigned vl_off = (unsigned)(tid >> 3) * VLS + (unsigned)(tid & 7) * 8u;
#define ALOAD(kt_)                                                                                                     \
  {                                                                                                                    \
    const bf16_t* kgt_ = kg + (size_t)(kt_) * 64 * QKH; const bf16_t* vgt_ = vg + (kt_) * 64;                          \
    unsigned kg_off = kg_off0, vg_off = vg_off0; asm volatile("" : "+v"(kg_off), "+v"(vg_off));                        \
    _Pragma("unroll") for (int i = 0; i < 3; ++i) rk[i] = *(const u32x4*)(kgt_ + (kg_off + (unsigned)(i * 64)));       \
    _Pragma("unroll") for (int i = 0; i < 2; ++i) rv[i] = *(const u32x4*)(vgt_ + (vg_off + (unsigned)(i * 64) * (unsigned)SV)); \
  }
      ALOAD(0);
#define ASTORE(stg_)                                                                                                   \
  {                                                                                                                    \
    bf16_t* sk_ = sm + (stg_) * ATT_STG_EL; bf16_t* sv_ = sk_ + K_EL;                                                  \
    _Pragma("unroll") for (int i = 0; i < 3; ++i) *(u32x4*)(sk_ + kl_off + i * 64) = rk[i];                            \
    _Pragma("unroll") for (int i = 0; i < 2; ++i) *(u32x4*)(sv_ + vl_off + i * 64 * VLS) = rv[i];                      \
  }
      ASTORE(0);
      __syncthreads();
      for (int kt = 0; kt < nkt; ++kt) {
        const bf16_t* smk = sm + (kt & 1) * ATT_STG_EL;
        const bf16_t* smv = smk + K_EL;
        if (kt + 1 < nkt) ALOAD(kt + 1);
        __builtin_amdgcn_sched_barrier(0);
        if (kt * 64 <= q0 + 31) {
        f32x16 sacc[2];
#pragma unroll
        for (int mt = 0; mt < 2; ++mt)
#pragma unroll
          for (int i = 0; i < 16; ++i) sacc[mt][i] = 0.f;
        const bf16_t* kp = smk + r * KLS + h * 8;
        {
          bf16x8 ka = *(const bf16x8*)(kp), kb = *(const bf16x8*)(kp + 32 * KLS);
#pragma unroll
          for (int st = 0; st < 12; ++st) {
            bf16x8 na = ka, nbq = kb;
            if (st + 1 < 12) { na = *(const bf16x8*)(kp + (st + 1) * 16); nbq = *(const bf16x8*)(kp + 32 * KLS + (st + 1) * 16); }
            sacc[0] = MFMA(ka, qf[st], sacc[0]);
            sacc[1] = MFMA(kb, qf[st], sacc[1]);
            ka = na; kb = nbq;
            __builtin_amdgcn_sched_barrier(0);
          }
        }
        bf16x8 va[2][4];
        {
          const bf16_t* vp0 = smv + r * VLS + h * 8;
#pragma unroll
          for (int mt = 0; mt < 4; ++mt) va[0][mt] = *(const bf16x8*)(vp0 + mt * 32 * VLS);
        }
        if (kt * 64 + 63 > q0) {
          const int qpos = q0 + r;
#pragma unroll
          for (int mt = 0; mt < 2; ++mt)
#pragma unroll
            for (int i = 0; i < 16; ++i) { const int key = kt * 64 + mt * 32 + crow(i, h); if (key > qpos) sacc[mt][i] = -INFINITY; }
        }
        float mx = sacc[0][0];
#pragma unroll
        for (int mt = 0; mt < 2; ++mt)
#pragma unroll
          for (int i = 0; i < 16; ++i) mx = fmaxf(mx, sacc[mt][i]);
        mx = xmax32(mx);
        const float m_new = fmaxf(m_run, mx);
        const float alpha = __builtin_amdgcn_exp2f(m_run - m_new);
        m_run = m_new;
        float rs = 0.f;
#pragma unroll
        for (int mt = 0; mt < 2; ++mt)
#pragma unroll
          for (int i = 0; i < 16; ++i) { const float pv = __builtin_amdgcn_exp2f(sacc[mt][i] - m_new); sacc[mt][i] = pv; rs += pv; }
        rs = xsum32(rs);
        l_run = l_run * alpha + rs;
        if (__any(alpha != 1.f)) {
#pragma unroll
          for (int mt = 0; mt < 4; ++mt)
#pragma unroll
            for (int i = 0; i < 16; ++i) oacc[mt][i] *= alpha;
        }
        bf16x8 pf[4];
#pragma unroll
        for (int ks = 0; ks < 4; ++ks) {
          u32x4 o;
          o.x = pack_bf16(sacc[ks >> 1][8 * (ks & 1) + 0], sacc[ks >> 1][8 * (ks & 1) + 1]);
          o.y = pack_bf16(sacc[ks >> 1][8 * (ks & 1) + 2], sacc[ks >> 1][8 * (ks & 1) + 3]);
          o.z = pack_bf16(sacc[ks >> 1][8 * (ks & 1) + 4], sacc[ks >> 1][8 * (ks & 1) + 5]);
          o.w = pack_bf16(sacc[ks >> 1][8 * (ks & 1) + 6], sacc[ks >> 1][8 * (ks & 1) + 7]);
          pf[ks] = __builtin_bit_cast(bf16x8, o);
        }
        const bf16_t* vp = smv + r * VLS + h * 8;
        __builtin_amdgcn_sched_barrier(0);
        {
#pragma unroll
          for (int ks = 0; ks < 4; ++ks) {
            if (ks + 1 < 4) {
#pragma unroll
              for (int mt = 0; mt < 4; ++mt) va[(ks + 1) & 1][mt] = *(const bf16x8*)(vp + mt * 32 * VLS + (ks + 1) * 16);
            }
#pragma unroll
            for (int mt = 0; mt < 4; ++mt) oacc[mt] = MFMA(va[ks & 1][mt], pf[ks], oacc[mt]);
            __builtin_amdgcn_sched_barrier(0);
          }
        }
        }
        if (kt + 1 < nkt) ASTORE((kt + 1) & 1);
        __syncthreads();
      }
#undef ALOAD
#undef ASTORE
      const float inv = 1.f / l_run;
      bf16_t* op = obuf + tok * LDH + hd * VH + 4 * h;
#pragma unroll
      for (int mt = 0; mt < 4; ++mt)
#pragma unroll
        for (int a = 0; a < 4; ++a) {
          u32x2 o;
          o.x = pack_bf16(oacc[mt][4 * a] * inv, oacc[mt][4 * a + 1] * inv);
          o.y = pack_bf16(oacc[mt][4 * a + 2] * inv, oacc[mt][4 * a + 3] * inv);
          *(u32x2*)(op + mt * 32 + 8 * a) = o;
        }
      __syncthreads();
    }
  }
}

typedef Cfg<4, 1, 1, 4, 64, 1> CR;

__global__ void __launch_bounds__(512, 2) fwd_megakernel(Params p) {
  cg::grid_group grid = cg::this_grid();
  unsigned char* ws = p.ws;
  const float* x_in = p.in[0];
  const int* positions = (const int*)p.in[1];
  float* out = p.out;
  bf16_t* wgu1 = (bf16_t*)(ws + OFF_WGU1); bf16_t* wdn1 = (bf16_t*)(ws + OFF_WDN1);
  bf16_t* wgu2 = (bf16_t*)(ws + OFF_WGU2); bf16_t* wdn2 = (bf16_t*)(ws + OFF_WDN2);
  bf16_t* wpool = (bf16_t*)(ws + OFF_WPOOL); bf16_t* win = (bf16_t*)(ws + OFF_WIN); bf16_t* wq = (bf16_t*)(ws + OFF_WQ);
  bf16_t* wkv = (bf16_t*)(ws + OFF_WKV); bf16_t* wout = (bf16_t*)(ws + OFF_WOUT);
  float* cosT = (float*)(ws + OFF_COS); float* sinT = (float*)(ws + OFF_SIN);
  float* ssq_all = (float*)(ws + OFF_SSQ);
  float* kpe = (float*)(ws + OFF_KPE);
  bf16_t* hb = (bf16_t*)(ws + OFF_HB);
  bf16_t* act = (bf16_t*)(ws + OFF_ACT); bf16_t* lat = (bf16_t*)(ws + OFF_LAT); bf16_t* qraw = (bf16_t*)(ws + OFF_QRAW);
  bf16_t* kbuf = (bf16_t*)(ws + OFF_K); bf16_t* vtb = (bf16_t*)(ws + OFF_VT);
  bf16_t* obuf = lat; bf16_t* pooled = (bf16_t*)(ws + OFF_POOLED);
  const int gt = blockIdx.x * 512 + threadIdx.x, gs = gridDim.x * 512;
  const int vhalf = __builtin_amdgcn_readfirstlane((int)(threadIdx.x >> 8));
  const int vb = blockIdx.x * 2 + vhalf, nvb = gridDim.x * 2;
  bf16_t* smh = (bf16_t*)(smem + vhalf * VHALF_BYTES);
  float* smf = (float*)(smem + vhalf * VHALF_BYTES);

  unsigned* ctl = (unsigned*)(ws + OFF_CTL);
  if (threadIdx.x == 0) {
    const unsigned xcc = (unsigned)__builtin_amdgcn_s_getreg((3 << 11) | 20) & 0x7u;
    const unsigned rank = atomicAdd(ctl + xcc, 1u);
    ((volatile int*)smem)[0] = (int)xcc; ((volatile int*)smem)[1] = (int)rank;
  }
  __syncthreads();
  int xs = __builtin_amdgcn_readfirstlane(((volatile int*)smem)[0]);
  int js = __builtin_amdgcn_readfirstlane(((volatile int*)smem)[1]);
  __syncthreads();

  for (int idx = gt; idx < T * 32; idx += gs) {
    const int t = idx >> 5, jf = idx & 31;
    const float inv_freq = exp2f(-(float)jf * 0.41524101186092029f);
    const float ang = (float)positions[t] * inv_freq;
    const double rev = (double)ang * 0.15915494309189535;
    const float fr = (float)(rev - rint(rev));
    cosT[idx] = __builtin_amdgcn_cosf(fr);
    sinT[idx] = __builtin_amdgcn_sinf(fr);
  }
  for (int i = gt; i < 15 * T; i += gs) ssq_all[T + i] = 0.f;
  norm0_phase(x_in, hb, ssq_all);
  for (int jl = 0; jl < 2; ++jl) {
    for (int g = 0; g < 4; ++g)
      prep_w(vb, nvb, p.in[7] + ((size_t)jl * 4 + g) * 65536, wpool + ((size_t)jl * 4 + g) * 256 * (256 + PADK), 256, 256, p.in[6] + (size_t)(2 * jl) * D + g * 256, p.in[8] + (size_t)jl * D + g * 256, 0, smf);
    prep_w(vb, nvb, p.in[9] + (size_t)jl * D * 1088, win + (size_t)jl * LATNP * (D + PADK), D, 1088, p.in[6] + (size_t)(2 * jl + 1) * D, nullptr, 0, smf);
    for (int i = gt; i < (LATNP - 1088) * (D + PADK) / 8; i += gs) ((u32x4*)(win + (size_t)jl * LATNP * (D + PADK) + (size_t)1088 * (D + PADK)))[i] = (u32x4){0u, 0u, 0u, 0u};
    prep_w(vb, nvb, p.in[11] + (size_t)jl * QL * 1536, wq + (size_t)jl * 1536 * (QL + PADK), QL, 1536, p.in[10] + (size_t)jl * QL, nullptr, 0, smf);
    prep_w(vb, nvb, p.in[13] + (size_t)jl * KVL * 2048, wkv + (size_t)jl * 2048 * (KVL + PADK), KVL, 2048, p.in[12] + (size_t)jl * KVL, nullptr, 3, smf);
    prep_w(vb, nvb, p.in[16] + (size_t)jl * D * D, wout + (size_t)jl * D * (D + PADK), D, D, nullptr, nullptr, 0, smf);
  }
#define PREP_FFN1(L_) { const size_t wo_ = (size_t)(L_) * D * FF; \
    prep_w(vb, nvb, p.in[3] + wo_, wgu1, D, FF, p.in[2] + (size_t)(L_) * D, nullptr, 1, smf); \
    prep_w(vb, nvb, p.in[4] + wo_, wgu1, D, FF, p.in[2] + (size_t)(L_) * D, nullptr, 2, smf); \
    prep_w(vb, nvb, p.in[5] + wo_, wdn1, FF, D, nullptr, nullptr, 0, smf); }
#define PREP_FFN2(L_) { const size_t wo_ = (size_t)(L_) * D * FF; \
    prep_w(vb, nvb, p.in[18] + wo_, wgu2, D, FF, p.in[17] + (size_t)(L_) * D, nullptr, 1, smf); \
    prep_w(vb, nvb, p.in[19] + wo_, wgu2, D, FF, p.in[17] + (size_t)(L_) * D, nullptr, 2, smf); \
    prep_w(vb, nvb, p.in[20] + wo_, wdn2, FF, D, nullptr, nullptr, 0, smf); }
  PREP_FFN1(0);
  PREP_FFN2(0);
  grid.sync();
  {
    bool even = true;
    for (int i = 0; i < 8; ++i) even = even && (__hip_atomic_load(ctl + i, __ATOMIC_RELAXED, __HIP_MEMORY_SCOPE_AGENT) == (gridDim.x >> 3));
    if (!even || js >= (int)(gridDim.x >> 3)) { xs = blockIdx.x & 7; js = blockIdx.x >> 3; }
  }
  unsigned bar_target = 0;
#define GBAR() { bar_target += gridDim.x; grid_bar(ctl + 32, bar_target); }
  unsigned xbar_target = 0;
#define XBAR() { xbar_target += (gridDim.x >> 3); grid_bar(ctl + 48 + xs, xbar_target); }
  const int jv = js * 2 + vhalf, nbv = (int)(gridDim.x >> 3) * 2;

  for (int layer = 0; layer < DEPTH; ++layer) {
    const float* xcur = (layer == 0) ? x_in : out;
    float* ssq0 = ssq_all + (size_t)(layer * 3 + 0) * T;
    float* ssq1 = ssq_all + (size_t)(layer * 3 + 1) * T;
    float* ssq2 = ssq_all + (size_t)(layer * 3 + 2) * T;
    float* ssq_next = ssq_all + (size_t)((layer + 1) * 3) * T;
    const int jl = layer >> 1;
    float* ssq_q = ssq_all + (size_t)(12 + jl) * T;
    float* ssq_kv = ssq_all + (size_t)(14 + jl) * T;
    if (layer > 0) PREP_FFN2(layer);
    gemm8_phase(xs, js, hb, LDH, wgu1, D, 2 * FF, 0, EpiGU8{act, ssq0});
    XBAR();
    gemm8_phase(xs, js, act, LDA, wdn1, FF, D, 0, EpiResid8{xcur, out, 0.5f, hb, ssq1});
    GBAR();
    if (layer + 1 < DEPTH) PREP_FFN1(layer + 1);
    if ((layer & 1) == 0) {
      poolprep_phase(vb, nvb, out, ssq1, pooled, smf);
      GBAR();
      gemm8_phase(xs, js, pooled, LDH, wpool + (size_t)jl * 1024 * (256 + PADK), 256, D, 256, EpiResid8{out, out, 1.0f, hb, ssq2});
      GBAR();
    } else {
      gemm8_phase(xs, js, hb, LDH, win + (size_t)jl * LATNP * (D + PADK), D, LATNP, 0, EpiLat8{lat, kpe, ssq_q, ssq_kv, ssq1});
      GBAR();
      gemm8_phase(xs, js, lat, LDH, wq + (size_t)jl * 1536 * (QL + PADK), QL, 1536, 0, EpiQraw8{qraw, ssq_q});
      gemm_phase<CR>(xs, jv, nbv, lat + QL, LDH, wkv + (size_t)jl * 2048 * (KVL + PADK), KVL, 2048, 0, EpiKV{ssq_kv, kpe, p.in[15] + (size_t)jl * QKH, cosT, sinT, kbuf, vtb}, smh);
      GBAR();
      attn_phase(qraw, kbuf, vtb, obuf, p.in[14] + (size_t)jl * QKH, cosT, sinT, (bf16_t*)smem, xs, js);
      GBAR();
      gemm8_phase(xs, js, obuf, LDH, wout + (size_t)jl * D * (D + PADK), D, D, 0, EpiResid8{out, out, 1.0f, hb, ssq2});
      GBAR();
    }
    gemm8_phase(xs, js, hb, LDH, wgu2, D, 2 * FF, 0, EpiGU8{act, ssq2});
    XBAR();
    const bool last = (layer + 1 == DEPTH);
    gemm8_phase(xs, js, act, LDA, wdn2, FF, D, 0, EpiResid8{out, out, 0.5f, last ? nullptr : hb, last ? nullptr : ssq_next});
    if (!last) GBAR();
  }
}

extern "C" void kernel_launch(void* const* d_in, const int* in_sizes, int n_in, void* d_out, int out_size, void* d_ws, size_t ws_size, hipStream_t stream) {
  static int grid_blocks = 0;
  if (!grid_blocks) {
    int dev = 0, cus = 0, per_cu = 0;
    (void)hipGetDevice(&dev);
    (void)hipDeviceGetAttribute(&cus, hipDeviceAttributeMultiprocessorCount, dev);
    (void)hipFuncSetAttribute((const void*)fwd_megakernel, hipFuncAttributeMaxDynamicSharedMemorySize, LDS_BYTES);
    (void)hipOccupancyMaxActiveBlocksPerMultiprocessor(&per_cu, fwd_megakernel, 512, LDS_BYTES);
    grid_blocks = cus;
    if (n_in != 21 || out_size != T * D || ws_size < WS_TOTAL || per_cu < 1) fprintf(stderr, "kernel_launch: unexpected n_in=%d out=%d ws=%zu (need %zu) per_cu=%d\n", n_in, out_size, ws_size, (size_t)WS_TOTAL, per_cu);
  }
  Params p{};
  for (int i = 0; i < 21; ++i) p.in[i] = (const float*)d_in[i];
  p.out = (float*)d_out; p.ws = (unsigned char*)d_ws;
  (void)hipMemsetAsync((unsigned char*)d_ws + OFF_CTL, 0, 256, stream);
  void* args[] = {&p};
  hipError_t e = hipLaunchCooperativeKernel((void*)fwd_megakernel, dim3(grid_blocks), dim3(512), args, LDS_BYTES, stream);
  if (e != hipSuccess) fprintf(stderr, "cooperative launch failed: %s (grid %d)\n", hipGetErrorString(e), grid_blocks);
}
```

```cpp
#include <hip/hip_runtime.h>
#include <hip/hip_cooperative_groups.h>
#include <cstdio>
#include <cstdint>
namespace cg = cooperative_groups;

#define DI __device__ __forceinline__
typedef unsigned short bf16_t;
typedef short bf16x8 __attribute__((ext_vector_type(8)));
typedef float f32x16 __attribute__((ext_vector_type(16)));
typedef float f32x4 __attribute__((ext_vector_type(4)));
typedef float f32x2 __attribute__((ext_vector_type(2)));
typedef unsigned u32x4 __attribute__((ext_vector_type(4)));
typedef unsigned u32x2 __attribute__((ext_vector_type(2)));
typedef __bf16 bf16v2 __attribute__((ext_vector_type(2)));

constexpr int NB = 2, S = 16384, T = NB * S, D = 1024, FF = 2816, NH = 8, DEPTH = 4;
constexpr int QL = 768, KVL = 256, QKH = 192, VH = 128;
constexpr int LATNP = 1280;
constexpr int LDH = D + 64;
constexpr int LDA = FF + 64;
constexpr int SV = S + 64;
constexpr int PADK = 64;
constexpr float EPS = 1e-6f;

constexpr size_t SZ_WGU = (size_t)2 * FF * (D + PADK) * 2, SZ_WDN = (size_t)D * (FF + PADK) * 2;
constexpr size_t OFF_WGU1 = 0, OFF_WDN1 = OFF_WGU1 + SZ_WGU, OFF_WGU2 = OFF_WDN1 + SZ_WDN, OFF_WDN2 = OFF_WGU2 + SZ_WGU;
constexpr size_t SZ_WPOOL = (size_t)1024 * (256 + PADK) * 2, SZ_WIN = (size_t)LATNP * (D + PADK) * 2, SZ_WQ = (size_t)1536 * (QL + PADK) * 2;
constexpr size_t SZ_WKV = (size_t)2048 * (KVL + PADK) * 2, SZ_WOUT = (size_t)D * (D + PADK) * 2;
constexpr size_t OFF_WPOOL = OFF_WDN2 + SZ_WDN;
constexpr size_t OFF_WIN = OFF_WPOOL + 2 * SZ_WPOOL;
constexpr size_t OFF_WQ = OFF_WIN + 2 * SZ_WIN;
constexpr size_t OFF_WKV = OFF_WQ + 2 * SZ_WQ;
constexpr size_t OFF_WOUT = OFF_WKV + 2 * SZ_WKV;
constexpr size_t OFF_COS = OFF_WOUT + 2 * SZ_WOUT;
constexpr size_t OFF_SIN = OFF_COS + (size_t)T * 32 * 4;
constexpr size_t OFF_SSQ = OFF_SIN + (size_t)T * 32 * 4;
constexpr size_t OFF_KPE = OFF_SSQ + (size_t)16 * T * 4;
constexpr size_t OFF_HB = OFF_KPE + (size_t)T * 64 * 4;
constexpr size_t OFF_BIG = OFF_HB + (size_t)T * LDH * 2;
constexpr size_t OFF_ACT = OFF_BIG;
constexpr size_t OFF_LAT = OFF_BIG;
constexpr size_t OFF_POOLED = OFF_BIG;
constexpr size_t OFF_QRAW = OFF_LAT + (size_t)T * LDH * 2;
constexpr size_t OFF_K = OFF_QRAW + (size_t)T * 1536 * 2;
constexpr size_t OFF_VT = OFF_K + (size_t)T * NH * QKH * 2;
constexpr size_t WS_END = OFF_VT + (size_t)NB * NH * VH * SV * 2;
static_assert(OFF_ACT + (size_t)T * LDA * 2 <= WS_END, "act must fit in the big region");
constexpr size_t OFF_CTL = WS_END;
constexpr size_t WS_TOTAL = OFF_CTL + 256;
static_assert(WS_TOTAL <= (size_t)536870912, "workspace budget (4 x largest tensor)");
constexpr int LDS_BYTES = 131072;
constexpr int VHALF_BYTES = 36864;

struct Params { const float* in[21]; float* out; unsigned char* ws; };
extern __shared__ __attribute__((aligned(1024))) unsigned char smem[];

DI unsigned pack_bf16(float lo, float hi) { f32x2 v = {lo, hi}; bf16v2 b = __builtin_convertvector(v, bf16v2); return __builtin_bit_cast(unsigned, b); }
DI bf16_t to_bf16(float x) { return (bf16_t)(pack_bf16(x, 0.f) & 0xffffu); }
DI float bf2f(short v) { return __uint_as_float(((unsigned)(unsigned short)v) << 16); }
DI int crow(int i, int h) { return (i & 3) + 8 * (i >> 2) + 4 * h; }
DI float red32(float v) { v += __shfl_xor(v, 1); v += __shfl_xor(v, 2); v += __shfl_xor(v, 4); v += __shfl_xor(v, 8); v += __shfl_xor(v, 16); return v; }
DI float red64(float v) { v = red32(v); v += __shfl_xor(v, 32); return v; }
DI float xmax32(float v) { const u32x2 r = __builtin_amdgcn_permlane32_swap(__float_as_uint(v), __float_as_uint(v), false, false); return fmaxf(__uint_as_float(r.x), __uint_as_float(r.y)); }
DI float xsum32(float v) { const u32x2 r = __builtin_amdgcn_permlane32_swap(__float_as_uint(v), __float_as_uint(v), false, false); return __uint_as_float(r.x) + __uint_as_float(r.y); }
DI int opaque_tid() { int t = threadIdx.x & 255; asm volatile("" : "+v"(t)); return t; }
DI int opaque_tid512() { int t = threadIdx.x; asm volatile("" : "+v"(t)); return t; }
#define MFMA(a, b, c) __builtin_amdgcn_mfma_f32_32x32x16_bf16((a), (b), (c), 0, 0, 0)
DI void grid_bar(unsigned* ctr, unsigned target) {
  asm volatile("s_waitcnt vmcnt(0)" ::: "memory");
  __syncthreads();
  if (threadIdx.x == 0) {
    __builtin_amdgcn_fence(__ATOMIC_RELEASE, "agent");
    asm volatile("s_waitcnt vmcnt(0)" ::: "memory");
    (void)__hip_atomic_fetch_add(ctr, 1u, __ATOMIC_RELAXED, __HIP_MEMORY_SCOPE_AGENT);
    while (__hip_atomic_load(ctr, __ATOMIC_RELAXED, __HIP_MEMORY_SCOPE_AGENT) < target) __builtin_amdgcn_s_sleep(1);
    __builtin_amdgcn_fence(__ATOMIC_ACQUIRE, "agent");
    asm volatile("s_waitcnt vmcnt(0)" ::: "memory");
  }
  __syncthreads();
}

DI void prep_w(int vb, int nvb, const float* __restrict__ W, bf16_t* __restrict__ Wt, int K, int N, const float* __restrict__ gk, const float* __restrict__ sn, int mode, float* smf) {
  const int ldt = K + PADK;
  const int tid = opaque_tid();
  const int ntn = N / 64, nt = (K / 64) * ntn;
  for (int t0 = 0; t0 < nt; t0 += nvb) {
    const int t = t0 + vb;
    const bool on = t < nt;
    const int k0 = (t / ntn) * 64, n0 = (t % ntn) * 64;
    if (on) {
#pragma unroll
      for (int i = 0; i < 16; ++i) {
        const int kk = i * 4 + (tid >> 6), nn = tid & 63;
        float v = __builtin_nontemporal_load(W + (size_t)(k0 + kk) * N + n0 + nn);
        if (gk) v *= gk[k0 + kk];
        if (sn) v *= sn[n0 + nn];
        smf[kk * 65 + nn] = v;
      }
    }
    __syncthreads();
    if (on) {
      const int nl = tid >> 2, kq = (tid & 3) * 16;
      u32x4 p0, p1;
      p0.x = pack_bf16(smf[(kq + 0) * 65 + nl], smf[(kq + 1) * 65 + nl]);
      p0.y = pack_bf16(smf[(kq + 2) * 65 + nl], smf[(kq + 3) * 65 + nl]);
      p0.z = pack_bf16(smf[(kq + 4) * 65 + nl], smf[(kq + 5) * 65 + nl]);
      p0.w = pack_bf16(smf[(kq + 6) * 65 + nl], smf[(kq + 7) * 65 + nl]);
      p1.x = pack_bf16(smf[(kq + 8) * 65 + nl], smf[(kq + 9) * 65 + nl]);
      p1.y = pack_bf16(smf[(kq + 10) * 65 + nl], smf[(kq + 11) * 65 + nl]);
      p1.z = pack_bf16(smf[(kq + 12) * 65 + nl], smf[(kq + 13) * 65 + nl]);
      p1.w = pack_bf16(smf[(kq + 14) * 65 + nl], smf[(kq + 15) * 65 + nl]);
      const int n = n0 + nl;
      int row = n;
      if (mode == 1) row = (n >> 4) * 32 + (n & 15);
      else if (mode == 2) row = (n >> 4) * 32 + 16 + (n & 15);
      else if (mode == 3) { const int hd = n >> 8, j = n & 255; row = (j < 128) ? (hd * 128 + j) : (1024 + hd * 128 + (j - 128)); }
      u32x4* dst = (u32x4*)(Wt + (size_t)row * ldt + k0 + kq);
      dst[0] = p0; dst[1] = p1;
    }
    __syncthreads();
  }
}

template <int WM_, int WN_, int MI_, int NI_, int BK_, int ST_>
struct Cfg {
  static constexpr int WM = WM_, WN = WN_, MI = MI_, NI = NI_, BK = BK_, ST = ST_;
  static constexpr int BM = WM * MI * 32, BN = WN * NI * 32;
  static constexpr int LS = BK + 8;
  static constexpr int A_EL = BM * LS, B_EL = BN * LS, STAGE_EL = A_EL + B_EL;
  static constexpr int CPR = BK / 8;
  static constexpr int A_CH = BM * CPR / 256, B_CH = BN * CPR / 256;
  static_assert(WM * WN == 4, "4 waves");
  static_assert(ST * STAGE_EL * 2 <= VHALF_BYTES, "LDS of a virtual half-block");
};

template <class C, class Epi>
DI void gemm_tile(const bf16_t* __restrict__ A, int lda, const bf16_t* __restrict__ Bt, int K, int m0, int n0, const Epi& epi, bf16_t* sm) {
  const int tid = opaque_tid(), lane = tid & 63, wave = tid >> 6, r = lane & 31, h = lane >> 5;
  const int wm = wave / C::WN, wn = wave % C::WN;
  f32x16 acc[C::MI][C::NI];
#pragma unroll
  for (int mi = 0; mi < C::MI; ++mi)
#pragma unroll
    for (int ni = 0; ni < C::NI; ++ni)
#pragma unroll
      for (int i = 0; i < 16; ++i) acc[mi][ni][i] = 0.f;
  const bf16_t* Ag = A + (size_t)m0 * lda;
  const int ldb = K + PADK;
  const bf16_t* Bg = Bt + (size_t)n0 * ldb;
  u32x4 ra[C::A_CH], rb[C::B_CH];
  const int nk = K / C::BK;
  constexpr int RPP = 256 / C::CPR;
  const unsigned a_off = (unsigned)(tid / C::CPR) * (unsigned)lda + (unsigned)(tid % C::CPR) * 8u;
  const unsigned b_off = (unsigned)(tid / C::CPR) * (unsigned)ldb + (unsigned)(tid % C::CPR) * 8u;
  const unsigned l_off = (unsigned)(tid / C::CPR) * C::LS + (unsigned)(tid % C::CPR) * 8u;
#define GLOAD(k0_)                                                                                   \
  {                                                                                                  \
    const bf16_t* ag_ = Ag + (k0_); const bf16_t* bg_ = Bg + (k0_);                                  \
    _Pragma("unroll") for (int i = 0; i < C::A_CH; ++i) ra[i] = *(const u32x4*)(ag_ + (a_off + (unsigned)(i * RPP) * (unsigned)lda)); \
    _Pragma("unroll") for (int i = 0; i < C::B_CH; ++i) rb[i] = *(const u32x4*)(bg_ + (b_off + (unsigned)(i * RPP) * (unsigned)ldb));   \
  }
#define LSTORE(buf_)                                                                                 \
  {                                                                                                  \
    bf16_t* sa_ = sm + (buf_) * C::STAGE_EL + l_off; bf16_t* sb_ = sa_ + C::A_EL;                    \
    _Pragma("unroll") for (int i = 0; i < C::A_CH; ++i) *(u32x4*)(sa_ + i * RPP * C::LS) = ra[i];   \
    _Pragma("unroll") for (int i = 0; i < C::B_CH; ++i) *(u32x4*)(sb_ + i * RPP * C::LS) = rb[i];   \
  }
  GLOAD(0);
  if (C::ST == 2) {
    LSTORE(0);
    __syncthreads();
  }
  for (int kt = 0; kt < nk; ++kt) {
    const int buf = (C::ST == 2) ? (kt & 1) : 0;
    if (C::ST == 1) {
      __syncthreads();
      LSTORE(0);
      __syncthreads();
    }
    if (kt + 1 < nk) GLOAD((kt + 1) * C::BK);
    __builtin_amdgcn_sched_barrier(0);
    const bf16_t* sa = sm + buf * C::STAGE_EL + (wm * C::MI * 32 + r) * C::LS + h * 8;
    const bf16_t* sb = sm + buf * C::STAGE_EL + C::A_EL + (wn * C::NI * 32 + r) * C::LS + h * 8;
#pragma unroll
    for (int ks = 0; ks < C::BK / 16; ++ks) {
      bf16x8 af[C::MI], bfr[C::NI];
#pragma unroll
      for (int mi = 0; mi < C::MI; ++mi) af[mi] = *(const bf16x8*)(sa + mi * 32 * C::LS + ks * 16);
#pragma unroll
      for (int ni = 0; ni < C::NI; ++ni) bfr[ni] = *(const bf16x8*)(sb + ni * 32 * C::LS + ks * 16);
#pragma unroll
      for (int mi = 0; mi < C::MI; ++mi)
#pragma unroll
        for (int ni = 0; ni < C::NI; ++ni) acc[mi][ni] = MFMA(af[mi], bfr[ni], acc[mi][ni]);
    }
    if (C::ST == 2) {
      if (kt + 1 < nk) LSTORE((kt + 1) & 1);
      __syncthreads();
    }
  }
  if (C::ST == 1) __syncthreads();
#undef GLOAD
#undef LSTORE
  epi.template run<C::MI, C::NI>(acc, m0 + wm * C::MI * 32, n0 + wn * C::NI * 32, r, h);
}

template <class C, class Epi>
DI void gemm_phase(int x, int j, int nb, const bf16_t* __restrict__ A, int lda, const bf16_t* __restrict__ Bt, int K, int N, int a_grp, const Epi& epi, bf16_t* sm) {
  static_assert(C::BM == 128 && (C::BN == 128 || C::BN == 256), "tile");
  constexpr int GN = (C::BN == 256) ? 4 : 8;
  const int nN = N / C::BN;
  const int total = 32 * nN;
  for (int u = j; u < total; u += nb) {
    const int ng = u / (32 * GN), rem = u % (32 * GN);
    int gn = nN - GN * ng; if (gn > GN) gn = GN;
    const int mg = rem / (8 * gn), jj = rem % (8 * gn);
    const int mt = 32 * x + 8 * mg + (jj & 7), nt = GN * ng + (jj >> 3);
    const int n0 = nt * C::BN;
    const bf16_t* Ap = a_grp ? (A + (n0 / a_grp) * K) : A;
    gemm_tile<C, Epi>(Ap, lda, Bt, K, mt * 128, n0, epi, sm);
  }
}

struct EpiGU {
  bf16_t* act; const float* ssq;
  template <int MI, int NI> DI void run(f32x16 (&acc)[MI][NI], int mb, int nb, int r, int h) const {
    static_assert((NI & 1) == 0, "gate/up pairs");
#pragma unroll
    for (int mi = 0; mi < MI; ++mi)
#pragma unroll
      for (int i = 0; i < 16; ++i) {
        const int row = mb + mi * 32 + crow(i, h);
        const float rs = rsqrtf(ssq[row] * (1.f / D) + EPS);
#pragma unroll
        for (int pi = 0; pi < NI / 2; ++pi) {
          const float g = acc[mi][2 * pi][i] * rs, u = acc[mi][2 * pi + 1][i] * rs;
          const float a = g / (1.f + __expf(-g)) * u;
          act[(size_t)row * LDA + (nb >> 1) + pi * 32 + r] = to_bf16(a);
        }
      }
  }
};
struct EpiResid {
  const float* xin; float* xout; float scale; bf16_t* xb; float* ssq;
  template <int MI, int NI> DI void run(f32x16 (&acc)[MI][NI], int mb, int nb, int r, int h) const {
#pragma unroll
    for (int mi = 0; mi < MI; ++mi)
#pragma unroll
      for (int hf = 0; hf < 2; ++hf) {
        float xv[8][NI];
#pragma unroll
        for (int i = 0; i < 8; ++i)
#pragma unroll
          for (int ni = 0; ni < NI; ++ni) xv[i][ni] = xin[(size_t)(mb + mi * 32 + crow(hf * 8 + i, h)) * D + nb + ni * 32 + r];
        __builtin_amdgcn_sched_barrier(0);
        float ssv[8];
#pragma unroll
        for (int i = 0; i < 8; ++i) {
          const int row = mb + mi * 32 + crow(hf * 8 + i, h);
          float ss = 0.f;
#pragma unroll
          for (int ni = 0; ni < NI; ++ni) {
            const float v = xv[i][ni] + scale * acc[mi][ni][hf * 8 + i];
            xout[(size_t)row * D + nb + ni * 32 + r] = v;
            if (xb) { xb[(size_t)row * LDH + nb + ni * 32 + r] = to_bf16(v); ss += v * v; }
          }
          ssv[i] = ss;
        }
        if (xb) {
#pragma unroll
          for (int i = 0; i < 8; ++i) { const float t = red32(ssv[i]); if (r == 0) atomicAdd(ssq + mb + mi * 32 + crow(hf * 8 + i, h), t); }
        }
        __builtin_amdgcn_sched_barrier(0);
      }
  }
};
struct EpiLat {
  bf16_t* lat; float* kpe; float* ssq_q; float* ssq_kv; const float* ssq_x;
  template <int MI, int NI> DI void run(f32x16 (&acc)[MI][NI], int mb, int nb, int r, int h) const {
    if (nb >= 1088) return;
    float* ssq = (nb < QL) ? ssq_q : ssq_kv;
#pragma unroll
    for (int mi = 0; mi < MI; ++mi) {
      float rsv[16];
#pragma unroll
      for (int i = 0; i < 16; ++i) rsv[i] = rsqrtf(ssq_x[mb + mi * 32 + crow(i, h)] * (1.f / D) + EPS);
      __builtin_amdgcn_sched_barrier(0);
      if (nb >= 1024) {
#pragma unroll
        for (int i = 0; i < 16; ++i)
#pragma unroll
          for (int ni = 0; ni < NI; ++ni) kpe[(size_t)(mb + mi * 32 + crow(i, h)) * 64 + (nb - 1024) + ni * 32 + r] = acc[mi][ni][i] * rsv[i];
      } else {
        float ssv[16];
#pragma unroll
        for (int i = 0; i < 16; ++i) {
          const int row = mb + mi * 32 + crow(i, h);
          float ss = 0.f;
#pragma unroll
          for (int ni = 0; ni < NI; ++ni) { const float v = acc[mi][ni][i] * rsv[i]; ss += v * v; lat[(size_t)row * LDH + nb + ni * 32 + r] = to_bf16(v); }
          ssv[i] = ss;
        }
#pragma unroll
        for (int i = 0; i < 16; ++i) { const float t = red32(ssv[i]); if (r == 0) atomicAdd(ssq + mb + mi * 32 + crow(i, h), t); }
      }
    }
  }
};
struct EpiQraw {
  bf16_t* q; const float* ssq_q;
  template <int MI, int NI> DI void run(f32x16 (&acc)[MI][NI], int mb, int nb, int r, int h) const {
#pragma unroll
    for (int mi = 0; mi < MI; ++mi)
#pragma unroll
      for (int i = 0; i < 16; ++i) {
        const int row = mb + mi * 32 + crow(i, h);
        const float rs = rsqrtf(ssq_q[row] * (1.f / QL) + EPS);
#pragma unroll
        for (int ni = 0; ni < NI; ++ni) q[(size_t)row * 1536 + nb + ni * 32 + r] = to_bf16(acc[mi][ni][i] * rs);
      }
  }
};
struct EpiKV {
  const float* ssq_kv; const float* kpe; const float* gk; const float* cosT; const float* sinT; bf16_t* kout; bf16_t* vt;
  template <int MI, int NI> DI void run(f32x16 (&acc)[MI][NI], int mb, int nb, int r, int h) const {
    static_assert(MI == 1 && NI == 4, "kv epilogue layout");
    const int b = mb / S, sb = mb % S;
    if (nb < 1024) {
      const int head = nb >> 7;
      const float g0 = gk[r], g1 = gk[32 + r], g2 = gk[64 + r], g3 = gk[96 + r], g4 = gk[128 + r], g5 = gk[160 + r];
#pragma unroll
      for (int i = 0; i < 16; ++i) {
        const int rw = crow(i, h), tok = mb + rw;
        const float rkv = rsqrtf(ssq_kv[tok] * (1.f / KVL) + EPS);
        const float v0 = acc[0][0][i] * rkv, v1 = acc[0][1][i] * rkv, v2 = acc[0][2][i] * rkv, v3 = acc[0][3][i] * rkv;
        const float p1 = kpe[(size_t)tok * 64 + r], p2 = kpe[(size_t)tok * 64 + 32 + r];
        float ss = v0 * v0 + v1 * v1 + v2 * v2 + v3 * v3 + p1 * p1 + p2 * p2;
        ss = red32(ss);
        const float rk = rsqrtf(ss * (1.f / QKH) + EPS);
        bf16_t* kr = kout + ((size_t)(b * NH + head) * S + sb + rw) * QKH;
        kr[r] = to_bf16(v0 * rk * g0); kr[32 + r] = to_bf16(v1 * rk * g1); kr[64 + r] = to_bf16(v2 * rk * g2); kr[96 + r] = to_bf16(v3 * rk * g3);
        const float c = cosT[(size_t)tok * 32 + r], sn = sinT[(size_t)tok * 32 + r];
        const float x1 = p1 * rk * g4, x2 = p2 * rk * g5;
        kr[128 + r] = to_bf16(x1 * c - x2 * sn); kr[160 + r] = to_bf16(x2 * c + x1 * sn);
      }
    } else {
      const int head = (nb - 1024) >> 7;
      float rkv[16];
#pragma unroll
      for (int i = 0; i < 16; ++i) rkv[i] = rsqrtf(ssq_kv[mb + crow(i, h)] * (1.f / KVL) + EPS);
#pragma unroll
      for (int ni = 0; ni < 4; ++ni) {
        bf16_t* vr = vt + ((size_t)(b * NH + head) * VH + ni * 32 + r) * SV + sb;
#pragma unroll
        for (int a = 0; a < 4; ++a) {
          u32x2 o;
          o.x = pack_bf16(acc[0][ni][4 * a] * rkv[4 * a], acc[0][ni][4 * a + 1] * rkv[4 * a + 1]);
          o.y = pack_bf16(acc[0][ni][4 * a + 2] * rkv[4 * a + 2], acc[0][ni][4 * a + 3] * rkv[4 * a + 3]);
          *(u32x2*)(vr + 16 * (a >> 1) + 8 * h + 4 * (a & 1)) = o;
        }
      }
    }
  }
};


DI int lds_byte2(int r, int c) { const int st = (r >> 4) * 2 + (c >> 5), ob = (r & 15) * 64 + (c & 31) * 2; return st * 1024 + (ob ^ (((ob >> 9) & 1) << 5)); }
DI void stage_rc2(int b, int& R, int& C) { const int st = b >> 10, sb = b & 1023, swz = sb ^ (((sb >> 9) & 1) << 5); R = (st >> 1) * 16 + swz / 64; C = (st & 1) * 32 + (swz % 64) / 2; }
#define MFMA16(a, b, c) __builtin_amdgcn_mfma_f32_16x16x32_bf16((a), (b), (c), 0, 0, 0)
constexpr int G8_TILE_B = 256 * 64 * 2, G8_STAGE_B = 2 * G8_TILE_B;

template <class Epi>
DI void gemm8_tile(const bf16_t* __restrict__ Ab, int lda, const bf16_t* __restrict__ Bb, int ldb, int K, int brow, int bcol, const Epi epi,
                   bool staged, bool has_next, const bf16_t* __restrict__ Abn, const bf16_t* __restrict__ Bbn) {
  const int tid = opaque_tid512(), wid = tid >> 6, lane = tid & 63, wr = wid >> 2, wc = wid & 3, fr = lane & 15, fq = lane >> 4;
  unsigned aoff[4], boff[4];
#pragma unroll
  for (int i = 0; i < 4; ++i) { int R, C; stage_rc2(wid * 1024 + i * 8192 + lane * 16, R, C); aoff[i] = (unsigned)R * (unsigned)lda + (unsigned)C; boff[i] = (unsigned)R * (unsigned)ldb + (unsigned)C; }
#define G8_STAGE_R(buf_, ap_, bp_, i0_, i1_)                                                                         \
  {                                                                                                                  \
    const bf16_t* ag_ = (ap_); const bf16_t* bg_ = (bp_);                                                            \
    _Pragma("unroll") for (int i = (i0_); i < (i1_); ++i) {                                                          \
      __builtin_amdgcn_global_load_lds((const unsigned*)(ag_ + aoff[i]), (unsigned*)(smem + (buf_) * G8_STAGE_B + wid * 1024 + i * 8192), 16, 0, 0);              \
      __builtin_amdgcn_global_load_lds((const unsigned*)(bg_ + boff[i]), (unsigned*)(smem + (buf_) * G8_STAGE_B + G8_TILE_B + wid * 1024 + i * 8192), 16, 0, 0);  \
    }                                                                                                                \
  }
#define G8_STAGE(buf_, ap_, bp_) G8_STAGE_R(buf_, ap_, bp_, 0, 4)
  f32x4 acc[8][4];
#pragma unroll
  for (int m = 0; m < 8; ++m)
#pragma unroll
    for (int n = 0; n < 4; ++n) acc[m][n] = (f32x4){0.f, 0.f, 0.f, 0.f};
  const int nt = K / 64;
  if (!staged) {
    G8_STAGE(0, Ab, Bb);
    asm volatile("s_waitcnt vmcnt(0)" ::: "memory");
    __syncthreads();
  }
  for (int t = 0; t < nt; ++t) {
    const int cur = t & 1;
    const unsigned char* sa = smem + cur * G8_STAGE_B;
    const unsigned char* sb = sa + G8_TILE_B;
#pragma unroll
    for (int ks = 0; ks < 2; ++ks) {
      bf16x8 At[8], Bf[4];
#pragma unroll
      for (int m = 0; m < 8; ++m) At[m] = *(const bf16x8*)(sa + lds_byte2(wr * 128 + m * 16 + fr, ks * 32 + fq * 8));
#pragma unroll
      for (int n = 0; n < 4; ++n) Bf[n] = *(const bf16x8*)(sb + lds_byte2(wc * 64 + n * 16 + fr, ks * 32 + fq * 8));
      {
        __builtin_amdgcn_sched_barrier(0);
        if (t + 1 < nt) { G8_STAGE_R(cur ^ 1, Ab + (t + 1) * 64, Bb + (t + 1) * 64, 2 * ks, 2 * ks + 2); }
        else if (has_next) { G8_STAGE_R(0, Abn, Bbn, 2 * ks, 2 * ks + 2); }
        __builtin_amdgcn_sched_barrier(0);
      }
#pragma unroll
      for (int m = 0; m < 8; ++m)
#pragma unroll
        for (int n = 0; n < 4; ++n) acc[m][n] = MFMA16(At[m], Bf[n], acc[m][n]);
      __builtin_amdgcn_sched_barrier(0);
    }
    asm volatile("s_waitcnt vmcnt(0)" ::: "memory");
    __syncthreads();
  }
#undef G8_STAGE
#undef G8_STAGE_R
  epi.run8(acc, brow + wr * 128, bcol + wc * 64, fr, fq);
  if (Epi::LDS_SCRATCH) __syncthreads();
}

DI void g8_decode(int u, int x, int nN, int& pm, int& pn) {
  const int ng = u >> 6, rem = u & 63;
  int gn = nN - 4 * ng; if (gn > 4) gn = 4;
  const int mg = rem / (8 * gn), jj = rem % (8 * gn);
  pm = 16 * x + 8 * mg + (jj & 7); pn = 4 * ng + (jj >> 3);
}
template <class Epi>
DI void gemm8_phase(int x, int j, const bf16_t* __restrict__ A, int lda, const bf16_t* __restrict__ Bt, int K, int N, int a_grp, const Epi epi) {
  const int nN = N / 256, nb = gridDim.x >> 3, ldb = K + PADK;
  const int total = 16 * nN;
  bool staged = false;
  for (int u = j; u < total; u += nb) {
    int pm, pn; g8_decode(u, x, nN, pm, pn);
    const int brow = pm * 256, bcol = pn * 256;
    const bf16_t* Ab = A + (size_t)brow * lda + (a_grp ? (bcol / a_grp) * K : 0);
    const bf16_t* Bb = Bt + (size_t)bcol * ldb;
    const bool has_next = (u + nb < total);
    const bf16_t* Abn = Ab; const bf16_t* Bbn = Bb;
    if (has_next) {
      int pm2, pn2; g8_decode(u + nb, x, nN, pm2, pn2);
      Abn = A + (size_t)(pm2 * 256) * lda + (a_grp ? ((pn2 * 256) / a_grp) * K : 0);
      Bbn = Bt + (size_t)(pn2 * 256) * ldb;
    }
    gemm8_tile<Epi>(Ab, lda, Bb, ldb, K, brow, bcol, epi, staged, has_next, Abn, Bbn);
    staged = has_next;
  }
}
DI float red16(float v) { v += __shfl_xor(v, 1); v += __shfl_xor(v, 2); v += __shfl_xor(v, 4); v += __shfl_xor(v, 8); return v; }

struct EpiGU8 {
  static constexpr bool LDS_SCRATCH = true;
  bf16_t* act; const float* ssq;
  DI void run8(f32x4 (&acc)[8][4], int rb, int cb, int fr, int fq) const {
    const int lane = fq * 16 + fr, wid = (int)(threadIdx.x >> 6);
    bf16_t* scr = (bf16_t*)(smem + G8_STAGE_B + wid * 1280);
    const int srow = lane >> 2, sch = lane & 3;
    bf16_t* ap = act + (size_t)(rb + srow) * LDA + (cb >> 1) + sch * 8;
    float rsv[8][4];
#pragma unroll
    for (int m = 0; m < 8; ++m)
#pragma unroll
      for (int j = 0; j < 4; ++j) rsv[m][j] = rsqrtf(ssq[rb + m * 16 + fq * 4 + j] * (1.f / D) + EPS);
#pragma unroll
    for (int m = 0; m < 8; ++m) {
#pragma unroll
      for (int j = 0; j < 4; ++j)
#pragma unroll
        for (int pi = 0; pi < 2; ++pi) {
          const float g = acc[m][2 * pi][j] * rsv[m][j], u = acc[m][2 * pi + 1][j] * rsv[m][j];
          const float a = g * __builtin_amdgcn_rcpf(1.f + __expf(-g)) * u;
          scr[(fq * 4 + j) * 40 + pi * 16 + fr] = to_bf16(a);
        }
      __builtin_amdgcn_sched_barrier(0);
      const u32x4 o = *(const u32x4*)(scr + srow * 40 + sch * 8);
      *(u32x4*)(ap + (size_t)(m * 16) * LDA) = o;
      __builtin_amdgcn_sched_barrier(0);
    }
  }
};
struct EpiResid8 {
  static constexpr bool LDS_SCRATCH = true;
  const float* xin; float* xout; float scale; bf16_t* xb; float* ssq;
  DI void run8(f32x4 (&acc)[8][4], int rb, int cb, int fr, int fq) const {
    const int lane = fq * 16 + fr, wid = (int)(threadIdx.x >> 6);
    const float sc = scale; bf16_t* const xbp = xb; float* const ssqp = ssq;
    float* scr = (float*)(smem + G8_STAGE_B + wid * 4352);
    const int prow = lane >> 4, c4 = lane & 15;
    const float* xp = xin + (size_t)(rb + prow) * D + cb + c4 * 4;
    float* op = xout + (size_t)(rb + prow) * D + cb + c4 * 4;
#pragma unroll
    for (int mh = 0; mh < 2; ++mh) {
      f32x4 xv[4][4];
#pragma unroll
      for (int mm = 0; mm < 4; ++mm)
#pragma unroll
        for (int ps = 0; ps < 4; ++ps) xv[mm][ps] = __builtin_nontemporal_load((const f32x4*)(xp + (size_t)((mh * 4 + mm) * 16 + ps * 4) * D));
      __builtin_amdgcn_sched_barrier(0);
#pragma unroll
      for (int mm = 0; mm < 4; ++mm) {
        const int m = mh * 4 + mm;
#pragma unroll
        for (int n = 0; n < 4; ++n)
#pragma unroll
          for (int j = 0; j < 4; ++j) scr[(fq * 4 + j) * 68 + n * 16 + fr] = acc[m][n][j];
        __builtin_amdgcn_sched_barrier(0);
#pragma unroll
        for (int ps = 0; ps < 4; ++ps) {
          const f32x4 a = *(const f32x4*)(scr + (ps * 4 + prow) * 68 + c4 * 4);
          f32x4 v;
          v.x = xv[mm][ps].x + a.x * sc; v.y = xv[mm][ps].y + a.y * sc; v.z = xv[mm][ps].z + a.z * sc; v.w = xv[mm][ps].w + a.w * sc;
          const int grow = rb + m * 16 + ps * 4 + prow;
          __builtin_nontemporal_store(v, (f32x4*)(op + (size_t)(m * 16 + ps * 4) * D));
          if (xbp) {
            u32x2 o; o.x = pack_bf16(v.x, v.y); o.y = pack_bf16(v.z, v.w);
            *(u32x2*)(xbp + (size_t)grow * LDH + cb + c4 * 4) = o;
            const float t = red16(v.x * v.x + v.y * v.y + v.z * v.z + v.w * v.w);
            if (c4 == 0) atomicAdd(ssqp + grow, t);
          }
        }
        __builtin_amdgcn_sched_barrier(0);
      }
    }
  }
};
struct EpiLat8 {
  static constexpr bool LDS_SCRATCH = false;
  bf16_t* lat; float* kpe; float* ssq_q; float* ssq_kv; const float* ssq_x;
  DI void run8(f32x4 (&acc)[8][4], int rb, int cb, int fr, int fq) const {
    if (cb >= 1088) return;
    float* ssq = (cb < QL) ? ssq_q : ssq_kv;
#pragma unroll
    for (int mp = 0; mp < 2; ++mp) {
      float rsv[4][4];
#pragma unroll
      for (int mm = 0; mm < 4; ++mm)
#pragma unroll
        for (int j = 0; j < 4; ++j) rsv[mm][j] = rsqrtf(ssq_x[rb + (4 * mp + mm) * 16 + fq * 4 + j] * (1.f / D) + EPS);
      __builtin_amdgcn_sched_barrier(0);
#pragma unroll
      for (int mm = 0; mm < 4; ++mm) {
        float ssv[4];
#pragma unroll
        for (int j = 0; j < 4; ++j) {
          const int row = rb + (4 * mp + mm) * 16 + fq * 4 + j;
          float ss = 0.f;
#pragma unroll
          for (int n = 0; n < 4; ++n) {
            const float v = acc[4 * mp + mm][n][j] * rsv[mm][j];
            if (cb >= 1024) kpe[(size_t)row * 64 + (cb - 1024) + n * 16 + fr] = v;
            else { lat[(size_t)row * LDH + cb + n * 16 + fr] = to_bf16(v); ss += v * v; }
          }
          ssv[j] = ss;
        }
        if (cb < 1024) {
#pragma unroll
          for (int j = 0; j < 4; ++j) { const float t = red16(ssv[j]); if (fr == 0) atomicAdd(ssq + rb + (4 * mp + mm) * 16 + fq * 4 + j, t); }
        }
      }
    }
  }
};
struct EpiQraw8 {
  static constexpr bool LDS_SCRATCH = false;
  bf16_t* q; const float* ssq_q;
  DI void run8(f32x4 (&acc)[8][4], int rb, int cb, int fr, int fq) const {
#pragma unroll
    for (int m = 0; m < 8; ++m)
#pragma unroll
      for (int j = 0; j < 4; ++j) {
        const int row = rb + m * 16 + fq * 4 + j;
        const float rs = rsqrtf(ssq_q[row] * (1.f / QL) + EPS);
#pragma unroll
        for (int n = 0; n < 4; ++n) q[(size_t)row * 1536 + cb + n * 16 + fr] = to_bf16(acc[m][n][j] * rs);
      }
  }
};

DI void norm0_phase(const float* __restrict__ x, bf16_t* __restrict__ hb, float* __restrict__ ssq) {
  const int tid = opaque_tid512();
  const int lane = tid & 63, gw = blockIdx.x * 8 + (tid >> 6), nw = gridDim.x * 8;
  for (int row = gw; row < T; row += nw) {
    const f32x4* xr = (const f32x4*)(x + (size_t)row * D);
    f32x4 v[4];
    float ss = 0.f;
#pragma unroll
    for (int c = 0; c < 4; ++c) { v[c] = __builtin_nontemporal_load(xr + c * 64 + lane); ss += v[c].x * v[c].x + v[c].y * v[c].y + v[c].z * v[c].z + v[c].w * v[c].w; }
    ss = red64(ss);
    if (lane == 0) ssq[row] = ss;
#pragma unroll
    for (int c = 0; c < 4; ++c) {
      u32x2 o; o.x = pack_bf16(v[c].x, v[c].y); o.y = pack_bf16(v[c].z, v[c].w);
      *(u32x2*)(hb + (size_t)row * LDH + (c * 64 + lane) * 4) = o;
    }
  }
}

template <int W>
DI void pool_rows(const float* __restrict__ x, const float* smr, bf16_t* __restrict__ pb, int t0, int s0, int tid) {
  const int tq0 = t0 - s0;
  const float* xq = x + tid * 4;
  f32x4 Sm = {0.f, 0.f, 0.f, 0.f};
#pragma unroll
  for (int i = 1; i < W; ++i) {
    int t = t0 - i; if (t < tq0) t = tq0;
    Sm += *(const f32x4*)(xq + (size_t)t * D) * smr[15 - i];
  }
#pragma unroll 8
  for (int tl = 0; tl < 64; ++tl) {
    const int t = t0 + tl, s = s0 + tl;
    int to = t - W + 1; if (to < tq0) to = tq0;
    const f32x4 hn = *(const f32x4*)(xq + (size_t)t * D) * smr[15 + tl];
    const f32x4 ho = *(const f32x4*)(xq + (size_t)to * D) * smr[15 + tl - W + 1];
    const int cnt = (s + 1 < W) ? (s + 1) : W;
    const float ic = 1.f / (float)cnt;
    Sm += hn;
    const f32x4 p = Sm * ic - hn;
    Sm -= ho;
    u32x2 o; o.x = pack_bf16(p.x, p.y); o.y = pack_bf16(p.z, p.w);
    *(u32x2*)(pb + (size_t)t * LDH + tid * 4) = o;
  }
}
DI void poolprep_phase(int vb, int nvb, const float* __restrict__ x, const float* __restrict__ ssq, bf16_t* __restrict__ pb, float* smf) {
  const int tid = opaque_tid(), wave = tid >> 6;
  for (int c0 = 0; c0 < T / 64; c0 += nvb) {
    const int ch = c0 + vb;
    const bool on = ch < T / 64;
    const int t0 = ch * 64, s0 = t0 & (S - 1);
    if (on && tid < 79) smf[tid] = (s0 + tid >= 15) ? rsqrtf(ssq[t0 - 15 + tid] * (1.f / D) + EPS) : 0.f;
    __syncthreads();
    if (on) {
      if (wave == 0) pool_rows<2>(x, smf, pb, t0, s0, tid);
      else if (wave == 1) pool_rows<4>(x, smf, pb, t0, s0, tid);
      else if (wave == 2) pool_rows<8>(x, smf, pb, t0, s0, tid);
      else pool_rows<16>(x, smf, pb, t0, s0, tid);
    }
    __syncthreads();
  }
}

constexpr int KLS = QKH + 8;
constexpr int VLS = 64 + 8;
constexpr int K_EL = 64 * KLS;
constexpr int ATT_STG_EL = K_EL + 128 * VLS;

DI void attn_phase(const bf16_t* __restrict__ qraw, const bf16_t* __restrict__ kbuf, const bf16_t* __restrict__ vtb, bf16_t* __restrict__ obuf,
                   const float* __restrict__ gq, const float* __restrict__ cosT, const float* __restrict__ sinT, bf16_t* sm, int x, int j) {
  const int nb = gridDim.x >> 3;
  for (int p = j; p < 64; p += nb) {
    const int bh = 2 * x + (p >> 5);
    const int b = bh >> 3, hd = bh & 7;
    for (int half = 0; half < 2; ++half) {
      const int tid = opaque_tid512(), lane = tid & 63, wave = tid >> 6, r = lane & 31, h = lane >> 5;
      const int qb = half ? (p & 31) : (63 - (p & 31));
      const int q0 = qb * 256 + wave * 32;
      const size_t tok = (size_t)b * S + q0 + r;
      bf16x8 qf[12];
      {
        const bf16_t* qp = qraw + tok * 1536 + hd * QKH + h * 8;
#pragma unroll
        for (int st = 0; st < 12; ++st) qf[st] = *(const bf16x8*)(qp + st * 16);
        float ss = 0.f;
#pragma unroll
        for (int st = 0; st < 12; ++st) {
#pragma unroll
          for (int e = 0; e < 8; ++e) { const float f = bf2f(qf[st][e]); ss += f * f; }
          u32x4 t = __builtin_bit_cast(u32x4, qf[st]);
          asm volatile("" : "+v"(t));
          qf[st] = __builtin_bit_cast(bf16x8, t);
        }
        ss += __shfl_xor(ss, 32);
        const float rq = rsqrtf(ss * (1.f / QKH) + EPS) * (0.07216878364870322f * 1.4426950408889634f);
        __builtin_amdgcn_sched_barrier(0);
#pragma unroll
        for (int st = 0; st < 8; ++st) {
          const f32x4 ga = *(const f32x4*)(gq + st * 16 + h * 8), gb = *(const f32x4*)(gq + st * 16 + h * 8 + 4);
          u32x4 o;
          o.x = pack_bf16(bf2f(qf[st][0]) * rq * ga.x, bf2f(qf[st][1]) * rq * ga.y);
          o.y = pack_bf16(bf2f(qf[st][2]) * rq * ga.z, bf2f(qf[st][3]) * rq * ga.w);
          o.z = pack_bf16(bf2f(qf[st][4]) * rq * gb.x, bf2f(qf[st][5]) * rq * gb.y);
          o.w = pack_bf16(bf2f(qf[st][6]) * rq * gb.z, bf2f(qf[st][7]) * rq * gb.w);
          asm volatile("" : "+v"(o));
          qf[st] = __builtin_bit_cast(bf16x8, o);
          __builtin_amdgcn_sched_barrier(0);
        }
#pragma unroll
        for (int st = 8; st < 10; ++st) {
          const int jb = (st - 8) * 16 + h * 8;
          u32x4 o1, o2;
#pragma unroll
          for (int hf = 0; hf < 2; ++hf) {
            const f32x4 g1 = *(const f32x4*)(gq + 128 + jb + 4 * hf), g2 = *(const f32x4*)(gq + 160 + jb + 4 * hf);
            const f32x4 cc = *(const f32x4*)(cosT + tok * 32 + jb + 4 * hf), sn = *(const f32x4*)(sinT + tok * 32 + jb + 4 * hf);
            float y1[4], y2[4];
#pragma unroll
            for (int e = 0; e < 4; ++e) {
              const float x1 = bf2f(qf[st][4 * hf + e]) * rq * g1[e], x2 = bf2f(qf[st + 2][4 * hf + e]) * rq * g2[e];
              y1[e] = x1 * cc[e] - x2 * sn[e]; y2[e] = x2 * cc[e] + x1 * sn[e];
            }
            if (hf == 0) { o1.x = pack_bf16(y1[0], y1[1]); o1.y = pack_bf16(y1[2], y1[3]); o2.x = pack_bf16(y2[0], y2[1]); o2.y = pack_bf16(y2[2], y2[3]); }
            else { o1.z = pack_bf16(y1[0], y1[1]); o1.w = pack_bf16(y1[2], y1[3]); o2.z = pack_bf16(y2[0], y2[1]); o2.w = pack_bf16(y2[2], y2[3]); }
          }
          asm volatile("" : "+v"(o1), "+v"(o2));
          qf[st] = __builtin_bit_cast(bf16x8, o1); qf[st + 2] = __builtin_bit_cast(bf16x8, o2);
          __builtin_amdgcn_sched_barrier(0);
        }
      }
      f32x16 oacc[4];
#pragma unroll
      for (int mt = 0; mt < 4; ++mt)
#pragma unroll
        for (int i = 0; i < 16; ++i) oacc[mt][i] = 0.f;
      float m_run = -1e30f, l_run = 0.f;
      const int nkt = 4 * qb + 4;
      const bf16_t* kg = kbuf + (size_t)bh * S * QKH;
      const bf16_t* vg = vtb + (size_t)bh * VH * SV;
      u32x4 rk[3], rv[2];
      const unsigned kg_off0 = (unsigned)(tid >> 3) * QKH + (unsigned)(tid & 7) * 8u;
      const unsigned vg_off0 = (unsigned)(tid >> 3) * (unsigned)SV + (unsigned)(tid & 7) * 8u;
      const unsigned kl_off = (unsigned)(tid >> 3) * KLS + (unsigned)(tid & 7) * 8u;
      const unsigned vl_off = (unsigned)(tid >> 3) * VLS + (unsigned)(tid & 7) * 8u;
#define ALOAD(kt_)                                                                                                     \
  {                                                                                                                    \
    const bf16_t* kgt_ = kg + (size_t)(kt_) * 64 * QKH; const bf16_t* vgt_ = vg + (kt_) * 64;                          \
    unsigned kg_off = kg_off0, vg_off = vg_off0; asm volatile("" : "+v"(kg_off), "+v"(vg_off));                        \
    _Pragma("unroll") for (int i = 0; i < 3; ++i) rk[i] = *(const u32x4*)(kgt_ + (kg_off + (unsigned)(i * 64)));       \
    _Pragma("unroll") for (int i = 0; i < 2; ++i) rv[i] = *(const u32x4*)(vgt_ + (vg_off + (unsigned)(i * 64) * (unsigned)SV)); \
  }
      ALOAD(0);
#define ASTORE(stg_)                                                                                                   \
  {                                                                                                                    \
    bf16_t* sk_ = sm + (stg_) * ATT_STG_EL; bf16_t* sv_ = sk_ + K_EL;                                                  \
    _Pragma("unroll") for (int i = 0; i < 3; ++i) *(u32x4*)(sk_ + kl_off + i * 64) = rk[i];                            \
    _Pragma("unroll") for (int i = 0; i < 2; ++i) *(u32x4*)(sv_ + vl_off + i * 64 * VLS) = rv[i];                      \
  }
      ASTORE(0);
      __syncthreads();
      for (int kt = 0; kt < nkt; ++kt) {
        const bf16_t* smk = sm + (kt & 1) * ATT_STG_EL;
        const bf16_t* smv = smk + K_EL;
        const bool act_tile = (kt * 64 <= q0 + 31);
        if (!act_tile && kt + 1 < nkt) ALOAD(kt + 1);
        __builtin_amdgcn_sched_barrier(0);
        if (act_tile) {
        f32x16 sacc[2];
#pragma unroll
        for (int mt = 0; mt < 2; ++mt)
#pragma unroll
          for (int i = 0; i < 16; ++i) sacc[mt][i] = 0.f;
        const bf16_t* kp = smk + r * KLS + h * 8;
        {
          bf16x8 ka = *(const bf16x8*)(kp), kb = *(const bf16x8*)(kp + 32 * KLS);
          __builtin_amdgcn_sched_barrier(0);
          if (kt + 1 < nkt) ALOAD(kt + 1);
          __builtin_amdgcn_sched_barrier(0);
#pragma unroll
          for (int st = 0; st < 12; ++st) {
            bf16x8 na = ka, nbq = kb;
            if (st + 1 < 12) { na = *(const bf16x8*)(kp + (st + 1) * 16); nbq = *(const bf16x8*)(kp + 32 * KLS + (st + 1) * 16); }
            sacc[0] = MFMA(ka, qf[st], sacc[0]);
            sacc[1] = MFMA(kb, qf[st], sacc[1]);
            ka = na; kb = nbq;
            __builtin_amdgcn_sched_barrier(0);
          }
        }
        bf16x8 va[2][4];
        {
          const bf16_t* vp0 = smv + r * VLS + h * 8;
#pragma unroll
          for (int mt = 0; mt < 4; ++mt) va[0][mt] = *(const bf16x8*)(vp0 + mt * 32 * VLS);
        }
        if (kt * 64 + 63 > q0) {
          const int qpos = q0 + r;
#pragma unroll
          for (int mt = 0; mt < 2; ++mt)
#pragma unroll
            for (int i = 0; i < 16; ++i) { const int key = kt * 64 + mt * 32 + crow(i, h); if (key > qpos) sacc[mt][i] = -INFINITY; }
        }
        float mx = sacc[0][0];
#pragma unroll
        for (int mt = 0; mt < 2; ++mt)
#pragma unroll
          for (int i = 0; i < 16; ++i) mx = fmaxf(mx, sacc[mt][i]);
        mx = xmax32(mx);
        const float m_new = fmaxf(m_run, mx);
        const float alpha = __builtin_amdgcn_exp2f(m_run - m_new);
        m_run = m_new;
        float rs = 0.f;
#pragma unroll
        for (int mt = 0; mt < 2; ++mt)
#pragma unroll
          for (int i = 0; i < 16; ++i) { const float pv = __builtin_amdgcn_exp2f(sacc[mt][i] - m_new); sacc[mt][i] = pv; rs += pv; }
        rs = xsum32(rs);
        l_run = l_run * alpha + rs;
        if (__any(alpha != 1.f)) {
#pragma unroll
          for (int mt = 0; mt < 4; ++mt)
#pragma unroll
            for (int i = 0; i < 16; ++i) oacc[mt][i] *= alpha;
        }
        bf16x8 pf[4];
#pragma unroll
        for (int ks = 0; ks < 4; ++ks) {
          u32x4 o;
          o.x = pack_bf16(sacc[ks >> 1][8 * (ks & 1) + 0], sacc[ks >> 1][8 * (ks & 1) + 1]);
          o.y = pack_bf16(sacc[ks >> 1][8 * (ks & 1) + 2], sacc[ks >> 1][8 * (ks & 1) + 3]);
          o.z = pack_bf16(sacc[ks >> 1][8 * (ks & 1) + 4], sacc[ks >> 1][8 * (ks & 1) + 5]);
          o.w = pack_bf16(sacc[ks >> 1][8 * (ks & 1) + 6], sacc[ks >> 1][8 * (ks & 1) + 7]);
          pf[ks] = __builtin_bit_cast(bf16x8, o);
        }
        const bf16_t* vp = smv + r * VLS + h * 8;
        __builtin_amdgcn_sched_barrier(0);
        {
#pragma unroll
          for (int ks = 0; ks < 4; ++ks) {
            if (ks + 1 < 4) {
#pragma unroll
              for (int mt = 0; mt < 4; ++mt) va[(ks + 1) & 1][mt] = *(const bf16x8*)(vp + mt * 32 * VLS + (ks + 1) * 16);
            }
#pragma unroll
            for (int mt = 0; mt < 4; ++mt) oacc[mt] = MFMA(va[ks & 1][mt], pf[ks], oacc[mt]);
            __builtin_amdgcn_sched_barrier(0);
          }
        }
        }
        if (kt + 1 < nkt) ASTORE((kt + 1) & 1);
        __syncthreads();
      }
#undef ALOAD
#undef ASTORE
      const float inv = 1.f / l_run;
      bf16_t* op = obuf + tok * LDH + hd * VH + 4 * h;
#pragma unroll
      for (int mt = 0; mt < 4; ++mt)
#pragma unroll
        for (int a = 0; a < 4; ++a) {
          u32x2 o;
          o.x = pack_bf16(oacc[mt][4 * a] * inv, oacc[mt][4 * a + 1] * inv);
          o.y = pack_bf16(oacc[mt][4 * a + 2] * inv, oacc[mt][4 * a + 3] * inv);
          *(u32x2*)(op + mt * 32 + 8 * a) = o;
        }
      __syncthreads();
    }
  }
}

typedef Cfg<4, 1, 1, 4, 64, 1> CR;

__global__ void __launch_bounds__(512, 2) fwd_megakernel(Params p) {
  cg::grid_group grid = cg::this_grid();
  unsigned char* ws = p.ws;
  const float* x_in = p.in[0];
  const int* positions = (const int*)p.in[1];
  float* out = p.out;
  bf16_t* wgu1 = (bf16_t*)(ws + OFF_WGU1); bf16_t* wdn1 = (bf16_t*)(ws + OFF_WDN1);
  bf16_t* wgu2 = (bf16_t*)(ws + OFF_WGU2); bf16_t* wdn2 = (bf16_t*)(ws + OFF_WDN2);
  bf16_t* wpool = (bf16_t*)(ws + OFF_WPOOL); bf16_t* win = (bf16_t*)(ws + OFF_WIN); bf16_t* wq = (bf16_t*)(ws + OFF_WQ);
  bf16_t* wkv = (bf16_t*)(ws + OFF_WKV); bf16_t* wout = (bf16_t*)(ws + OFF_WOUT);
  float* cosT = (float*)(ws + OFF_COS); float* sinT = (float*)(ws + OFF_SIN);
  float* ssq_all = (float*)(ws + OFF_SSQ);
  float* kpe = (float*)(ws + OFF_KPE);
  bf16_t* hb = (bf16_t*)(ws + OFF_HB);
  bf16_t* act = (bf16_t*)(ws + OFF_ACT); bf16_t* lat = (bf16_t*)(ws + OFF_LAT); bf16_t* qraw = (bf16_t*)(ws + OFF_QRAW);
  bf16_t* kbuf = (bf16_t*)(ws + OFF_K); bf16_t* vtb = (bf16_t*)(ws + OFF_VT);
  bf16_t* obuf = lat; bf16_t* pooled = (bf16_t*)(ws + OFF_POOLED);
  const int gt = blockIdx.x * 512 + threadIdx.x, gs = gridDim.x * 512;
  const int vhalf = __builtin_amdgcn_readfirstlane((int)(threadIdx.x >> 8));
  const int vb = blockIdx.x * 2 + vhalf, nvb = gridDim.x * 2;
  bf16_t* smh = (bf16_t*)(smem + vhalf * VHALF_BYTES);
  float* smf = (float*)(smem + vhalf * VHALF_BYTES);

  unsigned* ctl = (unsigned*)(ws + OFF_CTL);
  if (threadIdx.x == 0) {
    const unsigned xcc = (unsigned)__builtin_amdgcn_s_getreg((3 << 11) | 20) & 0x7u;
    const unsigned rank = atomicAdd(ctl + xcc, 1u);
    ((volatile int*)smem)[0] = (int)xcc; ((volatile int*)smem)[1] = (int)rank;
  }
  __syncthreads();
  int xs = __builtin_amdgcn_readfirstlane(((volatile int*)smem)[0]);
  int js = __builtin_amdgcn_readfirstlane(((volatile int*)smem)[1]);
  __syncthreads();

  for (int idx = gt; idx < T * 32; idx += gs) {
    const int t = idx >> 5, jf = idx & 31;
    const float inv_freq = exp2f(-(float)jf * 0.41524101186092029f);
    const float ang = (float)positions[t] * inv_freq;
    const double rev = (double)ang * 0.15915494309189535;
    const float fr = (float)(rev - rint(rev));
    cosT[idx] = __builtin_amdgcn_cosf(fr);
    sinT[idx] = __builtin_amdgcn_sinf(fr);
  }
  for (int i = gt; i < 15 * T; i += gs) ssq_all[T + i] = 0.f;
  norm0_phase(x_in, hb, ssq_all);
  for (int jl = 0; jl < 2; ++jl) {
    for (int g = 0; g < 4; ++g)
      prep_w(vb, nvb, p.in[7] + ((size_t)jl * 4 + g) * 65536, wpool + ((size_t)jl * 4 + g) * 256 * (256 + PADK), 256, 256, p.in[6] + (size_t)(2 * jl) * D + g * 256, p.in[8] + (size_t)jl * D + g * 256, 0, smf);
    prep_w(vb, nvb, p.in[9] + (size_t)jl * D * 1088, win + (size_t)jl * LATNP * (D + PADK), D, 1088, p.in[6] + (size_t)(2 * jl + 1) * D, nullptr, 0, smf);
    for (int i = gt; i < (LATNP - 1088) * (D + PADK) / 8; i += gs) ((u32x4*)(win + (size_t)jl * LATNP * (D + PADK) + (size_t)1088 * (D + PADK)))[i] = (u32x4){0u, 0u, 0u, 0u};
    prep_w(vb, nvb, p.in[11] + (size_t)jl * QL * 1536, wq + (size_t)jl * 1536 * (QL + PADK), QL, 1536, p.in[10] + (size_t)jl * QL, nullptr, 0, smf);
    prep_w(vb, nvb, p.in[13] + (size_t)jl * KVL * 2048, wkv + (size_t)jl * 2048 * (KVL + PADK), KVL, 2048, p.in[12] + (size_t)jl * KVL, nullptr, 3, smf);
    prep_w(vb, nvb, p.in[16] + (size_t)jl * D * D, wout + (size_t)jl * D * (D + PADK), D, D, nullptr, nullptr, 0, smf);
  }
#define PREP_FFN1(L_) { const size_t wo_ = (size_t)(L_) * D * FF; \
    prep_w(vb, nvb, p.in[3] + wo_, wgu1, D, FF, p.in[2] + (size_t)(L_) * D, nullptr, 1, smf); \
    prep_w(vb, nvb, p.in[4] + wo_, wgu1, D, FF, p.in[2] + (size_t)(L_) * D, nullptr, 2, smf); \
    prep_w(vb, nvb, p.in[5] + wo_, wdn1, FF, D, nullptr, nullptr, 0, smf); }
#define PREP_FFN2(L_) { const size_t wo_ = (size_t)(L_) * D * FF; \
    prep_w(vb, nvb, p.in[18] + wo_, wgu2, D, FF, p.in[17] + (size_t)(L_) * D, nullptr, 1, smf); \
    prep_w(vb, nvb, p.in[19] + wo_, wgu2, D, FF, p.in[17] + (size_t)(L_) * D, nullptr, 2, smf); \
    prep_w(vb, nvb, p.in[20] + wo_, wdn2, FF, D, nullptr, nullptr, 0, smf); }
  PREP_FFN1(0);
  PREP_FFN2(0);
  grid.sync();
  {
    bool even = true;
    for (int i = 0; i < 8; ++i) even = even && (__hip_atomic_load(ctl + i, __ATOMIC_RELAXED, __HIP_MEMORY_SCOPE_AGENT) == (gridDim.x >> 3));
    if (!even || js >= (int)(gridDim.x >> 3)) { xs = blockIdx.x & 7; js = blockIdx.x >> 3; }
  }
  unsigned bar_target = 0;
#define GBAR() { bar_target += gridDim.x; grid_bar(ctl + 32, bar_target); }
  unsigned xbar_target = 0;
#define XBAR() { xbar_target += (gridDim.x >> 3); grid_bar(ctl + 48 + xs, xbar_target); }
  const int jv = js * 2 + vhalf, nbv = (int)(gridDim.x >> 3) * 2;

  for (int layer = 0; layer < DEPTH; ++layer) {
    const float* xcur = (layer == 0) ? x_in : out;
    float* ssq0 = ssq_all + (size_t)(layer * 3 + 0) * T;
    float* ssq1 = ssq_all + (size_t)(layer * 3 + 1) * T;
    float* ssq2 = ssq_all + (size_t)(layer * 3 + 2) * T;
    float* ssq_next = ssq_all + (size_t)((layer + 1) * 3) * T;
    const int jl = layer >> 1;
    float* ssq_q = ssq_all + (size_t)(12 + jl) * T;
    float* ssq_kv = ssq_all + (size_t)(14 + jl) * T;
    if (layer > 0) PREP_FFN2(layer);
    gemm8_phase(xs, js, hb, LDH, wgu1, D, 2 * FF, 0, EpiGU8{act, ssq0});
    XBAR();
    gemm8_phase(xs, js, act, LDA, wdn1, FF, D, 0, EpiResid8{xcur, out, 0.5f, hb, ssq1});
    GBAR();
    if (layer + 1 < DEPTH) PREP_FFN1(layer + 1);
    if ((layer & 1) == 0) {
      poolprep_phase(vb, nvb, out, ssq1, pooled, smf);
      GBAR();
      gemm8_phase(xs, js, pooled, LDH, wpool + (size_t)jl * 1024 * (256 + PADK), 256, D, 256, EpiResid8{out, out, 1.0f, hb, ssq2});
      GBAR();
    } else {
      gemm8_phase(xs, js, hb, LDH, win + (size_t)jl * LATNP * (D + PADK), D, LATNP, 0, EpiLat8{lat, kpe, ssq_q, ssq_kv, ssq1});
      GBAR();
      gemm8_phase(xs, js, lat, LDH, wq + (size_t)jl * 1536 * (QL + PADK), QL, 1536, 0, EpiQraw8{qraw, ssq_q});
      gemm_phase<CR>(xs, jv, nbv, lat + QL, LDH, wkv + (size_t)jl * 2048 * (KVL + PADK), KVL, 2048, 0, EpiKV{ssq_kv, kpe, p.in[15] + (size_t)jl * QKH, cosT, sinT, kbuf, vtb}, smh);
      GBAR();
      attn_phase(qraw, kbuf, vtb, obuf, p.in[14] + (size_t)jl * QKH, cosT, sinT, (bf16_t*)smem, xs, js);
      GBAR();
      gemm8_phase(xs, js, obuf, LDH, wout + (size_t)jl * D * (D + PADK), D, D, 0, EpiResid8{out, out, 1.0f, hb, ssq2});
      GBAR();
    }
    gemm8_phase(xs, js, hb, LDH, wgu2, D, 2 * FF, 0, EpiGU8{act, ssq2});
    XBAR();
    const bool last = (layer + 1 == DEPTH);
    gemm8_phase(xs, js, act, LDA, wdn2, FF, D, 0, EpiResid8{out, out, 0.5f, last ? nullptr : hb, last ? nullptr : ssq_next});
    if (!last) GBAR();
  }
}

extern "C" void kernel_launch(void* const* d_in, const int* in_sizes, int n_in, void* d_out, int out_size, void* d_ws, size_t ws_size, hipStream_t stream) {
  static int grid_blocks = 0;
  if (!grid_blocks) {
    int dev = 0, cus = 0, per_cu = 0;
    (void)hipGetDevice(&dev);
    (void)hipDeviceGetAttribute(&cus, hipDeviceAttributeMultiprocessorCount, dev);
    (void)hipFuncSetAttribute((const void*)fwd_megakernel, hipFuncAttributeMaxDynamicSharedMemorySize, LDS_BYTES);
    (void)hipOccupancyMaxActiveBlocksPerMultiprocessor(&per_cu, fwd_megakernel, 512, LDS_BYTES);
    grid_blocks = cus;
    if (n_in != 21 || out_size != T * D || ws_size < WS_TOTAL || per_cu < 1) fprintf(stderr, "kernel_launch: unexpected n_in=%d out=%d ws=%zu (need %zu) per_cu=%d\n", n_in, out_size, ws_size, (size_t)WS_TOTAL, per_cu);
  }
  Params p{};
  for (int i = 0; i < 21; ++i) p.in[i] = (const float*)d_in[i];
  p.out = (float*)d_out; p.ws = (unsigned char*)d_ws;
  (void)hipMemsetAsync((unsigned char*)d_ws + OFF_CTL, 0, 256, stream);
  void* args[] = {&p};
  hipError_t e = hipLaunchCooperativeKernel((void*)fwd_megakernel, dim3(grid_blocks), dim3(512), args, LDS_BYTES, stream);
  if (e != hipSuccess) fprintf(stderr, "cooperative launch failed: %s (grid %d)\n", hipGetErrorString(e), grid_blocks);
}
```

```cpp
#include <hip/hip_runtime.h>
#include <hip/hip_cooperative_groups.h>
#include <cstdio>
#include <cstdint>
namespace cg = cooperative_groups;

#define DI __device__ __forceinline__
typedef unsigned short bf16_t;
typedef short bf16x8 __attribute__((ext_vector_type(8)));
typedef float f32x16 __attribute__((ext_vector_type(16)));
typedef float f32x4 __attribute__((ext_vector_type(4)));
typedef float f32x2 __attribute__((ext_vector_type(2)));
typedef unsigned u32x4 __attribute__((ext_vector_type(4)));
typedef unsigned u32x2 __attribute__((ext_vector_type(2)));
typedef __bf16 bf16v2 __attribute__((ext_vector_type(2)));

constexpr int NB = 2, S = 16384, T = NB * S, D = 1024, FF = 2816, NH = 8, DEPTH = 4;
constexpr int QL = 768, KVL = 256, QKH = 192, VH = 128;
constexpr int LATNP = 1280;
constexpr int LDH = D + 64;
constexpr int LDA = FF + 64;
constexpr int SV = S + 64;
constexpr int PADK = 64;
constexpr float EPS = 1e-6f;

constexpr size_t SZ_WGU = (size_t)2 * FF * (D + PADK) * 2, SZ_WDN = (size_t)D * (FF + PADK) * 2;
constexpr size_t OFF_WGU1 = 0, OFF_WDN1 = OFF_WGU1 + SZ_WGU, OFF_WGU2 = OFF_WDN1 + SZ_WDN, OFF_WDN2 = OFF_WGU2 + SZ_WGU;
constexpr size_t SZ_WPOOL = (size_t)1024 * (256 + PADK) * 2, SZ_WIN = (size_t)LATNP * (D + PADK) * 2, SZ_WQ = (size_t)1536 * (QL + PADK) * 2;
constexpr size_t SZ_WKV = (size_t)2048 * (KVL + PADK) * 2, SZ_WOUT = (size_t)D * (D + PADK) * 2;
constexpr size_t OFF_WPOOL = OFF_WDN2 + SZ_WDN;
constexpr size_t OFF_WIN = OFF_WPOOL + 2 * SZ_WPOOL;
constexpr size_t OFF_WQ = OFF_WIN + 2 * SZ_WIN;
constexpr size_t OFF_WKV = OFF_WQ + 2 * SZ_WQ;
constexpr size_t OFF_WOUT = OFF_WKV + 2 * SZ_WKV;
constexpr size_t OFF_COS = OFF_WOUT + 2 * SZ_WOUT;
constexpr size_t OFF_SIN = OFF_COS + (size_t)T * 32 * 4;
constexpr size_t OFF_SSQ = OFF_SIN + (size_t)T * 32 * 4;
constexpr size_t OFF_KPE = OFF_SSQ + (size_t)16 * T * 4;
constexpr size_t OFF_HB = OFF_KPE + (size_t)T * 64 * 4;
constexpr size_t OFF_BIG = OFF_HB + (size_t)T * LDH * 2;
constexpr size_t OFF_ACT = OFF_BIG;
constexpr size_t OFF_LAT = OFF_BIG;
constexpr size_t OFF_POOLED = OFF_BIG;
constexpr size_t OFF_QRAW = OFF_LAT + (size_t)T * LDH * 2;
constexpr size_t OFF_K = OFF_QRAW + (size_t)T * 1536 * 2;
constexpr size_t OFF_VT = OFF_K + (size_t)T * NH * QKH * 2;
constexpr size_t WS_END = OFF_VT + (size_t)NB * NH * VH * SV * 2;
static_assert(OFF_ACT + (size_t)T * LDA * 2 <= WS_END, "act must fit in the big region");
constexpr size_t OFF_CTL = WS_END;
constexpr size_t WS_TOTAL = OFF_CTL + 256;
static_assert(WS_TOTAL <= (size_t)536870912, "workspace budget (4 x largest tensor)");
constexpr int LDS_BYTES = 131072;
constexpr int VHALF_BYTES = 36864;

struct Params { const float* in[21]; float* out; unsigned char* ws; };
extern __shared__ __attribute__((aligned(1024))) unsigned char smem[];

DI unsigned pack_bf16(float lo, float hi) { f32x2 v = {lo, hi}; bf16v2 b = __builtin_convertvector(v, bf16v2); return __builtin_bit_cast(unsigned, b); }
DI bf16_t to_bf16(float x) { return (bf16_t)(pack_bf16(x, 0.f) & 0xffffu); }
DI float bf2f(short v) { return __uint_as_float(((unsigned)(unsigned short)v) << 16); }
DI int crow(int i, int h) { return (i & 3) + 8 * (i >> 2) + 4 * h; }
DI float red32(float v) { v += __shfl_xor(v, 1); v += __shfl_xor(v, 2); v += __shfl_xor(v, 4); v += __shfl_xor(v, 8); v += __shfl_xor(v, 16); return v; }
DI float red64(float v) { v = red32(v); v += __shfl_xor(v, 32); return v; }
DI float xmax32(float v) { const u32x2 r = __builtin_amdgcn_permlane32_swap(__float_as_uint(v), __float_as_uint(v), false, false); return fmaxf(__uint_as_float(r.x), __uint_as_float(r.y)); }
DI float xsum32(float v) { const u32x2 r = __builtin_amdgcn_permlane32_swap(__float_as_uint(v), __float_as_uint(v), false, false); return __uint_as_float(r.x) + __uint_as_float(r.y); }
DI int opaque_tid() { int t = threadIdx.x & 255; asm volatile("" : "+v"(t)); return t; }
DI int opaque_tid512() { int t = threadIdx.x; asm volatile("" : "+v"(t)); return t; }
#define MFMA(a, b, c) __builtin_amdgcn_mfma_f32_32x32x16_bf16((a), (b), (c), 0, 0, 0)
DI void grid_bar(unsigned* ctr, unsigned target) {
  asm volatile("s_waitcnt vmcnt(0)" ::: "memory");
  __syncthreads();
  if (threadIdx.x == 0) {
    __builtin_amdgcn_fence(__ATOMIC_RELEASE, "agent");
    asm volatile("s_waitcnt vmcnt(0)" ::: "memory");
    (void)__hip_atomic_fetch_add(ctr, 1u, __ATOMIC_RELAXED, __HIP_MEMORY_SCOPE_AGENT);
    while (__hip_atomic_load(ctr, __ATOMIC_RELAXED, __HIP_MEMORY_SCOPE_AGENT) < target) __builtin_amdgcn_s_sleep(1);
    __builtin_amdgcn_fence(__ATOMIC_ACQUIRE, "agent");
    asm volatile("s_waitcnt vmcnt(0)" ::: "memory");
  }
  __syncthreads();
}

DI void prep_w(int vb, int nvb, const float* __restrict__ W, bf16_t* __restrict__ Wt, int K, int N, const float* __restrict__ gk, const float* __restrict__ sn, int mode, float* smf) {
  const int ldt = K + PADK;
  const int tid = opaque_tid();
  const int ntn = N / 64, nt = (K / 64) * ntn;
  for (int t0 = 0; t0 < nt; t0 += nvb) {
    const int t = t0 + vb;
    const bool on = t < nt;
    const int k0 = (t / ntn) * 64, n0 = (t % ntn) * 64;
    if (on) {
#pragma unroll
      for (int i = 0; i < 16; ++i) {
        const int kk = i * 4 + (tid >> 6), nn = tid & 63;
        float v = __builtin_nontemporal_load(W + (size_t)(k0 + kk) * N + n0 + nn);
        if (gk) v *= gk[k0 + kk];
        if (sn) v *= sn[n0 + nn];
        smf[kk * 65 + nn] = v;
      }
    }
    __syncthreads();
    if (on) {
      const int nl = tid >> 2, kq = (tid & 3) * 16;
      u32x4 p0, p1;
      p0.x = pack_bf16(smf[(kq + 0) * 65 + nl], smf[(kq + 1) * 65 + nl]);
      p0.y = pack_bf16(smf[(kq + 2) * 65 + nl], smf[(kq + 3) * 65 + nl]);
      p0.z = pack_bf16(smf[(kq + 4) * 65 + nl], smf[(kq + 5) * 65 + nl]);
      p0.w = pack_bf16(smf[(kq + 6) * 65 + nl], smf[(kq + 7) * 65 + nl]);
      p1.x = pack_bf16(smf[(kq + 8) * 65 + nl], smf[(kq + 9) * 65 + nl]);
      p1.y = pack_bf16(smf[(kq + 10) * 65 + nl], smf[(kq + 11) * 65 + nl]);
      p1.z = pack_bf16(smf[(kq + 12) * 65 + nl], smf[(kq + 13) * 65 + nl]);
      p1.w = pack_bf16(smf[(kq + 14) * 65 + nl], smf[(kq + 15) * 65 + nl]);
      const int n = n0 + nl;
      int row = n;
      if (mode == 1) row = (n >> 4) * 32 + (n & 15);
      else if (mode == 2) row = (n >> 4) * 32 + 16 + (n & 15);
      else if (mode == 3) { const int hd = n >> 8, j = n & 255; row = (j < 128) ? (hd * 128 + j) : (1024 + hd * 128 + (j - 128)); }
      u32x4* dst = (u32x4*)(Wt + (size_t)row * ldt + k0 + kq);
      dst[0] = p0; dst[1] = p1;
    }
    __syncthreads();
  }
}

template <int WM_, int WN_, int MI_, int NI_, int BK_, int ST_>
struct Cfg {
  static constexpr int WM = WM_, WN = WN_, MI = MI_, NI = NI_, BK = BK_, ST = ST_;
  static constexpr int BM = WM * MI * 32, BN = WN * NI * 32;
  static constexpr int LS = BK + 8;
  static constexpr int A_EL = BM * LS, B_EL = BN * LS, STAGE_EL = A_EL + B_EL;
  static constexpr int CPR = BK / 8;
  static constexpr int A_CH = BM * CPR / 256, B_CH = BN * CPR / 256;
  static_assert(WM * WN == 4, "4 waves");
  static_assert(ST * STAGE_EL * 2 <= VHALF_BYTES, "LDS of a virtual half-block");
};

template <class C, class Epi>
DI void gemm_tile(const bf16_t* __restrict__ A, int lda, const bf16_t* __restrict__ Bt, int K, int m0, int n0, const Epi& epi, bf16_t* sm) {
  const int tid = opaque_tid(), lane = tid & 63, wave = tid >> 6, r = lane & 31, h = lane >> 5;
  const int wm = wave / C::WN, wn = wave % C::WN;
  f32x16 acc[C::MI][C::NI];
#pragma unroll
  for (int mi = 0; mi < C::MI; ++mi)
#pragma unroll
    for (int ni = 0; ni < C::NI; ++ni)
#pragma unroll
      for (int i = 0; i < 16; ++i) acc[mi][ni][i] = 0.f;
  const bf16_t* Ag = A + (size_t)m0 * lda;
  const int ldb = K + PADK;
  const bf16_t* Bg = Bt + (size_t)n0 * ldb;
  u32x4 ra[C::A_CH], rb[C::B_CH];
  const int nk = K / C::BK;
  constexpr int RPP = 256 / C::CPR;
  const unsigned a_off = (unsigned)(tid / C::CPR) * (unsigned)lda + (unsigned)(tid % C::CPR) * 8u;
  const unsigned b_off = (unsigned)(tid / C::CPR) * (unsigned)ldb + (unsigned)(tid % C::CPR) * 8u;
  const unsigned l_off = (unsigned)(tid / C::CPR) * C::LS + (unsigned)(tid % C::CPR) * 8u;
#define GLOAD(k0_)                                                                                   \
  {                                                                                                  \
    const bf16_t* ag_ = Ag + (k0_); const bf16_t* bg_ = Bg + (k0_);                                  \
    _Pragma("unroll") for (int i = 0; i < C::A_CH; ++i) ra[i] = *(const u32x4*)(ag_ + (a_off + (unsigned)(i * RPP) * (unsigned)lda)); \
    _Pragma("unroll") for (int i = 0; i < C::B_CH; ++i) rb[i] = *(const u32x4*)(bg_ + (b_off + (unsigned)(i * RPP) * (unsigned)ldb));   \
  }
#define LSTORE(buf_)                                                                                 \
  {                                                                                                  \
    bf16_t* sa_ = sm + (buf_) * C::STAGE_EL + l_off; bf16_t* sb_ = sa_ + C::A_EL;                    \
    _Pragma("unroll") for (int i = 0; i < C::A_CH; ++i) *(u32x4*)(sa_ + i * RPP * C::LS) = ra[i];   \
    _Pragma("unroll") for (int i = 0; i < C::B_CH; ++i) *(u32x4*)(sb_ + i * RPP * C::LS) = rb[i];   \
  }
  GLOAD(0);
  if (C::ST == 2) {
    LSTORE(0);
    __syncthreads();
  }
  for (int kt = 0; kt < nk; ++kt) {
    const int buf = (C::ST == 2) ? (kt & 1) : 0;
    if (C::ST == 1) {
      __syncthreads();
      LSTORE(0);
      __syncthreads();
    }
    if (kt + 1 < nk) GLOAD((kt + 1) * C::BK);
    __builtin_amdgcn_sched_barrier(0);
    const bf16_t* sa = sm + buf * C::STAGE_EL + (wm * C::MI * 32 + r) * C::LS + h * 8;
    const bf16_t* sb = sm + buf * C::STAGE_EL + C::A_EL + (wn * C::NI * 32 + r) * C::LS + h * 8;
#pragma unroll
    for (int ks = 0; ks < C::BK / 16; ++ks) {
      bf16x8 af[C::MI], bfr[C::NI];
#pragma unroll
      for (int mi = 0; mi < C::MI; ++mi) af[mi] = *(const bf16x8*)(sa + mi * 32 * C::LS + ks * 16);
#pragma unroll
      for (int ni = 0; ni < C::NI; ++ni) bfr[ni] = *(const bf16x8*)(sb + ni * 32 * C::LS + ks * 16);
#pragma unroll
      for (int mi = 0; mi < C::MI; ++mi)
#pragma unroll
        for (int ni = 0; ni < C::NI; ++ni) acc[mi][ni] = MFMA(af[mi], bfr[ni], acc[mi][ni]);
    }
    if (C::ST == 2) {
      if (kt + 1 < nk) LSTORE((kt + 1) & 1);
      __syncthreads();
    }
  }
  if (C::ST == 1) __syncthreads();
#undef GLOAD
#undef LSTORE
  epi.template run<C::MI, C::NI>(acc, m0 + wm * C::MI * 32, n0 + wn * C::NI * 32, r, h);
}

template <class C, class Epi>
DI void gemm_phase(int x, int j, int nb, const bf16_t* __restrict__ A, int lda, const bf16_t* __restrict__ Bt, int K, int N, int a_grp, const Epi& epi, bf16_t* sm) {
  static_assert(C::BM == 128 && (C::BN == 128 || C::BN == 256), "tile");
  constexpr int GN = (C::BN == 256) ? 4 : 8;
  const int nN = N / C::BN;
  const int total = 32 * nN;
  for (int u = j; u < total; u += nb) {
    const int ng = u / (32 * GN), rem = u % (32 * GN);
    int gn = nN - GN * ng; if (gn > GN) gn = GN;
    const int mg = rem / (8 * gn), jj = rem % (8 * gn);
    const int mt = 32 * x + 8 * mg + (jj & 7), nt = GN * ng + (jj >> 3);
    const int n0 = nt * C::BN;
    const bf16_t* Ap = a_grp ? (A + (n0 / a_grp) * K) : A;
    gemm_tile<C, Epi>(Ap, lda, Bt, K, mt * 128, n0, epi, sm);
  }
}

struct EpiGU {
  bf16_t* act; const float* ssq;
  template <int MI, int NI> DI void run(f32x16 (&acc)[MI][NI], int mb, int nb, int r, int h) const {
    static_assert((NI & 1) == 0, "gate/up pairs");
#pragma unroll
    for (int mi = 0; mi < MI; ++mi)
#pragma unroll
      for (int i = 0; i < 16; ++i) {
        const int row = mb + mi * 32 + crow(i, h);
        const float rs = rsqrtf(ssq[row] * (1.f / D) + EPS);
#pragma unroll
        for (int pi = 0; pi < NI / 2; ++pi) {
          const float g = acc[mi][2 * pi][i] * rs, u = acc[mi][2 * pi + 1][i] * rs;
          const float a = g / (1.f + __expf(-g)) * u;
          act[(size_t)row * LDA + (nb >> 1) + pi * 32 + r] = to_bf16(a);
        }
      }
  }
};
struct EpiResid {
  const float* xin; float* xout; float scale; bf16_t* xb; float* ssq;
  template <int MI, int NI> DI void run(f32x16 (&acc)[MI][NI], int mb, int nb, int r, int h) const {
#pragma unroll
    for (int mi = 0; mi < MI; ++mi)
#pragma unroll
      for (int hf = 0; hf < 2; ++hf) {
        float xv[8][NI];
#pragma unroll
        for (int i = 0; i < 8; ++i)
#pragma unroll
          for (int ni = 0; ni < NI; ++ni) xv[i][ni] = xin[(size_t)(mb + mi * 32 + crow(hf * 8 + i, h)) * D + nb + ni * 32 + r];
        __builtin_amdgcn_sched_barrier(0);
        float ssv[8];
#pragma unroll
        for (int i = 0; i < 8; ++i) {
          const int row = mb + mi * 32 + crow(hf * 8 + i, h);
          float ss = 0.f;
#pragma unroll
          for (int ni = 0; ni < NI; ++ni) {
            const float v = xv[i][ni] + scale * acc[mi][ni][hf * 8 + i];
            xout[(size_t)row * D + nb + ni * 32 + r] = v;
            if (xb) { xb[(size_t)row * LDH + nb + ni * 32 + r] = to_bf16(v); ss += v * v; }
          }
          ssv[i] = ss;
        }
        if (xb) {
#pragma unroll
          for (int i = 0; i < 8; ++i) { const float t = red32(ssv[i]); if (r == 0) atomicAdd(ssq + mb + mi * 32 + crow(hf * 8 + i, h), t); }
        }
        __builtin_amdgcn_sched_barrier(0);
      }
  }
};
struct EpiLat {
  bf16_t* lat; float* kpe; float* ssq_q; float* ssq_kv; const float* ssq_x;
  template <int MI, int NI> DI void run(f32x16 (&acc)[MI][NI], int mb, int nb, int r, int h) const {
    if (nb >= 1088) return;
    float* ssq = (nb < QL) ? ssq_q : ssq_kv;
#pragma unroll
    for (int mi = 0; mi < MI; ++mi) {
      float rsv[16];
#pragma unroll
      for (int i = 0; i < 16; ++i) rsv[i] = rsqrtf(ssq_x[mb + mi * 32 + crow(i, h)] * (1.f / D) + EPS);
      __builtin_amdgcn_sched_barrier(0);
      if (nb >= 1024) {
#pragma unroll
        for (int i = 0; i < 16; ++i)
#pragma unroll
          for (int ni = 0; ni < NI; ++ni) kpe[(size_t)(mb + mi * 32 + crow(i, h)) * 64 + (nb - 1024) + ni * 32 + r] = acc[mi][ni][i] * rsv[i];
      } else {
        float ssv[16];
#pragma unroll
        for (int i = 0; i < 16; ++i) {
          const int row = mb + mi * 32 + crow(i, h);
          float ss = 0.f;
#pragma unroll
          for (int ni = 0; ni < NI; ++ni) { const float v = acc[mi][ni][i] * rsv[i]; ss += v * v; lat[(size_t)row * LDH + nb + ni * 32 + r] = to_bf16(v); }
          ssv[i] = ss;
        }
#pragma unroll
        for (int i = 0; i < 16; ++i) { const float t = red32(ssv[i]); if (r == 0) atomicAdd(ssq + mb + mi * 32 + crow(i, h), t); }
      }
    }
  }
};
struct EpiQraw {
  bf16_t* q; const float* ssq_q;
  template <int MI, int NI> DI void run(f32x16 (&acc)[MI][NI], int mb, int nb, int r, int h) const {
#pragma unroll
    for (int mi = 0; mi < MI; ++mi)
#pragma unroll
      for (int i = 0; i < 16; ++i) {
        const int row = mb + mi * 32 + crow(i, h);
        const float rs = rsqrtf(ssq_q[row] * (1.f / QL) + EPS);
#pragma unroll
        for (int ni = 0; ni < NI; ++ni) q[(size_t)row * 1536 + nb + ni * 32 + r] = to_bf16(acc[mi][ni][i] * rs);
      }
  }
};
struct EpiKV {
  const float* ssq_kv; const float* kpe; const float* gk; const float* cosT; const float* sinT; bf16_t* kout; bf16_t* vt;
  template <int MI, int NI> DI void run(f32x16 (&acc)[MI][NI], int mb, int nb, int r, int h) const {
    static_assert(MI == 1 && NI == 4, "kv epilogue layout");
    const int b = mb / S, sb = mb % S;
    if (nb < 1024) {
      const int head = nb >> 7;
      const float g0 = gk[r], g1 = gk[32 + r], g2 = gk[64 + r], g3 = gk[96 + r], g4 = gk[128 + r], g5 = gk[160 + r];
#pragma unroll
      for (int i = 0; i < 16; ++i) {
        const int rw = crow(i, h), tok = mb + rw;
        const float rkv = rsqrtf(ssq_kv[tok] * (1.f / KVL) + EPS);
        const float v0 = acc[0][0][i] * rkv, v1 = acc[0][1][i] * rkv, v2 = acc[0][2][i] * rkv, v3 = acc[0][3][i] * rkv;
        const float p1 = kpe[(size_t)tok * 64 + r], p2 = kpe[(size_t)tok * 64 + 32 + r];
        float ss = v0 * v0 + v1 * v1 + v2 * v2 + v3 * v3 + p1 * p1 + p2 * p2;
        ss = red32(ss);
        const float rk = rsqrtf(ss * (1.f / QKH) + EPS);
        bf16_t* kr = kout + ((size_t)(b * NH + head) * S + sb + rw) * QKH;
        kr[r] = to_bf16(v0 * rk * g0); kr[32 + r] = to_bf16(v1 * rk * g1); kr[64 + r] = to_bf16(v2 * rk * g2); kr[96 + r] = to_bf16(v3 * rk * g3);
        const float c = cosT[(size_t)tok * 32 + r], sn = sinT[(size_t)tok * 32 + r];
        const float x1 = p1 * rk * g4, x2 = p2 * rk * g5;
        kr[128 + r] = to_bf16(x1 * c - x2 * sn); kr[160 + r] = to_bf16(x2 * c + x1 * sn);
      }
    } else {
      const int head = (nb - 1024) >> 7;
      float rkv[16];
#pragma unroll
      for (int i = 0; i < 16; ++i) rkv[i] = rsqrtf(ssq_kv[mb + crow(i, h)] * (1.f / KVL) + EPS);
#pragma unroll
      for (int ni = 0; ni < 4; ++ni) {
        bf16_t* vr = vt + ((size_t)(b * NH + head) * VH + ni * 32 + r) * SV + sb;
#pragma unroll
        for (int a = 0; a < 4; ++a) {
          u32x2 o;
          o.x = pack_bf16(acc[0][ni][4 * a] * rkv[4 * a], acc[0][ni][4 * a + 1] * rkv[4 * a + 1]);
          o.y = pack_bf16(acc[0][ni][4 * a + 2] * rkv[4 * a + 2], acc[0][ni][4 * a + 3] * rkv[4 * a + 3]);
          *(u32x2*)(vr + 16 * (a >> 1) + 8 * h + 4 * (a & 1)) = o;
        }
      }
    }
  }
};


DI int lds_byte2(int r, int c) { const int st = (r >> 4) * 2 + (c >> 5), ob = (r & 15) * 64 + (c & 31) * 2; return st * 1024 + (ob ^ (((ob >> 9) & 1) << 5)); }
DI void stage_rc2(int b, int& R, int& C) { const int st = b >> 10, sb = b & 1023, swz = sb ^ (((sb >> 9) & 1) << 5); R = (st >> 1) * 16 + swz / 64; C = (st & 1) * 32 + (swz % 64) / 2; }
#define MFMA16(a, b, c) __builtin_amdgcn_mfma_f32_16x16x32_bf16((a), (b), (c), 0, 0, 0)
constexpr int G8_TILE_B = 256 * 64 * 2, G8_STAGE_B = 2 * G8_TILE_B;

template <class Epi>
DI void gemm8_tile(const bf16_t* __restrict__ Ab, int lda, const bf16_t* __restrict__ Bb, int ldb, int K, int brow, int bcol, const Epi epi,
                   bool staged, bool has_next, const bf16_t* __restrict__ Abn, const bf16_t* __restrict__ Bbn) {
  const int tid = opaque_tid512(), wid = tid >> 6, lane = tid & 63, wr = wid >> 2, wc = wid & 3, fr = lane & 15, fq = lane >> 4;
  unsigned aoff[4], boff[4];
#pragma unroll
  for (int i = 0; i < 4; ++i) { int R, C; stage_rc2(wid * 1024 + i * 8192 + lane * 16, R, C); aoff[i] = (unsigned)R * (unsigned)lda + (unsigned)C; boff[i] = (unsigned)R * (unsigned)ldb + (unsigned)C; }
#define G8_STAGE_R(buf_, ap_, bp_, i0_, i1_)                                                                         \
  {                                                                                                                  \
    const bf16_t* ag_ = (ap_); const bf16_t* bg_ = (bp_);                                                            \
    _Pragma("unroll") for (int i = (i0_); i < (i1_); ++i) {                                                          \
      __builtin_amdgcn_global_load_lds((const unsigned*)(ag_ + aoff[i]), (unsigned*)(smem + (buf_) * G8_STAGE_B + wid * 1024 + i * 8192), 16, 0, 0);              \
      __builtin_amdgcn_global_load_lds((const unsigned*)(bg_ + boff[i]), (unsigned*)(smem + (buf_) * G8_STAGE_B + G8_TILE_B + wid * 1024 + i * 8192), 16, 0, 0);  \
    }                                                                                                                \
  }
#define G8_STAGE(buf_, ap_, bp_) G8_STAGE_R(buf_, ap_, bp_, 0, 4)
  f32x4 acc[8][4];
#pragma unroll
  for (int m = 0; m < 8; ++m)
#pragma unroll
    for (int n = 0; n < 4; ++n) acc[m][n] = (f32x4){0.f, 0.f, 0.f, 0.f};
  const int nt = K / 64;
  if (!staged) {
    G8_STAGE(0, Ab, Bb);
    asm volatile("s_waitcnt vmcnt(0)" ::: "memory");
    __syncthreads();
  }
  for (int t = 0; t < nt; ++t) {
    const int cur = t & 1;
    const unsigned char* sa = smem + cur * G8_STAGE_B;
    const unsigned char* sb = sa + G8_TILE_B;
#pragma unroll
    for (int ks = 0; ks < 2; ++ks) {
      bf16x8 At[8], Bf[4];
#pragma unroll
      for (int n = 0; n < 4; ++n) Bf[n] = *(const bf16x8*)(sb + lds_byte2(wc * 64 + n * 16 + fr, ks * 32 + fq * 8));
#pragma unroll
      for (int m = 0; m < 8; ++m) At[m] = *(const bf16x8*)(sa + lds_byte2(wr * 128 + m * 16 + fr, ks * 32 + fq * 8));
      {
        __builtin_amdgcn_sched_barrier(0);
        if (t + 1 < nt) { G8_STAGE_R(cur ^ 1, Ab + (t + 1) * 64, Bb + (t + 1) * 64, 2 * ks, 2 * ks + 2); }
        else if (has_next) { G8_STAGE_R(0, Abn, Bbn, 2 * ks, 2 * ks + 2); }
        __builtin_amdgcn_sched_barrier(0);
      }
#pragma unroll
      for (int m = 0; m < 8; ++m)
#pragma unroll
        for (int n = 0; n < 4; ++n) acc[m][n] = MFMA16(At[m], Bf[n], acc[m][n]);
      __builtin_amdgcn_sched_barrier(0);
    }
    asm volatile("s_waitcnt vmcnt(0)" ::: "memory");
    __syncthreads();
  }
#undef G8_STAGE
#undef G8_STAGE_R
  epi.run8(acc, brow + wr * 128, bcol + wc * 64, fr, fq);
  if (Epi::LDS_SCRATCH) __syncthreads();
}

DI void g8_decode(int u, int x, int nN, int& pm, int& pn) {
  const int ng = u >> 6, rem = u & 63;
  int gn = nN - 4 * ng; if (gn > 4) gn = 4;
  const int mg = rem / (8 * gn), jj = rem % (8 * gn);
  pm = 16 * x + 8 * mg + (jj & 7); pn = 4 * ng + (jj >> 3);
}
template <class Epi>
DI void gemm8_phase(int x, int j, const bf16_t* __restrict__ A, int lda, const bf16_t* __restrict__ Bt, int K, int N, int a_grp, const Epi epi) {
  const int nN = N / 256, nb = gridDim.x >> 3, ldb = K + PADK;
  const int total = 16 * nN;
  bool staged = false;
  for (int u = j; u < total; u += nb) {
    int pm, pn; g8_decode(u, x, nN, pm, pn);
    const int brow = pm * 256, bcol = pn * 256;
    const bf16_t* Ab = A + (size_t)brow * lda + (a_grp ? (bcol / a_grp) * K : 0);
    const bf16_t* Bb = Bt + (size_t)bcol * ldb;
    const bool has_next = (u + nb < total);
    const bf16_t* Abn = Ab; const bf16_t* Bbn = Bb;
    if (has_next) {
      int pm2, pn2; g8_decode(u + nb, x, nN, pm2, pn2);
      Abn = A + (size_t)(pm2 * 256) * lda + (a_grp ? ((pn2 * 256) / a_grp) * K : 0);
      Bbn = Bt + (size_t)(pn2 * 256) * ldb;
    }
    gemm8_tile<Epi>(Ab, lda, Bb, ldb, K, brow, bcol, epi, staged, has_next, Abn, Bbn);
    staged = has_next;
  }
}
DI float red16(float v) { v += __shfl_xor(v, 1); v += __shfl_xor(v, 2); v += __shfl_xor(v, 4); v += __shfl_xor(v, 8); return v; }

struct EpiGU8 {
  static constexpr bool LDS_SCRATCH = true;
  bf16_t* act; const float* ssq;
  DI void run8(f32x4 (&acc)[8][4], int rb, int cb, int fr, int fq) const {
    const int lane = fq * 16 + fr, wid = (int)(threadIdx.x >> 6);
    bf16_t* scr = (bf16_t*)(smem + G8_STAGE_B + wid * 1280);
    const int srow = lane >> 2, sch = lane & 3;
    bf16_t* ap = act + (size_t)(rb + srow) * LDA + (cb >> 1) + sch * 8;
    float rsv[8][4];
#pragma unroll
    for (int m = 0; m < 8; ++m)
#pragma unroll
      for (int j = 0; j < 4; ++j) rsv[m][j] = rsqrtf(ssq[rb + m * 16 + fq * 4 + j] * (1.f / D) + EPS);
#pragma unroll
    for (int m = 0; m < 8; ++m) {
#pragma unroll
      for (int j = 0; j < 4; ++j)
#pragma unroll
        for (int pi = 0; pi < 2; ++pi) {
          const float g = acc[m][2 * pi][j] * rsv[m][j], u = acc[m][2 * pi + 1][j] * rsv[m][j];
          const float a = g * __builtin_amdgcn_rcpf(1.f + __expf(-g)) * u;
          scr[(fq * 4 + j) * 40 + pi * 16 + fr] = to_bf16(a);
        }
      __builtin_amdgcn_sched_barrier(0);
      const u32x4 o = *(const u32x4*)(scr + srow * 40 + sch * 8);
      *(u32x4*)(ap + (size_t)(m * 16) * LDA) = o;
      __builtin_amdgcn_sched_barrier(0);
    }
  }
};
struct EpiResid8 {
  static constexpr bool LDS_SCRATCH = true;
  const float* xin; float* xout; float scale; bf16_t* xb; float* ssq;
  DI void run8(f32x4 (&acc)[8][4], int rb, int cb, int fr, int fq) const {
    const int lane = fq * 16 + fr, wid = (int)(threadIdx.x >> 6);
    const float sc = scale; bf16_t* const xbp = xb; float* const ssqp = ssq;
    float* scr = (float*)(smem + G8_STAGE_B + wid * 4352);
    const int prow = lane >> 4, c4 = lane & 15;
    const float* xp = xin + (size_t)(rb + prow) * D + cb + c4 * 4;
    float* op = xout + (size_t)(rb + prow) * D + cb + c4 * 4;
#pragma unroll
    for (int mh = 0; mh < 2; ++mh) {
      f32x4 xv[4][4];
#pragma unroll
      for (int mm = 0; mm < 4; ++mm)
#pragma unroll
        for (int ps = 0; ps < 4; ++ps) xv[mm][ps] = __builtin_nontemporal_load((const f32x4*)(xp + (size_t)((mh * 4 + mm) * 16 + ps * 4) * D));
      __builtin_amdgcn_sched_barrier(0);
#pragma unroll
      for (int mm = 0; mm < 4; ++mm) {
        const int m = mh * 4 + mm;
#pragma unroll
        for (int n = 0; n < 4; ++n)
#pragma unroll
          for (int j = 0; j < 4; ++j) scr[(fq * 4 + j) * 68 + n * 16 + fr] = acc[m][n][j];
        __builtin_amdgcn_sched_barrier(0);
#pragma unroll
        for (int ps = 0; ps < 4; ++ps) {
          const f32x4 a = *(const f32x4*)(scr + (ps * 4 + prow) * 68 + c4 * 4);
          f32x4 v;
          v.x = xv[mm][ps].x + a.x * sc; v.y = xv[mm][ps].y + a.y * sc; v.z = xv[mm][ps].z + a.z * sc; v.w = xv[mm][ps].w + a.w * sc;
          const int grow = rb + m * 16 + ps * 4 + prow;
          __builtin_nontemporal_store(v, (f32x4*)(op + (size_t)(m * 16 + ps * 4) * D));
          if (xbp) {
            u32x2 o; o.x = pack_bf16(v.x, v.y); o.y = pack_bf16(v.z, v.w);
            *(u32x2*)(xbp + (size_t)grow * LDH + cb + c4 * 4) = o;
            const float t = red16(v.x * v.x + v.y * v.y + v.z * v.z + v.w * v.w);
            if (c4 == 0) atomicAdd(ssqp + grow, t);
          }
        }
        __builtin_amdgcn_sched_barrier(0);
      }
    }
  }
};
struct EpiLat8 {
  static constexpr bool LDS_SCRATCH = false;
  bf16_t* lat; float* kpe; float* ssq_q; float* ssq_kv; const float* ssq_x;
  DI void run8(f32x4 (&acc)[8][4], int rb, int cb, int fr, int fq) const {
    if (cb >= 1088) return;
    float* ssq = (cb < QL) ? ssq_q : ssq_kv;
#pragma unroll
    for (int mp = 0; mp < 2; ++mp) {
      float rsv[4][4];
#pragma unroll
      for (int mm = 0; mm < 4; ++mm)
#pragma unroll
        for (int j = 0; j < 4; ++j) rsv[mm][j] = rsqrtf(ssq_x[rb + (4 * mp + mm) * 16 + fq * 4 + j] * (1.f / D) + EPS);
      __builtin_amdgcn_sched_barrier(0);
#pragma unroll
      for (int mm = 0; mm < 4; ++mm) {
        float ssv[4];
#pragma unroll
        for (int j = 0; j < 4; ++j) {
          const int row = rb + (4 * mp + mm) * 16 + fq * 4 + j;
          float ss = 0.f;
#pragma unroll
          for (int n = 0; n < 4; ++n) {
            const float v = acc[4 * mp + mm][n][j] * rsv[mm][j];
            if (cb >= 1024) kpe[(size_t)row * 64 + (cb - 1024) + n * 16 + fr] = v;
            else { lat[(size_t)row * LDH + cb + n * 16 + fr] = to_bf16(v); ss += v * v; }
          }
          ssv[j] = ss;
        }
        if (cb < 1024) {
#pragma unroll
          for (int j = 0; j < 4; ++j) { const float t = red16(ssv[j]); if (fr == 0) atomicAdd(ssq + rb + (4 * mp + mm) * 16 + fq * 4 + j, t); }
        }
      }
    }
  }
};
struct EpiQraw8 {
  static constexpr bool LDS_SCRATCH = false;
  bf16_t* q; const float* ssq_q;
  DI void run8(f32x4 (&acc)[8][4], int rb, int cb, int fr, int fq) const {
#pragma unroll
    for (int m = 0; m < 8; ++m)
#pragma unroll
      for (int j = 0; j < 4; ++j) {
        const int row = rb + m * 16 + fq * 4 + j;
        const float rs = rsqrtf(ssq_q[row] * (1.f / QL) + EPS);
#pragma unroll
        for (int n = 0; n < 4; ++n) q[(size_t)row * 1536 + cb + n * 16 + fr] = to_bf16(acc[m][n][j] * rs);
      }
  }
};

DI void norm0_phase(const float* __restrict__ x, bf16_t* __restrict__ hb, float* __restrict__ ssq) {
  const int tid = opaque_tid512();
  const int lane = tid & 63, gw = blockIdx.x * 8 + (tid >> 6), nw = gridDim.x * 8;
  for (int row = gw; row < T; row += nw) {
    const f32x4* xr = (const f32x4*)(x + (size_t)row * D);
    f32x4 v[4];
    float ss = 0.f;
#pragma unroll
    for (int c = 0; c < 4; ++c) { v[c] = __builtin_nontemporal_load(xr + c * 64 + lane); ss += v[c].x * v[c].x + v[c].y * v[c].y + v[c].z * v[c].z + v[c].w * v[c].w; }
    ss = red64(ss);
    if (lane == 0) ssq[row] = ss;
#pragma unroll
    for (int c = 0; c < 4; ++c) {
      u32x2 o; o.x = pack_bf16(v[c].x, v[c].y); o.y = pack_bf16(v[c].z, v[c].w);
      *(u32x2*)(hb + (size_t)row * LDH + (c * 64 + lane) * 4) = o;
    }
  }
}

template <int W>
DI void pool_rows(const float* __restrict__ x, const float* smr, bf16_t* __restrict__ pb, int t0, int s0, int tid) {
  const int tq0 = t0 - s0;
  const float* xq = x + tid * 4;
  f32x4 Sm = {0.f, 0.f, 0.f, 0.f};
#pragma unroll
  for (int i = 1; i < W; ++i) {
    int t = t0 - i; if (t < tq0) t = tq0;
    Sm += *(const f32x4*)(xq + (size_t)t * D) * smr[15 - i];
  }
#pragma unroll 8
  for (int tl = 0; tl < 64; ++tl) {
    const int t = t0 + tl, s = s0 + tl;
    int to = t - W + 1; if (to < tq0) to = tq0;
    const f32x4 hn = *(const f32x4*)(xq + (size_t)t * D) * smr[15 + tl];
    const f32x4 ho = *(const f32x4*)(xq + (size_t)to * D) * smr[15 + tl - W + 1];
    const int cnt = (s + 1 < W) ? (s + 1) : W;
    const float ic = 1.f / (float)cnt;
    Sm += hn;
    const f32x4 p = Sm * ic - hn;
    Sm -= ho;
    u32x2 o; o.x = pack_bf16(p.x, p.y); o.y = pack_bf16(p.z, p.w);
    *(u32x2*)(pb + (size_t)t * LDH + tid * 4) = o;
  }
}
DI void poolprep_phase(int vb, int nvb, const float* __restrict__ x, const float* __restrict__ ssq, bf16_t* __restrict__ pb, float* smf) {
  const int tid = opaque_tid(), wave = tid >> 6;
  for (int c0 = 0; c0 < T / 64; c0 += nvb) {
    const int ch = c0 + vb;
    const bool on = ch < T / 64;
    const int t0 = ch * 64, s0 = t0 & (S - 1);
    if (on && tid < 79) smf[tid] = (s0 + tid >= 15) ? rsqrtf(ssq[t0 - 15 + tid] * (1.f / D) + EPS) : 0.f;
    __syncthreads();
    if (on) {
      if (wave == 0) pool_rows<2>(x, smf, pb, t0, s0, tid);
      else if (wave == 1) pool_rows<4>(x, smf, pb, t0, s0, tid);
      else if (wave == 2) pool_rows<8>(x, smf, pb, t0, s0, tid);
      else pool_rows<16>(x, smf, pb, t0, s0, tid);
    }
    __syncthreads();
  }
}

constexpr int KLS = QKH + 8;
constexpr int VLS = 64 + 8;
constexpr int K_EL = 64 * KLS;
constexpr int ATT_STG_EL = K_EL + 128 * VLS;

DI void attn_phase(const bf16_t* __restrict__ qraw, const bf16_t* __restrict__ kbuf, const bf16_t* __restrict__ vtb, bf16_t* __restrict__ obuf,
                   const float* __restrict__ gq, const float* __restrict__ cosT, const float* __restrict__ sinT, bf16_t* sm, int x, int j) {
  const int nb = gridDim.x >> 3;
  for (int p = j; p < 64; p += nb) {
    const int bh = 2 * x + (p >> 5);
    const int b = bh >> 3, hd = bh & 7;
    for (int half = 0; half < 2; ++half) {
      const int tid = opaque_tid512(), lane = tid & 63, wave = tid >> 6, r = lane & 31, h = lane >> 5;
      const int qb = half ? (p & 31) : (63 - (p & 31));
      const int q0 = qb * 256 + wave * 32;
      const size_t tok = (size_t)b * S + q0 + r;
      bf16x8 qf[12];
      {
        const bf16_t* qp = qraw + tok * 1536 + hd * QKH + h * 8;
#pragma unroll
        for (int st = 0; st < 12; ++st) qf[st] = *(const bf16x8*)(qp + st * 16);
        float ss = 0.f;
#pragma unroll
        for (int st = 0; st < 12; ++st) {
#pragma unroll
          for (int e = 0; e < 8; ++e) { const float f = bf2f(qf[st][e]); ss += f * f; }
          u32x4 t = __builtin_bit_cast(u32x4, qf[st]);
          asm volatile("" : "+v"(t));
          qf[st] = __builtin_bit_cast(bf16x8, t);
        }
        ss += __shfl_xor(ss, 32);
        const float rq = rsqrtf(ss * (1.f / QKH) + EPS) * (0.07216878364870322f * 1.4426950408889634f);
        __builtin_amdgcn_sched_barrier(0);
#pragma unroll
        for (int st = 0; st < 8; ++st) {
          const f32x4 ga = *(const f32x4*)(gq + st * 16 + h * 8), gb = *(const f32x4*)(gq + st * 16 + h * 8 + 4);
          u32x4 o;
          o.x = pack_bf16(bf2f(qf[st][0]) * rq * ga.x, bf2f(qf[st][1]) * rq * ga.y);
          o.y = pack_bf16(bf2f(qf[st][2]) * rq * ga.z, bf2f(qf[st][3]) * rq * ga.w);
          o.z = pack_bf16(bf2f(qf[st][4]) * rq * gb.x, bf2f(qf[st][5]) * rq * gb.y);
          o.w = pack_bf16(bf2f(qf[st][6]) * rq * gb.z, bf2f(qf[st][7]) * rq * gb.w);
          asm volatile("" : "+v"(o));
          qf[st] = __builtin_bit_cast(bf16x8, o);
          __builtin_amdgcn_sched_barrier(0);
        }
#pragma unroll
        for (int st = 8; st < 10; ++st) {
          const int jb = (st - 8) * 16 + h * 8;
          u32x4 o1, o2;
#pragma unroll
          for (int hf = 0; hf < 2; ++hf) {
            const f32x4 g1 = *(const f32x4*)(gq + 128 + jb + 4 * hf), g2 = *(const f32x4*)(gq + 160 + jb + 4 * hf);
            const f32x4 cc = *(const f32x4*)(cosT + tok * 32 + jb + 4 * hf), sn = *(const f32x4*)(sinT + tok * 32 + jb + 4 * hf);
            float y1[4], y2[4];
#pragma unroll
            for (int e = 0; e < 4; ++e) {
              const float x1 = bf2f(qf[st][4 * hf + e]) * rq * g1[e], x2 = bf2f(qf[st + 2][4 * hf + e]) * rq * g2[e];
              y1[e] = x1 * cc[e] - x2 * sn[e]; y2[e] = x2 * cc[e] + x1 * sn[e];
            }
            if (hf == 0) { o1.x = pack_bf16(y1[0], y1[1]); o1.y = pack_bf16(y1[2], y1[3]); o2.x = pack_bf16(y2[0], y2[1]); o2.y = pack_bf16(y2[2], y2[3]); }
            else { o1.z = pack_bf16(y1[0], y1[1]); o1.w = pack_bf16(y1[2], y1[3]); o2.z = pack_bf16(y2[0], y2[1]); o2.w = pack_bf16(y2[2], y2[3]); }
          }
          asm volatile("" : "+v"(o1), "+v"(o2));
          qf[st] = __builtin_bit_cast(bf16x8, o1); qf[st + 2] = __builtin_bit_cast(bf16x8, o2);
          __builtin_amdgcn_sched_barrier(0);
        }
      }
      f32x16 oacc[4];
#pragma unroll
      for (int mt = 0; mt < 4; ++mt)
#pragma unroll
        for (int i = 0; i < 16; ++i) oacc[mt][i] = 0.f;
      float m_run = -1e30f, l_run = 0.f;
      const int nkt = 4 * qb + 4;
      const bf16_t* kg = kbuf + (size_t)bh * S * QKH;
      const bf16_t* vg = vtb + (size_t)bh * VH * SV;
      u32x4 rk[3], rv[2];
      const unsigned kg_off0 = (unsigned)(tid >> 3) * QKH + (unsigned)(tid & 7) * 8u;
      const unsigned vg_off0 = (unsigned)(tid >> 3) * (unsigned)SV + (unsigned)(tid & 7) * 8u;
      const unsigned kl_off = (unsigned)(tid >> 3) * KLS + (unsigned)(tid & 7) * 8u;
      const unsigned vl_off = (unsigned)(tid >> 3) * VLS + (unsigned)(tid & 7) * 8u;
#define ALOAD(kt_)                                                                                                     \
  {                                                                                                                    \
    const bf16_t* kgt_ = kg + (size_t)(kt_) * 64 * QKH; const bf16_t* vgt_ = vg + (kt_) * 64;                          \
    unsigned kg_off = kg_off0, vg_off = vg_off0; asm volatile("" : "+v"(kg_off), "+v"(vg_off));                        \
    _Pragma("unroll") for (int i = 0; i < 3; ++i) rk[i] = *(const u32x4*)(kgt_ + (kg_off + (unsigned)(i * 64)));       \
    _Pragma("unroll") for (int i = 0; i < 2; ++i) rv[i] = *(const u32x4*)(vgt_ + (vg_off + (unsigned)(i * 64) * (unsigned)SV)); \
  }
      ALOAD(0);
#define ASTORE(stg_)                                                                                                   \
  {                                                                                                                    \
    bf16_t* sk_ = sm + (stg_) * ATT_STG_EL; bf16_t* sv_ = sk_ + K_EL;                                                  \
    _Pragma("unroll") for (int i = 0; i < 3; ++i) *(u32x4*)(sk_ + kl_off + i * 64) = rk[i];                            \
    _Pragma("unroll") for (int i = 0; i < 2; ++i) *(u32x4*)(sv_ + vl_off + i * 64 * VLS) = rv[i];                      \
  }
      ASTORE(0);
      __syncthreads();
      for (int kt = 0; kt < nkt; ++kt) {
        const bf16_t* smk = sm + (kt & 1) * ATT_STG_EL;
        const bf16_t* smv = smk + K_EL;
        const bool act_tile = (kt * 64 <= q0 + 31);
        if (!act_tile && kt + 1 < nkt) ALOAD(kt + 1);
        __builtin_amdgcn_sched_barrier(0);
        if (act_tile) {
        f32x16 sacc[2];
#pragma unroll
        for (int mt = 0; mt < 2; ++mt)
#pragma unroll
          for (int i = 0; i < 16; ++i) sacc[mt][i] = 0.f;
        const bf16_t* kp = smk + r * KLS + h * 8;
        {
          bf16x8 ka = *(const bf16x8*)(kp), kb = *(const bf16x8*)(kp + 32 * KLS);
          __builtin_amdgcn_sched_barrier(0);
          if (kt + 1 < nkt) ALOAD(kt + 1);
          __builtin_amdgcn_sched_barrier(0);
#pragma unroll
          for (int st = 0; st < 12; ++st) {
            bf16x8 na = ka, nbq = kb;
            if (st + 1 < 12) { na = *(const bf16x8*)(kp + (st + 1) * 16); nbq = *(const bf16x8*)(kp + 32 * KLS + (st + 1) * 16); }
            sacc[0] = MFMA(ka, qf[st], sacc[0]);
            sacc[1] = MFMA(kb, qf[st], sacc[1]);
            ka = na; kb = nbq;
            __builtin_amdgcn_sched_barrier(0);
          }
        }
        bf16x8 va[2][4];
        {
          const bf16_t* vp0 = smv + r * VLS + h * 8;
#pragma unroll
          for (int mt = 0; mt < 4; ++mt) va[0][mt] = *(const bf16x8*)(vp0 + mt * 32 * VLS);
        }
        if (kt * 64 + 63 > q0) {
          const int qpos = q0 + r;
#pragma unroll
          for (int mt = 0; mt < 2; ++mt)
#pragma unroll
            for (int i = 0; i < 16; ++i) { const int key = kt * 64 + mt * 32 + crow(i, h); if (key > qpos) sacc[mt][i] = -INFINITY; }
        }
        float mx = sacc[0][0];
#pragma unroll
        for (int mt = 0; mt < 2; ++mt)
#pragma unroll
          for (int i = 0; i < 16; ++i) mx = fmaxf(mx, sacc[mt][i]);
        mx = xmax32(mx);
        const float m_new = fmaxf(m_run, mx);
        const float alpha = __builtin_amdgcn_exp2f(m_run - m_new);
        m_run = m_new;
        float rs = 0.f;
#pragma unroll
        for (int mt = 0; mt < 2; ++mt)
#pragma unroll
          for (int i = 0; i < 16; ++i) { const float pv = __builtin_amdgcn_exp2f(sacc[mt][i] - m_new); sacc[mt][i] = pv; rs += pv; }
        rs = xsum32(rs);
        l_run = l_run * alpha + rs;
        if (__any(alpha != 1.f)) {
#pragma unroll
          for (int mt = 0; mt < 4; ++mt)
#pragma unroll
            for (int i = 0; i < 16; ++i) oacc[mt][i] *= alpha;
        }
        bf16x8 pf[4];
#pragma unroll
        for (int ks = 0; ks < 4; ++ks) {
          u32x4 o;
          o.x = pack_bf16(sacc[ks >> 1][8 * (ks & 1) + 0], sacc[ks >> 1][8 * (ks & 1) + 1]);
          o.y = pack_bf16(sacc[ks >> 1][8 * (ks & 1) + 2], sacc[ks >> 1][8 * (ks & 1) + 3]);
          o.z = pack_bf16(sacc[ks >> 1][8 * (ks & 1) + 4], sacc[ks >> 1][8 * (ks & 1) + 5]);
          o.w = pack_bf16(sacc[ks >> 1][8 * (ks & 1) + 6], sacc[ks >> 1][8 * (ks & 1) + 7]);
          pf[ks] = __builtin_bit_cast(bf16x8, o);
        }
        const bf16_t* vp = smv + r * VLS + h * 8;
        __builtin_amdgcn_sched_barrier(0);
        {
#pragma unroll
          for (int ks = 0; ks < 4; ++ks) {
            if (ks + 1 < 4) {
#pragma unroll
              for (int mt = 0; mt < 4; ++mt) va[(ks + 1) & 1][mt] = *(const bf16x8*)(vp + mt * 32 * VLS + (ks + 1) * 16);
            }
#pragma unroll
            for (int mt = 0; mt < 4; ++mt) oacc[mt] = MFMA(va[ks & 1][mt], pf[ks], oacc[mt]);
            __builtin_amdgcn_sched_barrier(0);
          }
        }
        }
        if (kt + 1 < nkt) ASTORE((kt + 1) & 1);
        __syncthreads();
      }
#undef ALOAD
#undef ASTORE
      const float inv = 1.f / l_run;
      bf16_t* op = obuf + tok * LDH + hd * VH + 4 * h;
#pragma unroll
      for (int mt = 0; mt < 4; ++mt)
#pragma unroll
        for (int a = 0; a < 4; ++a) {
          u32x2 o;
          o.x = pack_bf16(oacc[mt][4 * a] * inv, oacc[mt][4 * a + 1] * inv);
          o.y = pack_bf16(oacc[mt][4 * a + 2] * inv, oacc[mt][4 * a + 3] * inv);
          *(u32x2*)(op + mt * 32 + 8 * a) = o;
        }
      __syncthreads();
    }
  }
}

typedef Cfg<4, 1, 1, 4, 64, 1> CR;

__global__ void __launch_bounds__(512, 2) fwd_megakernel(Params p) {
  cg::grid_group grid = cg::this_grid();
  unsigned char* ws = p.ws;
  const float* x_in = p.in[0];
  const int* positions = (const int*)p.in[1];
  float* out = p.out;
  bf16_t* wgu1 = (bf16_t*)(ws + OFF_WGU1); bf16_t* wdn1 = (bf16_t*)(ws + OFF_WDN1);
  bf16_t* wgu2 = (bf16_t*)(ws + OFF_WGU2); bf16_t* wdn2 = (bf16_t*)(ws + OFF_WDN2);
  bf16_t* wpool = (bf16_t*)(ws + OFF_WPOOL); bf16_t* win = (bf16_t*)(ws + OFF_WIN); bf16_t* wq = (bf16_t*)(ws + OFF_WQ);
  bf16_t* wkv = (bf16_t*)(ws + OFF_WKV); bf16_t* wout = (bf16_t*)(ws + OFF_WOUT);
  float* cosT = (float*)(ws + OFF_COS); float* sinT = (float*)(ws + OFF_SIN);
  float* ssq_all = (float*)(ws + OFF_SSQ);
  float* kpe = (float*)(ws + OFF_KPE);
  bf16_t* hb = (bf16_t*)(ws + OFF_HB);
  bf16_t* act = (bf16_t*)(ws + OFF_ACT); bf16_t* lat = (bf16_t*)(ws + OFF_LAT); bf16_t* qraw = (bf16_t*)(ws + OFF_QRAW);
  bf16_t* kbuf = (bf16_t*)(ws + OFF_K); bf16_t* vtb = (bf16_t*)(ws + OFF_VT);
  bf16_t* obuf = lat; bf16_t* pooled = (bf16_t*)(ws + OFF_POOLED);
  const int gt = blockIdx.x * 512 + threadIdx.x, gs = gridDim.x * 512;
  const int vhalf = __builtin_amdgcn_readfirstlane((int)(threadIdx.x >> 8));
  const int vb = blockIdx.x * 2 + vhalf, nvb = gridDim.x * 2;
  bf16_t* smh = (bf16_t*)(smem + vhalf * VHALF_BYTES);
  float* smf = (float*)(smem + vhalf * VHALF_BYTES);

  unsigned* ctl = (unsigned*)(ws + OFF_CTL);
  if (threadIdx.x == 0) {
    const unsigned xcc = (unsigned)__builtin_amdgcn_s_getreg((3 << 11) | 20) & 0x7u;
    const unsigned rank = atomicAdd(ctl + xcc, 1u);
    ((volatile int*)smem)[0] = (int)xcc; ((volatile int*)smem)[1] = (int)rank;
  }
  __syncthreads();
  int xs = __builtin_amdgcn_readfirstlane(((volatile int*)smem)[0]);
  int js = __builtin_amdgcn_readfirstlane(((volatile int*)smem)[1]);
  __syncthreads();

  for (int idx = gt; idx < T * 32; idx += gs) {
    const int t = idx >> 5, jf = idx & 31;
    const float inv_freq = exp2f(-(float)jf * 0.41524101186092029f);
    const float ang = (float)positions[t] * inv_freq;
    const double rev = (double)ang * 0.15915494309189535;
    const float fr = (float)(rev - rint(rev));
    cosT[idx] = __builtin_amdgcn_cosf(fr);
    sinT[idx] = __builtin_amdgcn_sinf(fr);
  }
  for (int i = gt; i < 15 * T; i += gs) ssq_all[T + i] = 0.f;
  norm0_phase(x_in, hb, ssq_all);
  for (int jl = 0; jl < 2; ++jl) {
    for (int g = 0; g < 4; ++g)
      prep_w(vb, nvb, p.in[7] + ((size_t)jl * 4 + g) * 65536, wpool + ((size_t)jl * 4 + g) * 256 * (256 + PADK), 256, 256, p.in[6] + (size_t)(2 * jl) * D + g * 256, p.in[8] + (size_t)jl * D + g * 256, 0, smf);
    prep_w(vb, nvb, p.in[9] + (size_t)jl * D * 1088, win + (size_t)jl * LATNP * (D + PADK), D, 1088, p.in[6] + (size_t)(2 * jl + 1) * D, nullptr, 0, smf);
    for (int i = gt; i < (LATNP - 1088) * (D + PADK) / 8; i += gs) ((u32x4*)(win + (size_t)jl * LATNP * (D + PADK) + (size_t)1088 * (D + PADK)))[i] = (u32x4){0u, 0u, 0u, 0u};
    prep_w(vb, nvb, p.in[11] + (size_t)jl * QL * 1536, wq + (size_t)jl * 1536 * (QL + PADK), QL, 1536, p.in[10] + (size_t)jl * QL, nullptr, 0, smf);
    prep_w(vb, nvb, p.in[13] + (size_t)jl * KVL * 2048, wkv + (size_t)jl * 2048 * (KVL + PADK), KVL, 2048, p.in[12] + (size_t)jl * KVL, nullptr, 3, smf);
    prep_w(vb, nvb, p.in[16] + (size_t)jl * D * D, wout + (size_t)jl * D * (D + PADK), D, D, nullptr, nullptr, 0, smf);
  }
#define PREP_FFN1(L_) { const size_t wo_ = (size_t)(L_) * D * FF; \
    prep_w(vb, nvb, p.in[3] + wo_, wgu1, D, FF, p.in[2] + (size_t)(L_) * D, nullptr, 1, smf); \
    prep_w(vb, nvb, p.in[4] + wo_, wgu1, D, FF, p.in[2] + (size_t)(L_) * D, nullptr, 2, smf); \
    prep_w(vb, nvb, p.in[5] + wo_, wdn1, FF, D, nullptr, nullptr, 0, smf); }
#define PREP_FFN2(L_) { const size_t wo_ = (size_t)(L_) * D * FF; \
    prep_w(vb, nvb, p.in[18] + wo_, wgu2, D, FF, p.in[17] + (size_t)(L_) * D, nullptr, 1, smf); \
    prep_w(vb, nvb, p.in[19] + wo_, wgu2, D, FF, p.in[17] + (size_t)(L_) * D, nullptr, 2, smf); \
    prep_w(vb, nvb, p.in[20] + wo_, wdn2, FF, D, nullptr, nullptr, 0, smf); }
  PREP_FFN1(0);
  PREP_FFN2(0);
  grid.sync();
  {
    bool even = true;
    for (int i = 0; i < 8; ++i) even = even && (__hip_atomic_load(ctl + i, __ATOMIC_RELAXED, __HIP_MEMORY_SCOPE_AGENT) == (gridDim.x >> 3));
    if (!even || js >= (int)(gridDim.x >> 3)) { xs = blockIdx.x & 7; js = blockIdx.x >> 3; }
  }
  unsigned bar_target = 0;
#define GBAR() { bar_target += gridDim.x; grid_bar(ctl + 32, bar_target); }
  unsigned xbar_target = 0;
#define XBAR() { xbar_target += (gridDim.x >> 3); grid_bar(ctl + 48 + xs, xbar_target); }
  const int jv = js * 2 + vhalf, nbv = (int)(gridDim.x >> 3) * 2;

  for (int layer = 0; layer < DEPTH; ++layer) {
    const float* xcur = (layer == 0) ? x_in : out;
    float* ssq0 = ssq_all + (size_t)(layer * 3 + 0) * T;
    float* ssq1 = ssq_all + (size_t)(layer * 3 + 1) * T;
    float* ssq2 = ssq_all + (size_t)(layer * 3 + 2) * T;
    float* ssq_next = ssq_all + (size_t)((layer + 1) * 3) * T;
    const int jl = layer >> 1;
    float* ssq_q = ssq_all + (size_t)(12 + jl) * T;
    float* ssq_kv = ssq_all + (size_t)(14 + jl) * T;
    if (layer > 0) PREP_FFN2(layer);
    gemm8_phase(xs, js, hb, LDH, wgu1, D, 2 * FF, 0, EpiGU8{act, ssq0});
    XBAR();
    gemm8_phase(xs, js, act, LDA, wdn1, FF, D, 0, EpiResid8{xcur, out, 0.5f, hb, ssq1});
    GBAR();
    if (layer + 1 < DEPTH) PREP_FFN1(layer + 1);
    if ((layer & 1) == 0) {
      poolprep_phase(vb, nvb, out, ssq1, pooled, smf);
      GBAR();
      gemm8_phase(xs, js, pooled, LDH, wpool + (size_t)jl * 1024 * (256 + PADK), 256, D, 256, EpiResid8{out, out, 1.0f, hb, ssq2});
      GBAR();
    } else {
      gemm8_phase(xs, js, hb, LDH, win + (size_t)jl * LATNP * (D + PADK), D, LATNP, 0, EpiLat8{lat, kpe, ssq_q, ssq_kv, ssq1});
      GBAR();
      gemm8_phase(xs, js, lat, LDH, wq + (size_t)jl * 1536 * (QL + PADK), QL, 1536, 0, EpiQraw8{qraw, ssq_q});
      gemm_phase<CR>(xs, jv, nbv, lat + QL, LDH, wkv + (size_t)jl * 2048 * (KVL + PADK), KVL, 2048, 0, EpiKV{ssq_kv, kpe, p.in[15] + (size_t)jl * QKH, cosT, sinT, kbuf, vtb}, smh);
      GBAR();
      attn_phase(qraw, kbuf, vtb, obuf, p.in[14] + (size_t)jl * QKH, cosT, sinT, (bf16_t*)smem, xs, js);
      GBAR();
      gemm8_phase(xs, js, obuf, LDH, wout + (size_t)jl * D * (D + PADK), D, D, 0, EpiResid8{out, out, 1.0f, hb, ssq2});
      GBAR();
    }
    gemm8_phase(xs, js, hb, LDH, wgu2, D, 2 * FF, 0, EpiGU8{act, ssq2});
    XBAR();
    const bool last = (layer + 1 == DEPTH);
    gemm8_phase(xs, js, act, LDA, wdn2, FF, D, 0, EpiResid8{out, out, 0.5f, last ? nullptr : hb, last ? nullptr : ssq_next});
    if (!last) GBAR();
  }
}

extern "C" void kernel_launch(void* const* d_in, const int* in_sizes, int n_in, void* d_out, int out_size, void* d_ws, size_t ws_size, hipStream_t stream) {
  static int grid_blocks = 0;
  if (!grid_blocks) {
    int dev = 0, cus = 0, per_cu = 0;
    (void)hipGetDevice(&dev);
    (void)hipDeviceGetAttribute(&cus, hipDeviceAttributeMultiprocessorCount, dev);
    (void)hipFuncSetAttribute((const void*)fwd_megakernel, hipFuncAttributeMaxDynamicSharedMemorySize, LDS_BYTES);
    (void)hipOccupancyMaxActiveBlocksPerMultiprocessor(&per_cu, fwd_megakernel, 512, LDS_BYTES);
    grid_blocks = cus;
    if (n_in != 21 || out_size != T * D || ws_size < WS_TOTAL || per_cu < 1) fprintf(stderr, "kernel_launch: unexpected n_in=%d out=%d ws=%zu (need %zu) per_cu=%d\n", n_in, out_size, ws_size, (size_t)WS_TOTAL, per_cu);
  }
  Params p{};
  for (int i = 0; i < 21; ++i) p.in[i] = (const float*)d_in[i];
  p.out = (float*)d_out; p.ws = (unsigned char*)d_ws;
  (void)hipMemsetAsync((unsigned char*)d_ws + OFF_CTL, 0, 256, stream);
  void* args[] = {&p};
  hipError_t e = hipLaunchCooperativeKernel((void*)fwd_megakernel, dim3(grid_blocks), dim3(512), args, LDS_BYTES, stream);
  if (e != hipSuccess) fprintf(stderr, "cooperative launch failed: %s (grid %d)\n", hipGetErrorString(e), grid_blocks);
}
```

```cpp
#include <hip/hip_runtime.h>
#include <hip/hip_cooperative_groups.h>
#include <cstdio>
#include <cstdint>
namespace cg = cooperative_groups;

#define DI __device__ __forceinline__
typedef unsigned short bf16_t;
typedef short bf16x8 __attribute__((ext_vector_type(8)));
typedef float f32x16 __attribute__((ext_vector_type(16)));
typedef float f32x4 __attribute__((ext_vector_type(4)));
typedef float f32x2 __attribute__((ext_vector_type(2)));
typedef unsigned u32x4 __attribute__((ext_vector_type(4)));
typedef unsigned u32x2 __attribute__((ext_vector_type(2)));
typedef __bf16 bf16v2 __attribute__((ext_vector_type(2)));

constexpr int NB = 2, S = 16384, T = NB * S, D = 1024, FF = 2816, NH = 8, DEPTH = 4;
constexpr int QL = 768, KVL = 256, QKH = 192, VH = 128;
constexpr int LATNP = 1280;
constexpr int LDH = D + 64;
constexpr int LDA = FF + 64;
constexpr int SV = S + 64;
constexpr int PADK = 64;
constexpr float EPS = 1e-6f;

constexpr size_t SZ_WGU = (size_t)2 * FF * (D + PADK) * 2, SZ_WDN = (size_t)D * (FF + PADK) * 2;
constexpr size_t OFF_WGU1 = 0, OFF_WDN1 = OFF_WGU1 + SZ_WGU, OFF_WGU2 = OFF_WDN1 + SZ_WDN, OFF_WDN2 = OFF_WGU2 + SZ_WGU;
constexpr size_t SZ_WPOOL = (size_t)1024 * (256 + PADK) * 2, SZ_WIN = (size_t)LATNP * (D + PADK) * 2, SZ_WQ = (size_t)1536 * (QL + PADK) * 2;
constexpr size_t SZ_WKV = (size_t)2048 * (KVL + PADK) * 2, SZ_WOUT = (size_t)D * (D + PADK) * 2;
constexpr size_t OFF_WPOOL = OFF_WDN2 + SZ_WDN;
constexpr size_t OFF_WIN = OFF_WPOOL + 2 * SZ_WPOOL;
constexpr size_t OFF_WQ = OFF_WIN + 2 * SZ_WIN;
constexpr size_t OFF_WKV = OFF_WQ + 2 * SZ_WQ;
constexpr size_t OFF_WOUT = OFF_WKV + 2 * SZ_WKV;
constexpr size_t OFF_COS = OFF_WOUT + 2 * SZ_WOUT;
constexpr size_t OFF_SIN = OFF_COS + (size_t)T * 32 * 4;
constexpr size_t OFF_SSQ = OFF_SIN + (size_t)T * 32 * 4;
constexpr size_t OFF_KPE = OFF_SSQ + (size_t)16 * T * 4;
constexpr size_t OFF_HB = OFF_KPE + (size_t)T * 64 * 4;
constexpr size_t OFF_BIG = OFF_HB + (size_t)T * LDH * 2;
constexpr size_t OFF_ACT = OFF_BIG;
constexpr size_t OFF_LAT = OFF_BIG;
constexpr size_t OFF_POOLED = OFF_BIG;
constexpr size_t OFF_QRAW = OFF_LAT + (size_t)T * LDH * 2;
constexpr size_t OFF_K = OFF_QRAW + (size_t)T * 1536 * 2;
constexpr size_t OFF_VT = OFF_K + (size_t)T * NH * QKH * 2;
constexpr size_t WS_END = OFF_VT + (size_t)NB * NH * VH * SV * 2;
static_assert(OFF_ACT + (size_t)T * LDA * 2 <= WS_END, "act must fit in the big region");
constexpr size_t OFF_CTL = WS_END;
constexpr size_t WS_TOTAL = OFF_CTL + 256;
static_assert(WS_TOTAL <= (size_t)536870912, "workspace budget (4 x largest tensor)");
constexpr int LDS_BYTES = 131072;
constexpr int VHALF_BYTES = 36864;

struct Params { const float* in[21]; float* out; unsigned char* ws; };
extern __shared__ __attribute__((aligned(1024))) unsigned char smem[];

DI unsigned pack_bf16(float lo, float hi) { f32x2 v = {lo, hi}; bf16v2 b = __builtin_convertvector(v, bf16v2); return __builtin_bit_cast(unsigned, b); }
DI bf16_t to_bf16(float x) { return (bf16_t)(pack_bf16(x, 0.f) & 0xffffu); }
DI float bf2f(short v) { return __uint_as_float(((unsigned)(unsigned short)v) << 16); }
DI int crow(int i, int h) { return (i & 3) + 8 * (i >> 2) + 4 * h; }
DI float red32(float v) { v += __shfl_xor(v, 1); v += __shfl_xor(v, 2); v += __shfl_xor(v, 4); v += __shfl_xor(v, 8); v += __shfl_xor(v, 16); return v; }
DI float red64(float v) { v = red32(v); v += __shfl_xor(v, 32); return v; }
DI float xmax32(float v) { const u32x2 r = __builtin_amdgcn_permlane32_swap(__float_as_uint(v), __float_as_uint(v), false, false); return fmaxf(__uint_as_float(r.x), __uint_as_float(r.y)); }
DI float xsum32(float v) { const u32x2 r = __builtin_amdgcn_permlane32_swap(__float_as_uint(v), __float_as_uint(v), false, false); return __uint_as_float(r.x) + __uint_as_float(r.y); }
DI int opaque_tid() { int t = threadIdx.x & 255; asm volatile("" : "+v"(t)); return t; }
DI int opaque_tid512() { int t = threadIdx.x; asm volatile("" : "+v"(t)); return t; }
#define MFMA(a, b, c) __builtin_amdgcn_mfma_f32_32x32x16_bf16((a), (b), (c), 0, 0, 0)
DI void grid_bar(unsigned* ctr, unsigned target) {
  asm volatile("s_waitcnt vmcnt(0)" ::: "memory");
  __syncthreads();
  if (threadIdx.x == 0) {
    __builtin_amdgcn_fence(__ATOMIC_RELEASE, "agent");
    asm volatile("s_waitcnt vmcnt(0)" ::: "memory");
    (void)__hip_atomic_fetch_add(ctr, 1u, __ATOMIC_RELAXED, __HIP_MEMORY_SCOPE_AGENT);
    while (__hip_atomic_load(ctr, __ATOMIC_RELAXED, __HIP_MEMORY_SCOPE_AGENT) < target) __builtin_amdgcn_s_sleep(1);
    __builtin_amdgcn_fence(__ATOMIC_ACQUIRE, "agent");
    asm volatile("s_waitcnt vmcnt(0)" ::: "memory");
  }
  __syncthreads();
}

DI void prep_w(int vb, int nvb, const float* __restrict__ W, bf16_t* __restrict__ Wt, int K, int N, const float* __restrict__ gk, const float* __restrict__ sn, int mode, float* smf) {
  const int ldt = K + PADK;
  const int tid = opaque_tid();
  const int ntn = N / 64, nt = (K / 64) * ntn;
  for (int t0 = 0; t0 < nt; t0 += nvb) {
    const int t = t0 + vb;
    const bool on = t < nt;
    const int k0 = (t / ntn) * 64, n0 = (t % ntn) * 64;
    if (on) {
#pragma unroll
      for (int i = 0; i < 16; ++i) {
        const int kk = i * 4 + (tid >> 6), nn = tid & 63;
        float v = __builtin_nontemporal_load(W + (size_t)(k0 + kk) * N + n0 + nn);
        if (gk) v *= gk[k0 + kk];
        if (sn) v *= sn[n0 + nn];
        smf[kk * 65 + nn] = v;
      }
    }
    __syncthreads();
    if (on) {
      const int nl = tid >> 2, kq = (tid & 3) * 16;
      u32x4 p0, p1;
      p0.x = pack_bf16(smf[(kq + 0) * 65 + nl], smf[(kq + 1) * 65 + nl]);
      p0.y = pack_bf16(smf[(kq + 2) * 65 + nl], smf[(kq + 3) * 65 + nl]);
      p0.z = pack_bf16(smf[(kq + 4) * 65 + nl], smf[(kq + 5) * 65 + nl]);
      p0.w = pack_bf16(smf[(kq + 6) * 65 + nl], smf[(kq + 7) * 65 + nl]);
      p1.x = pack_bf16(smf[(kq + 8) * 65 + nl], smf[(kq + 9) * 65 + nl]);
      p1.y = pack_bf16(smf[(kq + 10) * 65 + nl], smf[(kq + 11) * 65 + nl]);
      p1.z = pack_bf16(smf[(kq + 12) * 65 + nl], smf[(kq + 13) * 65 + nl]);
      p1.w = pack_bf16(smf[(kq + 14) * 65 + nl], smf[(kq + 15) * 65 + nl]);
      const int n = n0 + nl;
      int row = n;
      if (mode == 1) row = (n >> 4) * 32 + (n & 15);
      else if (mode == 2) row = (n >> 4) * 32 + 16 + (n & 15);
      else if (mode == 3) { const int hd = n >> 8, j = n & 255; row = (j < 128) ? (hd * 128 + j) : (1024 + hd * 128 + (j - 128)); }
      u32x4* dst = (u32x4*)(Wt + (size_t)row * ldt + k0 + kq);
      dst[0] = p0; dst[1] = p1;
    }
    __syncthreads();
  }
}

template <int WM_, int WN_, int MI_, int NI_, int BK_, int ST_>
struct Cfg {
  static constexpr int WM = WM_, WN = WN_, MI = MI_, NI = NI_, BK = BK_, ST = ST_;
  static constexpr int BM = WM * MI * 32, BN = WN * NI * 32;
  static constexpr int LS = BK + 8;
  static constexpr int A_EL = BM * LS, B_EL = BN * LS, STAGE_EL = A_EL + B_EL;
  static constexpr int CPR = BK / 8;
  static constexpr int A_CH = BM * CPR / 256, B_CH = BN * CPR / 256;
  static_assert(WM * WN == 4, "4 waves");
  static_assert(ST * STAGE_EL * 2 <= VHALF_BYTES, "LDS of a virtual half-block");
};

template <class C, class Epi>
DI void gemm_tile(const bf16_t* __restrict__ A, int lda, const bf16_t* __restrict__ Bt, int K, int m0, int n0, const Epi& epi, bf16_t* sm) {
  const int tid = opaque_tid(), lane = tid & 63, wave = tid >> 6, r = lane & 31, h = lane >> 5;
  const int wm = wave / C::WN, wn = wave % C::WN;
  f32x16 acc[C::MI][C::NI];
#pragma unroll
  for (int mi = 0; mi < C::MI; ++mi)
#pragma unroll
    for (int ni = 0; ni < C::NI; ++ni)
#pragma unroll
      for (int i = 0; i < 16; ++i) acc[mi][ni][i] = 0.f;
  const bf16_t* Ag = A + (size_t)m0 * lda;
  const int ldb = K + PADK;
  const bf16_t* Bg = Bt + (size_t)n0 * ldb;
  u32x4 ra[C::A_CH], rb[C::B_CH];
  const int nk = K / C::BK;
  constexpr int RPP = 256 / C::CPR;
  const unsigned a_off = (unsigned)(tid / C::CPR) * (unsigned)lda + (unsigned)(tid % C::CPR) * 8u;
  const unsigned b_off = (unsigned)(tid / C::CPR) * (unsigned)ldb + (unsigned)(tid % C::CPR) * 8u;
  const unsigned l_off = (unsigned)(tid / C::CPR) * C::LS + (unsigned)(tid % C::CPR) * 8u;
#define GLOAD(k0_)                                                                                   \
  {                                                                                                  \
    const bf16_t* ag_ = Ag + (k0_); const bf16_t* bg_ = Bg + (k0_);                                  \
    _Pragma("unroll") for (int i = 0; i < C::A_CH; ++i) ra[i] = *(const u32x4*)(ag_ + (a_off + (unsigned)(i * RPP) * (unsigned)lda)); \
    _Pragma("unroll") for (int i = 0; i < C::B_CH; ++i) rb[i] = *(const u32x4*)(bg_ + (b_off + (unsigned)(i * RPP) * (unsigned)ldb));   \
  }
#define LSTORE(buf_)                                                                                 \
  {                                                                                                  \
    bf16_t* sa_ = sm + (buf_) * C::STAGE_EL + l_off; bf16_t* sb_ = sa_ + C::A_EL;                    \
    _Pragma("unroll") for (int i = 0; i < C::A_CH; ++i) *(u32x4*)(sa_ + i * RPP * C::LS) = ra[i];   \
    _Pragma("unroll") for (int i = 0; i < C::B_CH; ++i) *(u32x4*)(sb_ + i * RPP * C::LS) = rb[i];   \
  }
  GLOAD(0);
  if (C::ST == 2) {
    LSTORE(0);
    __syncthreads();
  }
  for (int kt = 0; kt < nk; ++kt) {
    const int buf = (C::ST == 2) ? (kt & 1) : 0;
    if (C::ST == 1) {
      __syncthreads();
      LSTORE(0);
      __syncthreads();
    }
    if (kt + 1 < nk) GLOAD((kt + 1) * C::BK);
    __builtin_amdgcn_sched_barrier(0);
    const bf16_t* sa = sm + buf * C::STAGE_EL + (wm * C::MI * 32 + r) * C::LS + h * 8;
    const bf16_t* sb = sm + buf * C::STAGE_EL + C::A_EL + (wn * C::NI * 32 + r) * C::LS + h * 8;
#pragma unroll
    for (int ks = 0; ks < C::BK / 16; ++ks) {
      bf16x8 af[C::MI], bfr[C::NI];
#pragma unroll
      for (int mi = 0; mi < C::MI; ++mi) af[mi] = *(const bf16x8*)(sa + mi * 32 * C::LS + ks * 16);
#pragma unroll
      for (int ni = 0; ni < C::NI; ++ni) bfr[ni] = *(const bf16x8*)(sb + ni * 32 * C::LS + ks * 16);
#pragma unroll
      for (int mi = 0; mi < C::MI; ++mi)
#pragma unroll
        for (int ni = 0; ni < C::NI; ++ni) acc[mi][ni] = MFMA(af[mi], bfr[ni], acc[mi][ni]);
    }
    if (C::ST == 2) {
      if (kt + 1 < nk) LSTORE((kt + 1) & 1);
      __syncthreads();
    }
  }
  if (C::ST == 1) __syncthreads();
#undef GLOAD
#undef LSTORE
  epi.template run<C::MI, C::NI>(acc, m0 + wm * C::MI * 32, n0 + wn * C::NI * 32, r, h);
}

template <class C, class Epi>
DI void gemm_phase(int x, int j, int nb, const bf16_t* __restrict__ A, int lda, const bf16_t* __restrict__ Bt, int K, int N, int a_grp, const Epi& epi, bf16_t* sm) {
  static_assert(C::BM == 128 && (C::BN == 128 || C::BN == 256), "tile");
  constexpr int GN = (C::BN == 256) ? 4 : 8;
  const int nN = N / C::BN;
  const int total = 32 * nN;
  for (int u = j; u < total; u += nb) {
    const int ng = u / (32 * GN), rem = u % (32 * GN);
    int gn = nN - GN * ng; if (gn > GN) gn = GN;
    const int mg = rem / (8 * gn), jj = rem % (8 * gn);
    const int mt = 32 * x + 8 * mg + (jj & 7), nt = GN * ng + (jj >> 3);
    const int n0 = nt * C::BN;
    const bf16_t* Ap = a_grp ? (A + (n0 / a_grp) * K) : A;
    gemm_tile<C, Epi>(Ap, lda, Bt, K, mt * 128, n0, epi, sm);
  }
}

struct EpiGU {
  bf16_t* act; const float* ssq;
  template <int MI, int NI> DI void run(f32x16 (&acc)[MI][NI], int mb, int nb, int r, int h) const {
    static_assert((NI & 1) == 0, "gate/up pairs");
#pragma unroll
    for (int mi = 0; mi < MI; ++mi)
#pragma unroll
      for (int i = 0; i < 16; ++i) {
        const int row = mb + mi * 32 + crow(i, h);
        const float rs = rsqrtf(ssq[row] * (1.f / D) + EPS);
#pragma unroll
        for (int pi = 0; pi < NI / 2; ++pi) {
          const float g = acc[mi][2 * pi][i] * rs, u = acc[mi][2 * pi + 1][i] * rs;
          const float a = g / (1.f + __expf(-g)) * u;
          act[(size_t)row * LDA + (nb >> 1) + pi * 32 + r] = to_bf16(a);
        }
      }
  }
};
struct EpiResid {
  const float* xin; float* xout; float scale; bf16_t* xb; float* ssq;
  template <int MI, int NI> DI void run(f32x16 (&acc)[MI][NI], int mb, int nb, int r, int h) const {
#pragma unroll
    for (int mi = 0; mi < MI; ++mi)
#pragma unroll
      for (int hf = 0; hf < 2; ++hf) {
        float xv[8][NI];
#pragma unroll
        for (int i = 0; i < 8; ++i)
#pragma unroll
          for (int ni = 0; ni < NI; ++ni) xv[i][ni] = xin[(size_t)(mb + mi * 32 + crow(hf * 8 + i, h)) * D + nb + ni * 32 + r];
        __builtin_amdgcn_sched_barrier(0);
        float ssv[8];
#pragma unroll
        for (int i = 0; i < 8; ++i) {
          const int row = mb + mi * 32 + crow(hf * 8 + i, h);
          float ss = 0.f;
#pragma unroll
          for (int ni = 0; ni < NI; ++ni) {
            const float v = xv[i][ni] + scale * acc[mi][ni][hf * 8 + i];
            xout[(size_t)row * D + nb + ni * 32 + r] = v;
            if (xb) { xb[(size_t)row * LDH + nb + ni * 32 + r] = to_bf16(v); ss += v * v; }
          }
          ssv[i] = ss;
        }
        if (xb) {
#pragma unroll
          for (int i = 0; i < 8; ++i) { const float t = red32(ssv[i]); if (r == 0) atomicAdd(ssq + mb + mi * 32 + crow(hf * 8 + i, h), t); }
        }
        __builtin_amdgcn_sched_barrier(0);
      }
  }
};
struct EpiLat {
  bf16_t* lat; float* kpe; float* ssq_q; float* ssq_kv; const float* ssq_x;
  template <int MI, int NI> DI void run(f32x16 (&acc)[MI][NI], int mb, int nb, int r, int h) const {
    if (nb >= 1088) return;
    float* ssq = (nb < QL) ? ssq_q : ssq_kv;
#pragma unroll
    for (int mi = 0; mi < MI; ++mi) {
      float rsv[16];
#pragma unroll
      for (int i = 0; i < 16; ++i) rsv[i] = rsqrtf(ssq_x[mb + mi * 32 + crow(i, h)] * (1.f / D) + EPS);
      __builtin_amdgcn_sched_barrier(0);
      if (nb >= 1024) {
#pragma unroll
        for (int i = 0; i < 16; ++i)
#pragma unroll
          for (int ni = 0; ni < NI; ++ni) kpe[(size_t)(mb + mi * 32 + crow(i, h)) * 64 + (nb - 1024) + ni * 32 + r] = acc[mi][ni][i] * rsv[i];
      } else {
        float ssv[16];
#pragma unroll
        for (int i = 0; i < 16; ++i) {
          const int row = mb + mi * 32 + crow(i, h);
          float ss = 0.f;
#pragma unroll
          for (int ni = 0; ni < NI; ++ni) { const float v = acc[mi][ni][i] * rsv[i]; ss += v * v; lat[(size_t)row * LDH + nb + ni * 32 + r] = to_bf16(v); }
          ssv[i] = ss;
        }
#pragma unroll
        for (int i = 0; i < 16; ++i) { const float t = red32(ssv[i]); if (r == 0) atomicAdd(ssq + mb + mi * 32 + crow(i, h), t); }
      }
    }
  }
};
struct EpiQraw {
  bf16_t* q; const float* ssq_q;
  template <int MI, int NI> DI void run(f32x16 (&acc)[MI][NI], int mb, int nb, int r, int h) const {
#pragma unroll
    for (int mi = 0; mi < MI; ++mi)
#pragma unroll
      for (int i = 0; i < 16; ++i) {
        const int row = mb + mi * 32 + crow(i, h);
        const float rs = rsqrtf(ssq_q[row] * (1.f / QL) + EPS);
#pragma unroll
        for (int ni = 0; ni < NI; ++ni) q[(size_t)row * 1536 + nb + ni * 32 + r] = to_bf16(acc[mi][ni][i] * rs);
      }
  }
};
struct EpiKV {
  const float* ssq_kv; const float* kpe; const float* gk; const float* cosT; const float* sinT; bf16_t* kout; bf16_t* vt;
  template <int MI, int NI> DI void run(f32x16 (&acc)[MI][NI], int mb, int nb, int r, int h) const {
    static_assert(MI == 1 && NI == 4, "kv epilogue layout");
    const int b = mb / S, sb = mb % S;
    if (nb < 1024) {
      const int head = nb >> 7;
      const float g0 = gk[r], g1 = gk[32 + r], g2 = gk[64 + r], g3 = gk[96 + r], g4 = gk[128 + r], g5 = gk[160 + r];
#pragma unroll
      for (int i = 0; i < 16; ++i) {
        const int rw = crow(i, h), tok = mb + rw;
        const float rkv = rsqrtf(ssq_kv[tok] * (1.f / KVL) + EPS);
        const float v0 = acc[0][0][i] * rkv, v1 = acc[0][1][i] * rkv, v2 = acc[0][2][i] * rkv, v3 = acc[0][3][i] * rkv;
        const float p1 = kpe[(size_t)tok * 64 + r], p2 = kpe[(size_t)tok * 64 + 32 + r];
        float ss = v0 * v0 + v1 * v1 + v2 * v2 + v3 * v3 + p1 * p1 + p2 * p2;
        ss = red32(ss);
        const float rk = rsqrtf(ss * (1.f / QKH) + EPS);
        bf16_t* kr = kout + ((size_t)(b * NH + head) * S + sb + rw) * QKH;
        kr[r] = to_bf16(v0 * rk * g0); kr[32 + r] = to_bf16(v1 * rk * g1); kr[64 + r] = to_bf16(v2 * rk * g2); kr[96 + r] = to_bf16(v3 * rk * g3);
        const float c = cosT[(size_t)tok * 32 + r], sn = sinT[(size_t)tok * 32 + r];
        const float x1 = p1 * rk * g4, x2 = p2 * rk * g5;
        kr[128 + r] = to_bf16(x1 * c - x2 * sn); kr[160 + r] = to_bf16(x2 * c + x1 * sn);
      }
    } else {
      const int head = (nb - 1024) >> 7;
      float rkv[16];
#pragma unroll
      for (int i = 0; i < 16; ++i) rkv[i] = rsqrtf(ssq_kv[mb + crow(i, h)] * (1.f / KVL) + EPS);
#pragma unroll
      for (int ni = 0; ni < 4; ++ni) {
        bf16_t* vr = vt + ((size_t)(b * NH + head) * VH + ni * 32 + r) * SV + sb;
#pragma unroll
        for (int a = 0; a < 4; ++a) {
          u32x2 o;
          o.x = pack_bf16(acc[0][ni][4 * a] * rkv[4 * a], acc[0][ni][4 * a + 1] * rkv[4 * a + 1]);
          o.y = pack_bf16(acc[0][ni][4 * a + 2] * rkv[4 * a + 2], acc[0][ni][4 * a + 3] * rkv[4 * a + 3]);
          *(u32x2*)(vr + 16 * (a >> 1) + 8 * h + 4 * (a & 1)) = o;
        }
      }
    }
  }
};


DI int lds_byte2(int r, int c) { const int st = (r >> 4) * 2 + (c >> 5), ob = (r & 15) * 64 + (c & 31) * 2; return st * 1024 + (ob ^ (((ob >> 9) & 1) << 5)); }
DI void stage_rc2(int b, int& R, int& C) { const int st = b >> 10, sb = b & 1023, swz = sb ^ (((sb >> 9) & 1) << 5); R = (st >> 1) * 16 + swz / 64; C = (st & 1) * 32 + (swz % 64) / 2; }
#define MFMA16(a, b, c) __builtin_amdgcn_mfma_f32_16x16x32_bf16((a), (b), (c), 0, 0, 0)
constexpr int G8_TILE_B = 256 * 64 * 2, G8_STAGE_B = 2 * G8_TILE_B;

template <class Epi>
DI void gemm8_tile(const bf16_t* __restrict__ Ab, int lda, const bf16_t* __restrict__ Bb, int ldb, int K, int brow, int bcol, const Epi epi,
                   bool staged, bool has_next, const bf16_t* __restrict__ Abn, const bf16_t* __restrict__ Bbn) {
  const int tid = opaque_tid512(), wid = tid >> 6, lane = tid & 63, wr = wid >> 2, wc = wid & 3, fr = lane & 15, fq = lane >> 4;
  unsigned aoff[4], boff[4];
#pragma unroll
  for (int i = 0; i < 4; ++i) { int R, C; stage_rc2(wid * 1024 + i * 8192 + lane * 16, R, C); aoff[i] = (unsigned)R * (unsigned)lda + (unsigned)C; boff[i] = (unsigned)R * (unsigned)ldb + (unsigned)C; }
#define G8_STAGE_R(buf_, ap_, bp_, i0_, i1_)                                                                         \
  {                                                                                                                  \
    const bf16_t* ag_ = (ap_); const bf16_t* bg_ = (bp_);                                                            \
    _Pragma("unroll") for (int i = (i0_); i < (i1_); ++i) {                                                          \
      __builtin_amdgcn_global_load_lds((const unsigned*)(ag_ + aoff[i]), (unsigned*)(smem + (buf_) * G8_STAGE_B + wid * 1024 + i * 8192), 16, 0, 0);              \
      __builtin_amdgcn_global_load_lds((const unsigned*)(bg_ + boff[i]), (unsigned*)(smem + (buf_) * G8_STAGE_B + G8_TILE_B + wid * 1024 + i * 8192), 16, 0, 0);  \
    }                                                                                                                \
  }
#define G8_STAGE(buf_, ap_, bp_) G8_STAGE_R(buf_, ap_, bp_, 0, 4)
  f32x4 acc[8][4];
#pragma unroll
  for (int m = 0; m < 8; ++m)
#pragma unroll
    for (int n = 0; n < 4; ++n) acc[m][n] = (f32x4){0.f, 0.f, 0.f, 0.f};
  const int nt = K / 64;
  if (!staged) {
    G8_STAGE(0, Ab, Bb);
    asm volatile("s_waitcnt vmcnt(0)" ::: "memory");
    __syncthreads();
  }
  for (int t = 0; t < nt; ++t) {
    const int cur = t & 1;
    const unsigned char* sa = smem + cur * G8_STAGE_B;
    const unsigned char* sb = sa + G8_TILE_B;
#pragma unroll
    for (int ks = 0; ks < 2; ++ks) {
      bf16x8 At[8], Bf[4];
      Bf[0] = *(const bf16x8*)(sb + lds_byte2(wc * 64 + fr, ks * 32 + fq * 8));
      At[0] = *(const bf16x8*)(sa + lds_byte2(wr * 128 + fr, ks * 32 + fq * 8));
#pragma unroll
      for (int n = 1; n < 4; ++n) Bf[n] = *(const bf16x8*)(sb + lds_byte2(wc * 64 + n * 16 + fr, ks * 32 + fq * 8));
#pragma unroll
      for (int m = 1; m < 8; ++m) At[m] = *(const bf16x8*)(sa + lds_byte2(wr * 128 + m * 16 + fr, ks * 32 + fq * 8));
      {
        __builtin_amdgcn_sched_barrier(0);
        if (t + 1 < nt) { G8_STAGE_R(cur ^ 1, Ab + (t + 1) * 64, Bb + (t + 1) * 64, 2 * ks, 2 * ks + 2); }
        else if (has_next) { G8_STAGE_R(0, Abn, Bbn, 2 * ks, 2 * ks + 2); }
        __builtin_amdgcn_sched_barrier(0);
      }
#pragma unroll
      for (int m = 0; m < 8; ++m)
#pragma unroll
        for (int n = 0; n < 4; ++n) acc[m][n] = MFMA16(At[m], Bf[n], acc[m][n]);
      __builtin_amdgcn_sched_barrier(0);
    }
    asm volatile("s_waitcnt vmcnt(0)" ::: "memory");
    __syncthreads();
  }
#undef G8_STAGE
#undef G8_STAGE_R
  epi.run8(acc, brow + wr * 128, bcol + wc * 64, fr, fq);
  if (Epi::LDS_SCRATCH) __syncthreads();
}

DI void g8_decode(int u, int x, int nN, int& pm, int& pn) {
  const int ng = u >> 6, rem = u & 63;
  int gn = nN - 4 * ng; if (gn > 4) gn = 4;
  const int mg = rem / (8 * gn), jj = rem % (8 * gn);
  pm = 16 * x + 8 * mg + (jj & 7); pn = 4 * ng + (jj >> 3);
}
template <class Epi>
DI void gemm8_phase(int x, int j, const bf16_t* __restrict__ A, int lda, const bf16_t* __restrict__ Bt, int K, int N, int a_grp, const Epi epi) {
  const int nN = N / 256, nb = gridDim.x >> 3, ldb = K + PADK;
  const int total = 16 * nN;
  bool staged = false;
  for (int u = j; u < total; u += nb) {
    int pm, pn; g8_decode(u, x, nN, pm, pn);
    const int brow = pm * 256, bcol = pn * 256;
    const bf16_t* Ab = A + (size_t)brow * lda + (a_grp ? (bcol / a_grp) * K : 0);
    const bf16_t* Bb = Bt + (size_t)bcol * ldb;
    const bool has_next = (u + nb < total);
    const bf16_t* Abn = Ab; const bf16_t* Bbn = Bb;
    if (has_next) {
      int pm2, pn2; g8_decode(u + nb, x, nN, pm2, pn2);
      Abn = A + (size_t)(pm2 * 256) * lda + (a_grp ? ((pn2 * 256) / a_grp) * K : 0);
      Bbn = Bt + (size_t)(pn2 * 256) * ldb;
    }
    gemm8_tile<Epi>(Ab, lda, Bb, ldb, K, brow, bcol, epi, staged, has_next, Abn, Bbn);
    staged = has_next;
  }
}
DI float red16(float v) { v += __shfl_xor(v, 1); v += __shfl_xor(v, 2); v += __shfl_xor(v, 4); v += __shfl_xor(v, 8); return v; }

struct EpiGU8 {
  static constexpr bool LDS_SCRATCH = true;
  bf16_t* act; const float* ssq;
  DI void run8(f32x4 (&acc)[8][4], int rb, int cb, int fr, int fq) const {
    const int lane = fq * 16 + fr, wid = (int)(threadIdx.x >> 6);
    bf16_t* scr = (bf16_t*)(smem + G8_STAGE_B + wid * 1280);
    const int srow = lane >> 2, sch = lane & 3;
    bf16_t* ap = act + (size_t)(rb + srow) * LDA + (cb >> 1) + sch * 8;
    float rsv[8][4];
#pragma unroll
    for (int m = 0; m < 8; ++m)
#pragma unroll
      for (int j = 0; j < 4; ++j) rsv[m][j] = rsqrtf(ssq[rb + m * 16 + fq * 4 + j] * (1.f / D) + EPS);
#pragma unroll
    for (int m = 0; m < 8; ++m) {
#pragma unroll
      for (int j = 0; j < 4; ++j)
#pragma unroll
        for (int pi = 0; pi < 2; ++pi) {
          const float g = acc[m][2 * pi][j] * rsv[m][j], u = acc[m][2 * pi + 1][j] * rsv[m][j];
          const float a = g * __builtin_amdgcn_rcpf(1.f + __expf(-g)) * u;
          scr[(fq * 4 + j) * 40 + pi * 16 + fr] = to_bf16(a);
        }
      __builtin_amdgcn_sched_barrier(0);
      const u32x4 o = *(const u32x4*)(scr + srow * 40 + sch * 8);
      *(u32x4*)(ap + (size_t)(m * 16) * LDA) = o;
      __builtin_amdgcn_sched_barrier(0);
    }
  }
};
struct EpiResid8 {
  static constexpr bool LDS_SCRATCH = true;
  const float* xin; float* xout; float scale; bf16_t* xb; float* ssq;
  DI void run8(f32x4 (&acc)[8][4], int rb, int cb, int fr, int fq) const {
    const int lane = fq * 16 + fr, wid = (int)(threadIdx.x >> 6);
    const float sc = scale; bf16_t* const xbp = xb; float* const ssqp = ssq;
    float* scr = (float*)(smem + G8_STAGE_B + wid * 4352);
    const int prow = lane >> 4, c4 = lane & 15;
    const float* xp = xin + (size_t)(rb + prow) * D + cb + c4 * 4;
    float* op = xout + (size_t)(rb + prow) * D + cb + c4 * 4;
#pragma unroll
    for (int mh = 0; mh < 2; ++mh) {
      f32x4 xv[4][4];
#pragma unroll
      for (int mm = 0; mm < 4; ++mm)
#pragma unroll
        for (int ps = 0; ps < 4; ++ps) xv[mm][ps] = __builtin_nontemporal_load((const f32x4*)(xp + (size_t)((mh * 4 + mm) * 16 + ps * 4) * D));
      __builtin_amdgcn_sched_barrier(0);
#pragma unroll
      for (int mm = 0; mm < 4; ++mm) {
        const int m = mh * 4 + mm;
#pragma unroll
        for (int n = 0; n < 4; ++n)
#pragma unroll
          for (int j = 0; j < 4; ++j) scr[(fq * 4 + j) * 68 + n * 16 + fr] = acc[m][n][j];
        __builtin_amdgcn_sched_barrier(0);
#pragma unroll
        for (int ps = 0; ps < 4; ++ps) {
          const f32x4 a = *(const f32x4*)(scr + (ps * 4 + prow) * 68 + c4 * 4);
          f32x4 v;
          v.x = xv[mm][ps].x + a.x * sc; v.y = xv[mm][ps].y + a.y * sc; v.z = xv[mm][ps].z + a.z * sc; v.w = xv[mm][ps].w + a.w * sc;
          const int grow = rb + m * 16 + ps * 4 + prow;
          __builtin_nontemporal_store(v, (f32x4*)(op + (size_t)(m * 16 + ps * 4) * D));
          if (xbp) {
            u32x2 o; o.x = pack_bf16(v.x, v.y); o.y = pack_bf16(v.z, v.w);
            *(u32x2*)(xbp + (size_t)grow * LDH + cb + c4 * 4) = o;
            const float t = red16(v.x * v.x + v.y * v.y + v.z * v.z + v.w * v.w);
            if (c4 == 0) atomicAdd(ssqp + grow, t);
          }
        }
        __builtin_amdgcn_sched_barrier(0);
      }
    }
  }
};
struct EpiLat8 {
  static constexpr bool LDS_SCRATCH = false;
  bf16_t* lat; float* kpe; float* ssq_q; float* ssq_kv; const float* ssq_x;
  DI void run8(f32x4 (&acc)[8][4], int rb, int cb, int fr, int fq) const {
    if (cb >= 1088) return;
    float* ssq = (cb < QL) ? ssq_q : ssq_kv;
#pragma unroll
    for (int mp = 0; mp < 2; ++mp) {
      float rsv[4][4];
#pragma unroll
      for (int mm = 0; mm < 4; ++mm)
#pragma unroll
        for (int j = 0; j < 4; ++j) rsv[mm][j] = rsqrtf(ssq_x[rb + (4 * mp + mm) * 16 + fq * 4 + j] * (1.f / D) + EPS);
      __builtin_amdgcn_sched_barrier(0);
#pragma unroll
      for (int mm = 0; mm < 4; ++mm) {
        float ssv[4];
#pragma unroll
        for (int j = 0; j < 4; ++j) {
          const int row = rb + (4 * mp + mm) * 16 + fq * 4 + j;
          float ss = 0.f;
#pragma unroll
          for (int n = 0; n < 4; ++n) {
            const float v = acc[4 * mp + mm][n][j] * rsv[mm][j];
            if (cb >= 1024) kpe[(size_t)row * 64 + (cb - 1024) + n * 16 + fr] = v;
            else { lat[(size_t)row * LDH + cb + n * 16 + fr] = to_bf16(v); ss += v * v; }
          }
          ssv[j] = ss;
        }
        if (cb < 1024) {
#pragma unroll
          for (int j = 0; j < 4; ++j) { const float t = red16(ssv[j]); if (fr == 0) atomicAdd(ssq + rb + (4 * mp + mm) * 16 + fq * 4 + j, t); }
        }
      }
    }
  }
};
struct EpiQraw8 {
  static constexpr bool LDS_SCRATCH = false;
  bf16_t* q; const float* ssq_q;
  DI void run8(f32x4 (&acc)[8][4], int rb, int cb, int fr, int fq) const {
#pragma unroll
    for (int m = 0; m < 8; ++m)
#pragma unroll
      for (int j = 0; j < 4; ++j) {
        const int row = rb + m * 16 + fq * 4 + j;
        const float rs = rsqrtf(ssq_q[row] * (1.f / QL) + EPS);
#pragma unroll
        for (int n = 0; n < 4; ++n) q[(size_t)row * 1536 + cb + n * 16 + fr] = to_bf16(acc[m][n][j] * rs);
      }
  }
};

DI void norm0_phase(const float* __restrict__ x, bf16_t* __restrict__ hb, float* __restrict__ ssq) {
  const int tid = opaque_tid512();
  const int lane = tid & 63, gw = blockIdx.x * 8 + (tid >> 6), nw = gridDim.x * 8;
  for (int row = gw; row < T; row += nw) {
    const f32x4* xr = (const f32x4*)(x + (size_t)row * D);
    f32x4 v[4];
    float ss = 0.f;
#pragma unroll
    for (int c = 0; c < 4; ++c) { v[c] = __builtin_nontemporal_load(xr + c * 64 + lane); ss += v[c].x * v[c].x + v[c].y * v[c].y + v[c].z * v[c].z + v[c].w * v[c].w; }
    ss = red64(ss);
    if (lane == 0) ssq[row] = ss;
#pragma unroll
    for (int c = 0; c < 4; ++c) {
      u32x2 o; o.x = pack_bf16(v[c].x, v[c].y); o.y = pack_bf16(v[c].z, v[c].w);
      *(u32x2*)(hb + (size_t)row * LDH + (c * 64 + lane) * 4) = o;
    }
  }
}

template <int W>
DI void pool_rows(const float* __restrict__ x, const float* smr, bf16_t* __restrict__ pb, int t0, int s0, int tid) {
  const int tq0 = t0 - s0;
  const float* xq = x + tid * 4;
  f32x4 Sm = {0.f, 0.f, 0.f, 0.f};
#pragma unroll
  for (int i = 1; i < W; ++i) {
    int t = t0 - i; if (t < tq0) t = tq0;
    Sm += *(const f32x4*)(xq + (size_t)t * D) * smr[15 - i];
  }
#pragma unroll 8
  for (int tl = 0; tl < 64; ++tl) {
    const int t = t0 + tl, s = s0 + tl;
    int to = t - W + 1; if (to < tq0) to = tq0;
    const f32x4 hn = *(const f32x4*)(xq + (size_t)t * D) * smr[15 + tl];
    const f32x4 ho = *(const f32x4*)(xq + (size_t)to * D) * smr[15 + tl - W + 1];
    const int cnt = (s + 1 < W) ? (s + 1) : W;
    const float ic = 1.f / (float)cnt;
    Sm += hn;
    const f32x4 p = Sm * ic - hn;
    Sm -= ho;
    u32x2 o; o.x = pack_bf16(p.x, p.y); o.y = pack_bf16(p.z, p.w);
    *(u32x2*)(pb + (size_t)t * LDH + tid * 4) = o;
  }
}
DI void poolprep_phase(int vb, int nvb, const float* __restrict__ x, const float* __restrict__ ssq, bf16_t* __restrict__ pb, float* smf) {
  const int tid = opaque_tid(), wave = tid >> 6;
  for (int c0 = 0; c0 < T / 64; c0 += nvb) {
    const int ch = c0 + vb;
    const bool on = ch < T / 64;
    const int t0 = ch * 64, s0 = t0 & (S - 1);
    if (on && tid < 79) smf[tid] = (s0 + tid >= 15) ? rsqrtf(ssq[t0 - 15 + tid] * (1.f / D) + EPS) : 0.f;
    __syncthreads();
    if (on) {
      if (wave == 0) pool_rows<2>(x, smf, pb, t0, s0, tid);
      else if (wave == 1) pool_rows<4>(x, smf, pb, t0, s0, tid);
      else if (wave == 2) pool_rows<8>(x, smf, pb, t0, s0, tid);
      else pool_rows<16>(x, smf, pb, t0, s0, tid);
    }
    __syncthreads();
  }
}

constexpr int KLS = QKH + 8;
constexpr int VLS = 64 + 8;
constexpr int K_EL = 64 * KLS;
constexpr int ATT_STG_EL = K_EL + 128 * VLS;

DI void attn_phase(const bf16_t* __restrict__ qraw, const bf16_t* __restrict__ kbuf, const bf16_t* __restrict__ vtb, bf16_t* __restrict__ obuf,
                   const float* __restrict__ gq, const float* __restrict__ cosT, const float* __restrict__ sinT, bf16_t* sm, int x, int j) {
  const int nb = gridDim.x >> 3;
  for (int p = j; p < 64; p += nb) {
    const int bh = 2 * x + (p >> 5);
    const int b = bh >> 3, hd = bh & 7;
    for (int half = 0; half < 2; ++half) {
      const int tid = opaque_tid512(), lane = tid & 63, wave = tid >> 6, r = lane & 31, h = lane >> 5;
      const int qb = half ? (p & 31) : (63 - (p & 31));
      const int q0 = qb * 256 + wave * 32;
      const size_t tok = (size_t)b * S + q0 + r;
      bf16x8 qf[12];
      {
        const bf16_t* qp = qraw + tok * 1536 + hd * QKH + h * 8;
#pragma unroll
        for (int st = 0; st < 12; ++st) qf[st] = *(const bf16x8*)(qp + st * 16);
        float ss = 0.f;
#pragma unroll
        for (int st = 0; st < 12; ++st) {
#pragma unroll
          for (int e = 0; e < 8; ++e) { const float f = bf2f(qf[st][e]); ss += f * f; }
          u32x4 t = __builtin_bit_cast(u32x4, qf[st]);
          asm volatile("" : "+v"(t));
          qf[st] = __builtin_bit_cast(bf16x8, t);
        }
        ss += __shfl_xor(ss, 32);
        const float rq = rsqrtf(ss * (1.f / QKH) + EPS) * (0.07216878364870322f * 1.4426950408889634f);
        __builtin_amdgcn_sched_barrier(0);
#pragma unroll
        for (int st = 0; st < 8; ++st) {
          const f32x4 ga = *(const f32x4*)(gq + st * 16 + h * 8), gb = *(const f32x4*)(gq + st * 16 + h * 8 + 4);
          u32x4 o;
          o.x = pack_bf16(bf2f(qf[st][0]) * rq * ga.x, bf2f(qf[st][1]) * rq * ga.y);
          o.y = pack_bf16(bf2f(qf[st][2]) * rq * ga.z, bf2f(qf[st][3]) * rq * ga.w);
          o.z = pack_bf16(bf2f(qf[st][4]) * rq * gb.x, bf2f(qf[st][5]) * rq * gb.y);
          o.w = pack_bf16(bf2f(qf[st][6]) * rq * gb.z, bf2f(qf[st][7]) * rq * gb.w);
          asm volatile("" : "+v"(o));
          qf[st] = __builtin_bit_cast(bf16x8, o);
          __builtin_amdgcn_sched_barrier(0);
        }
#pragma unroll
        for (int st = 8; st < 10; ++st) {
          const int jb = (st - 8) * 16 + h * 8;
          u32x4 o1, o2;
#pragma unroll
          for (int hf = 0; hf < 2; ++hf) {
            const f32x4 g1 = *(const f32x4*)(gq + 128 + jb + 4 * hf), g2 = *(const f32x4*)(gq + 160 + jb + 4 * hf);
            const f32x4 cc = *(const f32x4*)(cosT + tok * 32 + jb + 4 * hf), sn = *(const f32x4*)(sinT + tok * 32 + jb + 4 * hf);
            float y1[4], y2[4];
#pragma unroll
            for (int e = 0; e < 4; ++e) {
              const float x1 = bf2f(qf[st][4 * hf + e]) * rq * g1[e], x2 = bf2f(qf[st + 2][4 * hf + e]) * rq * g2[e];
              y1[e] = x1 * cc[e] - x2 * sn[e]; y2[e] = x2 * cc[e] + x1 * sn[e];
            }
            if (hf == 0) { o1.x = pack_bf16(y1[0], y1[1]); o1.y = pack_bf16(y1[2], y1[3]); o2.x = pack_bf16(y2[0], y2[1]); o2.y = pack_bf16(y2[2], y2[3]); }
            else { o1.z = pack_bf16(y1[0], y1[1]); o1.w = pack_bf16(y1[2], y1[3]); o2.z = pack_bf16(y2[0], y2[1]); o2.w = pack_bf16(y2[2], y2[3]); }
          }
          asm volatile("" : "+v"(o1), "+v"(o2));
          qf[st] = __builtin_bit_cast(bf16x8, o1); qf[st + 2] = __builtin_bit_cast(bf16x8, o2);
          __builtin_amdgcn_sched_barrier(0);
        }
      }
      f32x16 oacc[4];
#pragma unroll
      for (int mt = 0; mt < 4; ++mt)
#pragma unroll
        for (int i = 0; i < 16; ++i) oacc[mt][i] = 0.f;
      float m_run = -1e30f, l_run = 0.f;
      const int nkt = 4 * qb + 4;
      const bf16_t* kg = kbuf + (size_t)bh * S * QKH;
      const bf16_t* vg = vtb + (size_t)bh * VH * SV;
      u32x4 rk[3], rv[2];
      const unsigned kg_off0 = (unsigned)(tid >> 3) * QKH + (unsigned)(tid & 7) * 8u;
      const unsigned vg_off0 = (unsigned)(tid >> 3) * (unsigned)SV + (unsigned)(tid & 7) * 8u;
      const unsigned kl_off = (unsigned)(tid >> 3) * KLS + (unsigned)(tid & 7) * 8u;
      const unsigned vl_off = (unsigned)(tid >> 3) * VLS + (unsigned)(tid & 7) * 8u;
#define ALOAD(kt_)                                                                                                     \
  {                                                                                                                    \
    const bf16_t* kgt_ = kg + (size_t)(kt_) * 64 * QKH; const bf16_t* vgt_ = vg + (kt_) * 64;                          \
    unsigned kg_off = kg_off0, vg_off = vg_off0; asm volatile("" : "+v"(kg_off), "+v"(vg_off));                        \
    _Pragma("unroll") for (int i = 0; i < 3; ++i) rk[i] = *(const u32x4*)(kgt_ + (kg_off + (unsigned)(i * 64)));       \
    _Pragma("unroll") for (int i = 0; i < 2; ++i) rv[i] = *(const u32x4*)(vgt_ + (vg_off + (unsigned)(i * 64) * (unsigned)SV)); \
  }
      ALOAD(0);
#define ASTORE(stg_)                                                                                                   \
  {                                                                                                                    \
    bf16_t* sk_ = sm + (stg_) * ATT_STG_EL; bf16_t* sv_ = sk_ + K_EL;                                                  \
    _Pragma("unroll") for (int i = 0; i < 3; ++i) *(u32x4*)(sk_ + kl_off + i * 64) = rk[i];                            \
    _Pragma("unroll") for (int i = 0; i < 2; ++i) *(u32x4*)(sv_ + vl_off + i * 64 * VLS) = rv[i];                      \
  }
      ASTORE(0);
      __syncthreads();
      for (int kt = 0; kt < nkt; ++kt) {
        const bf16_t* smk = sm + (kt & 1) * ATT_STG_EL;
        const bf16_t* smv = smk + K_EL;
        const bool act_tile = (kt * 64 <= q0 + 31);
        if (!act_tile && kt + 1 < nkt) ALOAD(kt + 1);
        __builtin_amdgcn_sched_barrier(0);
        if (act_tile) {
        f32x16 sacc[2];
#pragma unroll
        for (int mt = 0; mt < 2; ++mt)
#pragma unroll
          for (int i = 0; i < 16; ++i) sacc[mt][i] = 0.f;
        const bf16_t* kp = smk + r * KLS + h * 8;
        {
          bf16x8 ka = *(const bf16x8*)(kp), kb = *(const bf16x8*)(kp + 32 * KLS);
          __builtin_amdgcn_sched_barrier(0);
          if (kt + 1 < nkt) ALOAD(kt + 1);
          __builtin_amdgcn_sched_barrier(0);
#pragma unroll
          for (int st = 0; st < 12; ++st) {
            bf16x8 na = ka, nbq = kb;
            if (st + 1 < 12) { na = *(const bf16x8*)(kp + (st + 1) * 16); nbq = *(const bf16x8*)(kp + 32 * KLS + (st + 1) * 16); }
            sacc[0] = MFMA(ka, qf[st], sacc[0]);
            sacc[1] = MFMA(kb, qf[st], sacc[1]);
            ka = na; kb = nbq;
            __builtin_amdgcn_sched_barrier(0);
          }
        }
        bf16x8 va[2][4];
        {
          const bf16_t* vp0 = smv + r * VLS + h * 8;
#pragma unroll
          for (int mt = 0; mt < 4; ++mt) va[0][mt] = *(const bf16x8*)(vp0 + mt * 32 * VLS);
        }
        if (kt * 64 + 63 > q0) {
          const int qpos = q0 + r;
#pragma unroll
          for (int mt = 0; mt < 2; ++mt)
#pragma unroll
            for (int i = 0; i < 16; ++i) { const int key = kt * 64 + mt * 32 + crow(i, h); if (key > qpos) sacc[mt][i] = -INFINITY; }
        }
        float mx = sacc[0][0];
#pragma unroll
        for (int mt = 0; mt < 2; ++mt)
#pragma unroll
          for (int i = 0; i < 16; ++i) mx = fmaxf(mx, sacc[mt][i]);
        mx = xmax32(mx);
        const float m_new = fmaxf(m_run, mx);
        const float alpha = __builtin_amdgcn_exp2f(m_run - m_new);
        m_run = m_new;
        float rs = 0.f;
#pragma unroll
        for (int mt = 0; mt < 2; ++mt)
#pragma unroll
          for (int i = 0; i < 16; ++i) { const float pv = __builtin_amdgcn_exp2f(sacc[mt][i] - m_new); sacc[mt][i] = pv; rs += pv; }
        rs = xsum32(rs);
        l_run = l_run * alpha + rs;
        if (__any(alpha != 1.f)) {
#pragma unroll
          for (int mt = 0; mt < 4; ++mt)
#pragma unroll
            for (int i = 0; i < 16; ++i) oacc[mt][i] *= alpha;
        }
        bf16x8 pf[4];
#pragma unroll
        for (int ks = 0; ks < 4; ++ks) {
          u32x4 o;
          o.x = pack_bf16(sacc[ks >> 1][8 * (ks & 1) + 0], sacc[ks >> 1][8 * (ks & 1) + 1]);
          o.y = pack_bf16(sacc[ks >> 1][8 * (ks & 1) + 2], sacc[ks >> 1][8 * (ks & 1) + 3]);
          o.z = pack_bf16(sacc[ks >> 1][8 * (ks & 1) + 4], sacc[ks >> 1][8 * (ks & 1) + 5]);
          o.w = pack_bf16(sacc[ks >> 1][8 * (ks & 1) + 6], sacc[ks >> 1][8 * (ks & 1) + 7]);
          pf[ks] = __builtin_bit_cast(bf16x8, o);
        }
        const bf16_t* vp = smv + r * VLS + h * 8;
        __builtin_amdgcn_sched_barrier(0);
        {
#pragma unroll
          for (int ks = 0; ks < 4; ++ks) {
            if (ks + 1 < 4) {
#pragma unroll
              for (int mt = 0; mt < 4; ++mt) va[(ks + 1) & 1][mt] = *(const bf16x8*)(vp + mt * 32 * VLS + (ks + 1) * 16);
            }
#pragma unroll
            for (int mt = 0; mt < 4; ++mt) oacc[mt] = MFMA(va[ks & 1][mt], pf[ks], oacc[mt]);
            __builtin_amdgcn_sched_barrier(0);
          }
        }
        }
        if (kt + 1 < nkt) ASTORE((kt + 1) & 1);
        __syncthreads();
      }
#undef ALOAD
#undef ASTORE
      const float inv = 1.f / l_run;
      bf16_t* op = obuf + tok * LDH + hd * VH + 4 * h;
#pragma unroll
      for (int mt = 0; mt < 4; ++mt)
#pragma unroll
        for (int a = 0; a < 4; ++a) {
          u32x2 o;
          o.x = pack_bf16(oacc[mt][4 * a] * inv, oacc[mt][4 * a + 1] * inv);
          o.y = pack_bf16(oacc[mt][4 * a + 2] * inv, oacc[mt][4 * a + 3] * inv);
          *(u32x2*)(op + mt * 32 + 8 * a) = o;
        }
      __syncthreads();
    }
  }
}

typedef Cfg<4, 1, 1, 4, 64, 1> CR;

__global__ void __launch_bounds__(512, 2) fwd_megakernel(Params p) {
  cg::grid_group grid = cg::this_grid();
  unsigned char* ws = p.ws;
  const float* x_in = p.in[0];
  const int* positions = (const int*)p.in[1];
  float* out = p.out;
  bf16_t* wgu1 = (bf16_t*)(ws + OFF_WGU1); bf16_t* wdn1 = (bf16_t*)(ws + OFF_WDN1);
  bf16_t* wgu2 = (bf16_t*)(ws + OFF_WGU2); bf16_t* wdn2 = (bf16_t*)(ws + OFF_WDN2);
  bf16_t* wpool = (bf16_t*)(ws + OFF_WPOOL); bf16_t* win = (bf16_t*)(ws + OFF_WIN); bf16_t* wq = (bf16_t*)(ws + OFF_WQ);
  bf16_t* wkv = (bf16_t*)(ws + OFF_WKV); bf16_t* wout = (bf16_t*)(ws + OFF_WOUT);
  float* cosT = (float*)(ws + OFF_COS); float* sinT = (float*)(ws + OFF_SIN);
  float* ssq_all = (float*)(ws + OFF_SSQ);
  float* kpe = (float*)(ws + OFF_KPE);
  bf16_t* hb = (bf16_t*)(ws + OFF_HB);
  bf16_t* act = (bf16_t*)(ws + OFF_ACT); bf16_t* lat = (bf16_t*)(ws + OFF_LAT); bf16_t* qraw = (bf16_t*)(ws + OFF_QRAW);
  bf16_t* kbuf = (bf16_t*)(ws + OFF_K); bf16_t* vtb = (bf16_t*)(ws + OFF_VT);
  bf16_t* obuf = lat; bf16_t* pooled = (bf16_t*)(ws + OFF_POOLED);
  const int gt = blockIdx.x * 512 + threadIdx.x, gs = gridDim.x * 512;
  const int vhalf = __builtin_amdgcn_readfirstlane((int)(threadIdx.x >> 8));
  const int vb = blockIdx.x * 2 + vhalf, nvb = gridDim.x * 2;
  bf16_t* smh = (bf16_t*)(smem + vhalf * VHALF_BYTES);
  float* smf = (float*)(smem + vhalf * VHALF_BYTES);

  unsigned* ctl = (unsigned*)(ws + OFF_CTL);
  if (threadIdx.x == 0) {
    const unsigned xcc = (unsigned)__builtin_amdgcn_s_getreg((3 << 11) | 20) & 0x7u;
    const unsigned rank = atomicAdd(ctl + xcc, 1u);
    ((volatile int*)smem)[0] = (int)xcc; ((volatile int*)smem)[1] = (int)rank;
  }
  __syncthreads();
  int xs = __builtin_amdgcn_readfirstlane(((volatile int*)smem)[0]);
  int js = __builtin_amdgcn_readfirstlane(((volatile int*)smem)[1]);
  __syncthreads();

  for (int idx = gt; idx < T * 32; idx += gs) {
    const int t = idx >> 5, jf = idx & 31;
    const float inv_freq = exp2f(-(float)jf * 0.41524101186092029f);
    const float ang = (float)positions[t] * inv_freq;
    const double rev = (double)ang * 0.15915494309189535;
    const float fr = (float)(rev - rint(rev));
    cosT[idx] = __builtin_amdgcn_cosf(fr);
    sinT[idx] = __builtin_amdgcn_sinf(fr);
  }
  for (int i = gt; i < 15 * T; i += gs) ssq_all[T + i] = 0.f;
  norm0_phase(x_in, hb, ssq_all);
  for (int jl = 0; jl < 2; ++jl) {
    for (int g = 0; g < 4; ++g)
      prep_w(vb, nvb, p.in[7] + ((size_t)jl * 4 + g) * 65536, wpool + ((size_t)jl * 4 + g) * 256 * (256 + PADK), 256, 256, p.in[6] + (size_t)(2 * jl) * D + g * 256, p.in[8] + (size_t)jl * D + g * 256, 0, smf);
    prep_w(vb, nvb, p.in[9] + (size_t)jl * D * 1088, win + (size_t)jl * LATNP * (D + PADK), D, 1088, p.in[6] + (size_t)(2 * jl + 1) * D, nullptr, 0, smf);
    for (int i = gt; i < (LATNP - 1088) * (D + PADK) / 8; i += gs) ((u32x4*)(win + (size_t)jl * LATNP * (D + PADK) + (size_t)1088 * (D + PADK)))[i] = (u32x4){0u, 0u, 0u, 0u};
    prep_w(vb, nvb, p.in[11] + (size_t)jl * QL * 1536, wq + (size_t)jl * 1536 * (QL + PADK), QL, 1536, p.in[10] + (size_t)jl * QL, nullptr, 0, smf);
    prep_w(vb, nvb, p.in[13] + (size_t)jl * KVL * 2048, wkv + (size_t)jl * 2048 * (KVL + PADK), KVL, 2048, p.in[12] + (size_t)jl * KVL, nullptr, 3, smf);
    prep_w(vb, nvb, p.in[16] + (size_t)jl * D * D, wout + (size_t)jl * D * (D + PADK), D, D, nullptr, nullptr, 0, smf);
  }
#define PREP_FFN1(L_) { const size_t wo_ = (size_t)(L_) * D * FF; \
    prep_w(vb, nvb, p.in[3] + wo_, wgu1, D, FF, p.in[2] + (size_t)(L_) * D, nullptr, 1, smf); \
    prep_w(vb, nvb, p.in[4] + wo_, wgu1, D, FF, p.in[2] + (size_t)(L_) * D, nullptr, 2, smf); \
    prep_w(vb, nvb, p.in[5] + wo_, wdn1, FF, D, nullptr, nullptr, 0, smf); }
#define PREP_FFN2(L_) { const size_t wo_ = (size_t)(L_) * D * FF; \
    prep_w(vb, nvb, p.in[18] + wo_, wgu2, D, FF, p.in[17] + (size_t)(L_) * D, nullptr, 1, smf); \
    prep_w(vb, nvb, p.in[19] + wo_, wgu2, D, FF, p.in[17] + (size_t)(L_) * D, nullptr, 2, smf); \
    prep_w(vb, nvb, p.in[20] + wo_, wdn2, FF, D, nullptr, nullptr, 0, smf); }
  PREP_FFN1(0);
  PREP_FFN2(0);
  grid.sync();
  {
    bool even = true;
    for (int i = 0; i < 8; ++i) even = even && (__hip_atomic_load(ctl + i, __ATOMIC_RELAXED, __HIP_MEMORY_SCOPE_AGENT) == (gridDim.x >> 3));
    if (!even || js >= (int)(gridDim.x >> 3)) { xs = blockIdx.x & 7; js = blockIdx.x >> 3; }
  }
  unsigned bar_target = 0;
#define GBAR() { bar_target += gridDim.x; grid_bar(ctl + 32, bar_target); }
  unsigned xbar_target = 0;
#define XBAR() { xbar_target += (gridDim.x >> 3); grid_bar(ctl + 48 + xs, xbar_target); }
  const int jv = js * 2 + vhalf, nbv = (int)(gridDim.x >> 3) * 2;

  for (int layer = 0; layer < DEPTH; ++layer) {
    const float* xcur = (layer == 0) ? x_in : out;
    float* ssq0 = ssq_all + (size_t)(layer * 3 + 0) * T;
    float* ssq1 = ssq_all + (size_t)(layer * 3 + 1) * T;
    float* ssq2 = ssq_all + (size_t)(layer * 3 + 2) * T;
    float* ssq_next = ssq_all + (size_t)((layer + 1) * 3) * T;
    const int jl = layer >> 1;
    float* ssq_q = ssq_all + (size_t)(12 + jl) * T;
    float* ssq_kv = ssq_all + (size_t)(14 + jl) * T;
    if (layer > 0) PREP_FFN2(layer);
    gemm8_phase(xs, js, hb, LDH, wgu1, D, 2 * FF, 0, EpiGU8{act, ssq0});
    XBAR();
    gemm8_phase(xs, js, act, LDA, wdn1, FF, D, 0, EpiResid8{xcur, out, 0.5f, hb, ssq1});
    GBAR();
    if (layer + 1 < DEPTH) PREP_FFN1(layer + 1);
    if ((layer & 1) == 0) {
      poolprep_phase(vb, nvb, out, ssq1, pooled, smf);
      GBAR();
      gemm8_phase(xs, js, pooled, LDH, wpool + (size_t)jl * 1024 * (256 + PADK), 256, D, 256, EpiResid8{out, out, 1.0f, hb, ssq2});
      GBAR();
    } else {
      gemm8_phase(xs, js, hb, LDH, win + (size_t)jl * LATNP * (D + PADK), D, LATNP, 0, EpiLat8{lat, kpe, ssq_q, ssq_kv, ssq1});
      GBAR();
      gemm8_phase(xs, js, lat, LDH, wq + (size_t)jl * 1536 * (QL + PADK), QL, 1536, 0, EpiQraw8{qraw, ssq_q});
      gemm_phase<CR>(xs, jv, nbv, lat + QL, LDH, wkv + (size_t)jl * 2048 * (KVL + PADK), KVL, 2048, 0, EpiKV{ssq_kv, kpe, p.in[15] + (size_t)jl * QKH, cosT, sinT, kbuf, vtb}, smh);
      GBAR();
      attn_phase(qraw, kbuf, vtb, obuf, p.in[14] + (size_t)jl * QKH, cosT, sinT, (bf16_t*)smem, xs, js);
      GBAR();
      gemm8_phase(xs, js, obuf, LDH, wout + (size_t)jl * D * (D + PADK), D, D, 0, EpiResid8{out, out, 1.0f, hb, ssq2});
      GBAR();
    }
    gemm8_phase(xs, js, hb, LDH, wgu2, D, 2 * FF, 0, EpiGU8{act, ssq2});
    XBAR();
    const bool last = (layer + 1 == DEPTH);
    gemm8_phase(xs, js, act, LDA, wdn2, FF, D, 0, EpiResid8{out, out, 0.5f, last ? nullptr : hb, last ? nullptr : ssq_next});
    if (!last) GBAR();
  }
}

extern "C" void kernel_launch(void* const* d_in, const int* in_sizes, int n_in, void* d_out, int out_size, void* d_ws, size_t ws_size, hipStream_t stream) {
  static int grid_blocks = 0;
  if (!grid_blocks) {
    int dev = 0, cus = 0, per_cu = 0;
    (void)hipGetDevice(&dev);
    (void)hipDeviceGetAttribute(&cus, hipDeviceAttributeMultiprocessorCount, dev);
    (void)hipFuncSetAttribute((const void*)fwd_megakernel, hipFuncAttributeMaxDynamicSharedMemorySize, LDS_BYTES);
    (void)hipOccupancyMaxActiveBlocksPerMultiprocessor(&per_cu, fwd_megakernel, 512, LDS_BYTES);
    grid_blocks = cus;
    if (n_in != 21 || out_size != T * D || ws_size < WS_TOTAL || per_cu < 1) fprintf(stderr, "kernel_launch: unexpected n_in=%d out=%d ws=%zu (need %zu) per_cu=%d\n", n_in, out_size, ws_size, (size_t)WS_TOTAL, per_cu);
  }
  Params p{};
  for (int i = 0; i < 21; ++i) p.in[i] = (const float*)d_in[i];
  p.out = (float*)d_out; p.ws = (unsigned char*)d_ws;
  (void)hipMemsetAsync((unsigned char*)d_ws + OFF_CTL, 0, 256, stream);
  void* args[] = {&p};
  hipError_t e = hipLaunchCooperativeKernel((void*)fwd_megakernel, dim3(grid_blocks), dim3(512), args, LDS_BYTES, stream);
  if (e != hipSuccess) fprintf(stderr, "cooperative launch failed: %s (grid %d)\n", hipGetErrorString(e), grid_blocks);
}
```
